# Optimizing an MI355X kernel written in HIP

```python
import jax
import jax.numpy as jnp
from jax import lax
import numpy as np


D_MODEL = 2048
BATCH = 4
SEQ = 2048
DEPTH = 1

GRID_W = 64
NA_HEADS = 16
NA_HEAD_DIM = 64
NA_WIDTH = NA_HEADS * NA_HEAD_DIM
NA_WIN_R = 8
NA_WIN_C = 16
GLA_HEADS = 4
GLA_DK = D_MODEL // (2 * GLA_HEADS)
GLA_DV = D_MODEL // GLA_HEADS
GLA_K = GLA_HEADS * GLA_DK
GLA_V = GLA_HEADS * GLA_DV
GLA_GATE_RANK = 16
GLA_TAU = 16.0
GLA_CHUNK = 64
PEER_HEADS = 8
PEER_NKEYS = 128
PEER_N = PEER_NKEYS * PEER_NKEYS
PEER_DKEY = 256
PEER_TOPK = 16
PEER_BLOCK = 128
PLE_DIM = 256
LN_EPS = 1e-5
DEEPNORM_ALPHA = (2.0 * DEPTH) ** 0.25
DEEPNORM_BETA = (8.0 * DEPTH) ** -0.25

IN_SPLITS = (NA_WIDTH, NA_WIDTH, NA_WIDTH, GLA_K, GLA_K, GLA_V, GLA_V, GLA_GATE_RANK, GLA_GATE_RANK, D_MODEL, D_MODEL)
IN_WIDTH = sum(IN_SPLITS)
IN_SPLIT_POINTS = tuple(int(c) for c in np.cumsum(IN_SPLITS)[:-1])

kernel_name = 'hybrid_natten_gla_peer_encoder'


def layer_norm(x, g, b):
    xf = x.astype(jnp.float32)
    mu = jnp.mean(xf, axis=-1, keepdims=True)
    var = jnp.mean(jnp.square(xf - mu), axis=-1, keepdims=True)
    y = (xf - mu) * lax.rsqrt(var + LN_EPS)
    return (y * g.astype(jnp.float32) + b.astype(jnp.float32)).astype(x.dtype)


def to_heads(t, n_heads):
    bsz, s, _ = t.shape
    return t.reshape(bsz, s, n_heads, -1).transpose(0, 2, 1, 3)


def neighbourhood_attention(q, k, v, rpb):
    bsz, s, h, dh = q.shape
    rows = s // GRID_W
    kr = min(NA_WIN_R, rows)
    kc = NA_WIN_C

    def to_grid(t):
        return t.reshape(bsz, rows, GRID_W, h, dh).transpose(1, 0, 3, 2, 4)

    qg = to_grid(q * (dh ** -0.5))
    kg = to_grid(k)
    vg = to_grid(v)
    cols = jnp.arange(GRID_W)
    col_idx = jnp.clip(cols - kc // 2, 0, GRID_W - kc)[:, None] + jnp.arange(kc)[None, :]
    dc = col_idx - cols[:, None] + (NA_WIN_C - 1)

    def row_block(r):
        r0 = jnp.clip(r - kr // 2, 0, rows - kr)
        k_win = lax.dynamic_slice_in_dim(kg, r0, kr, axis=0)[:, :, :, col_idx, :]
        v_win = lax.dynamic_slice_in_dim(vg, r0, kr, axis=0)[:, :, :, col_idx, :]
        dr = r0 + jnp.arange(kr) - r + (NA_WIN_R - 1)
        bias = rpb[:, dr[:, None, None], dc[None, :, :]].transpose(0, 2, 1, 3)
        scores = jnp.einsum('bhwd,ibhwjd->bhwij', qg[r], k_win).astype(jnp.float32)
        scores = scores + bias.astype(jnp.float32)[None]
        probs = jax.nn.softmax(scores.reshape(bsz, h, GRID_W, kr * kc), axis=-1)
        probs = probs.reshape(bsz, h, GRID_W, kr, kc).astype(v.dtype)
        return jnp.einsum('bhwij,ibhwjd->bhwd', probs, v_win)

    out = lax.map(row_block, jnp.arange(rows))
    return out.transpose(1, 0, 3, 2, 4).reshape(bsz, s, h * dh)


def gla_chunked(q, k, v, log_a, include_diag):
    bsz, h, s, dk = q.shape
    dv = v.shape[-1]
    c = GLA_CHUNK
    n = s // c
    f32 = jnp.float32
    qc = q.astype(f32).reshape(bsz, h, n, c, dk)
    kc = k.astype(f32).reshape(bsz, h, n, c, dk)
    vc = v.astype(f32).reshape(bsz, h, n, c, dv)
    b = jnp.cumsum(log_a.astype(f32).reshape(bsz, h, n, c, dk), axis=3)
    b_last = b[:, :, :, -1:, :]
    q_dec = qc * jnp.exp(b)
    k_intra = kc * jnp.exp(-b)
    k_state = kc * jnp.exp(b_last - b)
    mask = jnp.tril(jnp.ones((c, c), dtype=bool), 0 if include_diag else -1)
    attn = jnp.where(mask, jnp.einsum('bhnik,bhnjk->bhnij', q_dec, k_intra), 0.0)
    o_intra = jnp.einsum('bhnij,bhnjv->bhniv', attn, vc)

    def step(state, xs):
        q_d, k_s, v_n, decay = xs
        o = jnp.einsum('bhck,bhkv->bhcv', q_d, state)
        state = decay[..., None] * state + jnp.einsum('bhck,bhcv->bhkv', k_s, v_n)
        return state, o

    xs = (jnp.moveaxis(q_dec, 2, 0), jnp.moveaxis(k_state, 2, 0), jnp.moveaxis(vc, 2, 0),
          jnp.moveaxis(jnp.exp(b_last[:, :, :, 0, :]), 2, 0))
    _, o_inter = lax.scan(step, jnp.zeros((bsz, h, dk, dv), f32), xs)
    o = o_intra + jnp.moveaxis(o_inter, 0, 2)
    return o.reshape(bsz, h, s, dv)


def peer(x, w_q, sub_keys, u, v):
    bsz, s, d = x.shape
    kk = PEER_TOPK
    q = (x @ w_q).reshape(bsz, s, PEER_HEADS, 2, PEER_DKEY // 2)
    sc = jnp.einsum('bshpk,hpnk->bshpn', q, sub_keys).astype(jnp.float32)
    val, idx = lax.top_k(sc, kk)
    cand = val[..., 0, :, None] + val[..., 1, None, :]
    cand_idx = idx[..., 0, :, None] * PEER_NKEYS + idx[..., 1, None, :]
    top_val, top_pos = lax.top_k(cand.reshape(bsz, s, PEER_HEADS, kk * kk), kk)
    expert = jnp.take_along_axis(cand_idx.reshape(bsz, s, PEER_HEADS, kk * kk), top_pos, axis=-1)
    gate = jax.nn.softmax(top_val, axis=-1)
    n_blocks = (bsz * s) // PEER_BLOCK
    xb = x.reshape(n_blocks, PEER_BLOCK, d)
    eb = expert.reshape(n_blocks, PEER_BLOCK, PEER_HEADS * kk)
    gb = gate.reshape(n_blocks, PEER_BLOCK, PEER_HEADS * kk).astype(x.dtype)

    def block(args):
        xt, et, gt = args
        hid = jnp.einsum('td,ted->te', xt, u[et])
        w = gt * jax.nn.gelu(hid, approximate=False)
        return jnp.einsum('te,ted->td', w, v[et])

    y = lax.map(block, (xb, eb, gb))
    return y.reshape(bsz, s, d)


def setup_inputs(seed: int = 0) -> dict:
    key = jax.random.key(seed)
    ks = jax.random.split(key, 25)

    def nrm(k, shape, scale):
        return jax.random.normal(k, shape, jnp.float32) * scale

    L, D = DEPTH, D_MODEL
    return {
        'x': nrm(ks[0], (BATCH, SEQ, D), 1.0),
        'p': nrm(ks[1], (L, BATCH, SEQ, PLE_DIM), 1.0),
        'ln_emb_g': 1.0 + nrm(ks[2], (D,), 0.02),
        'ln_emb_b': nrm(ks[3], (D,), 0.02),
        'w_in': nrm(ks[4], (L, D, IN_WIDTH), D ** -0.5),
        'b_in': nrm(ks[5], (L, IN_WIDTH), 0.01),
        'na_rpb': nrm(ks[6], (L, NA_HEADS, 2 * NA_WIN_R - 1, 2 * NA_WIN_C - 1), 0.1),
        'gla_gk_up_f': nrm(ks[7], (L, GLA_GATE_RANK, GLA_K), GLA_GATE_RANK ** -0.5),
        'gla_gk_bias_f': nrm(ks[8], (L, GLA_K), 0.01),
        'gla_gk_up_b': nrm(ks[9], (L, GLA_GATE_RANK, GLA_K), GLA_GATE_RANK ** -0.5),
        'gla_gk_bias_b': nrm(ks[10], (L, GLA_K), 0.01),
        'gla_norm_g': 1.0 + nrm(ks[11], (L, GLA_DV), 0.02),
        'w_proj_a': nrm(ks[12], (L, NA_WIDTH, D), NA_WIDTH ** -0.5),
        'w_proj_b': nrm(ks[13], (L, GLA_V, D), GLA_V ** -0.5),
        'w_out': nrm(ks[14], (L, D, D), DEEPNORM_BETA * D ** -0.5),
        'ln_a_g': 1.0 + nrm(ks[15], (L, D), 0.02),
        'ln_a_b': nrm(ks[16], (L, D), 0.02),
        'peer_wq': nrm(ks[17], (L, D, PEER_HEADS * PEER_DKEY), D ** -0.5),
        'peer_sub_keys': nrm(ks[18], (L, PEER_HEADS, 2, PEER_NKEYS, PEER_DKEY // 2), (PEER_DKEY // 2) ** -0.5),
        'peer_u': nrm(ks[19], (L, PEER_N, D), D ** -0.5),
        'peer_v': nrm(ks[20], (L, PEER_N, D), DEEPNORM_BETA),
        'w_ple': nrm(ks[21], (L, PLE_DIM, D), DEEPNORM_BETA * PLE_DIM ** -0.5),
        'w_ple_gate': nrm(ks[22], (L, D, D), D ** -0.5),
        'ln_b_g': 1.0 + nrm(ks[23], (L, D), 0.02),
        'ln_b_b': nrm(ks[24], (L, D), 0.02),
    }


def reference(x, p, ln_emb_g, ln_emb_b, w_in, b_in, na_rpb, gla_gk_up_f, gla_gk_bias_f,
              gla_gk_up_b, gla_gk_bias_b, gla_norm_g, w_proj_a, w_proj_b, w_out, ln_a_g, ln_a_b,
              peer_wq, peer_sub_keys, peer_u, peer_v, w_ple, w_ple_gate, ln_b_g, ln_b_b):
    bsz, s, d = x.shape
    f32 = jnp.float32
    h = layer_norm(x, ln_emb_g, ln_emb_b)
    for i in range(DEPTH):
        z = h @ w_in[i] + b_in[i]
        (na_q, na_k, na_v, g_q, g_k, g_v, g_out, gk_f_lr, gk_b_lr, gate_a, gate_b) = jnp.split(
            z, IN_SPLIT_POINTS, axis=-1)
        hd = (bsz, s, NA_HEADS, NA_HEAD_DIM)
        y_na = neighbourhood_attention(na_q.reshape(hd), na_k.reshape(hd), na_v.reshape(hd), na_rpb[i])
        y_a = y_na @ w_proj_a[i]
        gq = to_heads(g_q, GLA_HEADS) * (GLA_DK ** -0.5)
        gk = to_heads(g_k, GLA_HEADS)
        gv = to_heads(g_v, GLA_HEADS)
        la_f = to_heads(jax.nn.log_sigmoid((gk_f_lr @ gla_gk_up_f[i] + gla_gk_bias_f[i]).astype(f32)) / GLA_TAU, GLA_HEADS)
        la_b = to_heads(jax.nn.log_sigmoid((gk_b_lr @ gla_gk_up_b[i] + gla_gk_bias_b[i]).astype(f32)) / GLA_TAU, GLA_HEADS)
        o_f = gla_chunked(gq, gk, gv, la_f, True)
        o_b = jnp.flip(gla_chunked(jnp.flip(gq, 2), jnp.flip(gk, 2), jnp.flip(gv, 2), jnp.flip(la_b, 2), False), 2)
        o = (o_f + o_b).transpose(0, 2, 1, 3)
        o = o * lax.rsqrt(jnp.mean(o * o, axis=-1, keepdims=True) + LN_EPS) * gla_norm_g[i].astype(f32)
        o = o.astype(x.dtype) * jax.nn.silu(g_out.reshape(bsz, s, GLA_HEADS, GLA_DV))
        y_b = o.reshape(bsz, s, GLA_V) @ w_proj_b[i]
        merged = jax.nn.sigmoid(gate_a) * y_a + jax.nn.sigmoid(gate_b) * y_b
        h = layer_norm(DEEPNORM_ALPHA * h + merged @ w_out[i], ln_a_g[i], ln_a_b[i])
        ple = (p[i] @ w_ple[i]) * jax.nn.sigmoid(h @ w_ple_gate[i])
        y_c = peer(h, peer_wq[i], peer_sub_keys[i], peer_u[i], peer_v[i])
        h = layer_norm(DEEPNORM_ALPHA * h + y_c + ple, ln_b_g[i], ln_b_b[i])
    return h
```

```cpp
#include <hip/hip_runtime.h>
#include <cstdio>
#include <cstdint>

typedef unsigned short bf16;
#define DEV __device__ __forceinline__

constexpr int D = 2048, BATCH = 4, SEQ = 2048, T = BATCH * SEQ;
constexpr int GRID_W = 64, ROWS = SEQ / GRID_W;
constexpr int NA_H = 16, NA_DH = 64, NA_W = 1024, WIN_R = 8, WIN_C = 16;
constexpr int GH = 4, GDK = 256, GDV = 512, GK = 1024, GV = 2048, GRANK = 16;
constexpr int PH = 8, PNK = 128, PTOPK = 16, PLE = 256;
constexpr int IN_W = 13344;
constexpr float LN_EPS = 1e-5f;
constexpr float ALPHA = 1.189207115002721f;

constexpr int C_NAQ = 0, C_NAK = 1024, C_NAV = 2048, C_GQ = 3072, C_GK = 4096, C_GV = 5120, C_GOUT = 7168, C_LRF = 9216, C_LRB = 9232, C_GA = 9248, C_GB = 11296;
constexpr int N1 = 10496;

constexpr size_t MiB = 1u << 20;
constexpr size_t WS_CTL = 0, WS_H0 = 1 * MiB, WS_W1T = 33 * MiB, WS_WVT = 74 * MiB, WS_WAT = 86 * MiB, WS_WBT = 90 * MiB, WS_WOT = 98 * MiB, WS_W2T = 106 * MiB,
                 WS_WPT = 122 * MiB, WS_PB = 123 * MiB, WS_KEYS = 127 * MiB, WS_B1 = 127 * MiB + 512 * 1024, WS_BV = 127 * MiB + 640 * 1024,
                 WS_RSU = 127 * MiB + 768 * 1024, WS_RSV = 127 * MiB + 896 * 1024,
                 WS_U8 = 192 * MiB, WS_V8 = 160 * MiB,
                 WS_U4 = 352 * MiB, WS_V4 = 368 * MiB,
                 WS_AF = 128 * MiB, WS_AB = 160 * MiB,
                 WS_OF = 192 * MiB, WS_OB = 224 * MiB,
                 WS_NAQK = 256 * MiB, WS_GQK = 288 * MiB, WS_GOUT = 320 * MiB, WS_GATES = 352 * MiB, WS_LR = 416 * MiB,
                 WS_VT = 420 * MiB, WS_YNA = 468 * MiB, WS_IDS = 484 * MiB, WS_GATEP = 488 * MiB,
                 WS_W1F8 = 33 * MiB, WS_H0F8 = 54 * MiB, WS_WVF8 = 74 * MiB, WS_W2F8 = 106 * MiB, WS_H1F8 = 54 * MiB,
                 WS_LNX = 502 * MiB,
                 WS_QD = 192 * MiB, WS_KST = 224 * MiB,
                 WS_ATT = 493 * MiB, WS_DEC = 501 * MiB,
                 WS_TMP = 33 * MiB,
                 WS_OG = 192 * MiB,
                 WS_MERGED = 224 * MiB,
                 WS_R1 = 256 * MiB,
                 WS_H1 = 320 * MiB,
                 WS_PLELIN = 128 * MiB, WS_PLEB = 384 * MiB,
                 WS_QP = 420 * MiB;

DEV float bf2f(bf16 v) { return __uint_as_float((unsigned)v << 16); }
DEV bf16 f2bf(float f) { unsigned u = __float_as_uint(f); return (bf16)((u + 0x7fffu + ((u >> 16) & 1u)) >> 16); }
DEV float sigmoidf_(float x) { return __builtin_amdgcn_rcpf(1.f + __builtin_amdgcn_exp2f(x * -1.44269504f)); }
#define WR_DPP(x, ctl) __builtin_bit_cast(float, __builtin_amdgcn_mov_dpp(__builtin_bit_cast(int, x), ctl, 0xf, 0xf, true))
DEV float wave_sum(float v) {
    v += WR_DPP(v, 0xB1); v += WR_DPP(v, 0x4E); v += WR_DPP(v, 0x141); v += WR_DPP(v, 0x140);
    { const auto p = __builtin_amdgcn_permlane16_swap(__float_as_uint(v), __float_as_uint(v), false, false); v = __uint_as_float(p[0]) + __uint_as_float(p[1]); }
    { const auto p = __builtin_amdgcn_permlane32_swap(__float_as_uint(v), __float_as_uint(v), false, false); v = __uint_as_float(p[0]) + __uint_as_float(p[1]); }
    return v;
}
DEV float wave_max(float v) {
    v = fmaxf(v, WR_DPP(v, 0xB1)); v = fmaxf(v, WR_DPP(v, 0x4E)); v = fmaxf(v, WR_DPP(v, 0x141)); v = fmaxf(v, WR_DPP(v, 0x140));
    { const auto p = __builtin_amdgcn_permlane16_swap(__float_as_uint(v), __float_as_uint(v), false, false); v = fmaxf(__uint_as_float(p[0]), __uint_as_float(p[1])); }
    { const auto p = __builtin_amdgcn_permlane32_swap(__float_as_uint(v), __float_as_uint(v), false, false); v = fmaxf(__uint_as_float(p[0]), __uint_as_float(p[1])); }
    return v;
}

DEV int orig_col_main(int n) {
    if (n < 1024) return C_NAQ + n; if (n < 2048) return C_NAK + (n - 1024); if (n < 3072) return C_GQ + (n - 2048); if (n < 4096) return C_GK + (n - 3072);
    if (n < 6144) return C_GOUT + (n - 4096); if (n < 8192) return C_GA + (n - 6144); if (n < 10240) return C_GB + (n - 8192); if (n < 10272) return C_LRF + (n - 10240); return -1; }
struct EpiArgs { const float* bias; const float* bias2; bf16* o0; bf16* o1; bf16* o2; bf16* o3; bf16* o4; bf16* o5; float* of; const bf16* a0; const bf16* a1; int qonly; int pad; };
enum { EK_MAIN = 0, EK_VT = 1, EK_A = 2, EK_B = 3, EK_OUT = 4, EK_PLE = 5, EK_2 = 6 };
DEV void na_naive_task(const bf16* __restrict__ NAQK, const bf16* __restrict__ VT, const float* __restrict__ rpb, bf16* __restrict__ YNA, int task, int lane) {
    const int tok = task >> 4, h = task & 15, b = tok >> 11, s = tok & 2047, r = s >> 6, c = s & 63;
    const int r0 = min(max(r - WIN_R / 2, 0), ROWS - WIN_R), c0 = min(max(c - WIN_C / 2, 0), GRID_W - WIN_C);
    const bf16* q = NAQK + (size_t)tok * 2048 + h * 64;
    float sc[2];
#pragma unroll
    for (int u = 0; u < 2; ++u) {
        const int kidx = lane + 64 * u, i = kidx >> 4, j = kidx & 15, kt = b * 2048 + (r0 + i) * 64 + c0 + j;
        const bf16* kp = NAQK + (size_t)kt * 2048 + 1024 + h * 64; float a = 0.f;
        for (int d = 0; d < 64; ++d) a += bf2f(q[d]) * bf2f(kp[d]);
        sc[u] = a + rpb[(h * 15 + (r0 + i - r + WIN_R - 1)) * 31 + (c0 + j - c + WIN_C - 1)];
    }
    const float mx = wave_max(fmaxf(sc[0], sc[1]));
    const float p0 = __expf(sc[0] - mx), p1 = __expf(sc[1] - mx), inv = 1.f / wave_sum(p0 + p1);
    float o = 0.f;
    const bf16* vrow = VT + (size_t)(h * 64 + lane) * T;
    for (int kidx = 0; kidx < 128; ++kidx) {
        const float p = __shfl(kidx < 64 ? p0 : p1, kidx & 63);
        const int i = kidx >> 4, j = kidx & 15, kt = b * 2048 + (r0 + i) * 64 + c0 + j;
        o += p * bf2f(vrow[kt]);
    }
    YNA[(size_t)tok * 1024 + h * 64 + lane] = f2bf(o * inv);
}

DEV void gla_decay_elem(const bf16* __restrict__ LR, const float* __restrict__ upf, const float* __restrict__ bf_, const float* __restrict__ upb, const float* __restrict__ bb_, float* __restrict__ AF, float* __restrict__ AB, size_t i) {
    const int tok = (int)(i >> 10), ch = (int)(i & 1023);
    float gf = bf_[ch], gb = bb_[ch];
#pragma unroll
    for (int r = 0; r < 16; ++r) { gf += bf2f(LR[(size_t)tok * 256 + r]) * upf[r * 1024 + ch]; gb += bf2f(LR[(size_t)tok * 256 + 16 + r]) * upb[r * 1024 + ch]; }
    const float lf = fminf(gf, 0.f) - log1pf(__expf(-fabsf(gf))), lb = fminf(gb, 0.f) - log1pf(__expf(-fabsf(gb)));
    AF[i] = __expf(lf * (1.f / 16.f)); AB[i] = __expf(lb * (1.f / 16.f));
}
DEV void gla_naive_thread(const bf16* __restrict__ GQK, const bf16* __restrict__ VT, const float* __restrict__ AF, const float* __restrict__ AB, bf16* __restrict__ OF, bf16* __restrict__ OB, int gid) {
    const int kq = gid & 3, dv = (gid >> 2) & 511, bhd = gid >> 11, dir = bhd & 1, h = (bhd >> 1) & 3, b = bhd >> 3;
    const float* Adec = dir ? AB : AF; bf16* O = dir ? OB : OF;
    const bf16* vrow = VT + (size_t)(1024 + h * 512 + dv) * T + (size_t)b * 2048;
    float s[64];
#pragma unroll
    for (int k = 0; k < 64; ++k) s[k] = 0.f;
    for (int tt = 0; tt < SEQ; ++tt) {
        const int t = dir ? SEQ - 1 - tt : tt; const size_t tok = (size_t)b * 2048 + t;
        const bf16* qp = GQK + tok * 2048 + h * 256 + kq * 64; const bf16* kp = qp + 1024; const float* ap = Adec + tok * 1024 + h * 256 + kq * 64;
        const float v = bf2f(vrow[t]); float o = 0.f;
        if (dir == 0) {
#pragma unroll
            for (int k = 0; k < 64; ++k) { s[k] = ap[k] * s[k] + bf2f(kp[k]) * v; o += bf2f(qp[k]) * s[k]; }
        } else {
#pragma unroll
            for (int k = 0; k < 64; ++k) { const float sd = ap[k] * s[k]; o += bf2f(qp[k]) * sd; s[k] = sd + bf2f(kp[k]) * v; }
        }
        o += __shfl_xor(o, 1); o += __shfl_xor(o, 2);
        if (kq == 0) O[tok * 2048 + h * 512 + dv] = f2bf(o);
    }
}
DEV void peer_topk_task(const bf16* __restrict__ QP, const bf16* __restrict__ KEYS, int* __restrict__ IDS, float* __restrict__ GP, int task, int n, __attribute__((address_space(3))) float* sm) {
    __attribute__((address_space(3))) float (*sc)[128] = (__attribute__((address_space(3))) float (*)[128])sm;
    __attribute__((address_space(3))) float (*tv)[16] = (__attribute__((address_space(3))) float (*)[16])(sm + 256);
    __attribute__((address_space(3))) int (*ti)[16] = (__attribute__((address_space(3))) int (*)[16])(sm + 288);
    __attribute__((address_space(3))) float* cv = sm + 320; __attribute__((address_space(3))) float* fv = sm + 576; __attribute__((address_space(3))) int* fi = (__attribute__((address_space(3))) int*)(sm + 592);
    const int tok = task >> 3, h = task & 7;
#pragma unroll
    for (int half = 0; half < 2; ++half) {
        const bf16* q = QP + (size_t)tok * 2048 + h * 256 + half * 128; const bf16* kp = KEYS + ((size_t)(h * 2 + half) * 128 + n) * 128; float a = 0.f;
        for (int k = 0; k < 128; ++k) a += bf2f(q[k]) * bf2f(kp[k]);
        sc[half][n] = a;
    }
    __syncthreads();
#pragma unroll
    for (int half = 0; half < 2; ++half) { const float v = sc[half][n]; int rank = 0;
        for (int m = 0; m < 128; ++m) { const float w = sc[half][m]; rank += (w > v || (w == v && m < n)) ? 1 : 0; }
        if (rank < 16) { tv[half][rank] = v; ti[half][rank] = n; } }
    __syncthreads();
    for (int c = n; c < 256; c += 128) cv[c] = tv[0][c >> 4] + tv[1][c & 15];
    __syncthreads();
    for (int c = n; c < 256; c += 128) { const float v = cv[c]; int rank = 0;
        for (int m = 0; m < 256; ++m) { const float w = cv[m]; rank += (w > v || (w == v && m < c)) ? 1 : 0; }
        if (rank < 16) { fv[rank] = v; fi[rank] = ti[0][c >> 4] * 128 + ti[1][c & 15]; } }
    __syncthreads();
    if (n < 16) { float mx = fv[0], sum = 0.f;
        for (int m = 0; m < 16; ++m) sum += __expf(fv[m] - mx);
        IDS[(size_t)tok * 128 + h * 16 + n] = fi[n]; GP[(size_t)tok * 128 + h * 16 + n] = __expf(fv[n] - mx) / sum; }
}
DEV void peer_gather_naive_tok(const bf16* __restrict__ H1, const int* __restrict__ IDS, const float* __restrict__ GP, const float* __restrict__ U, const float* __restrict__ V,
                              const bf16* __restrict__ PLEB, const float* __restrict__ lg, const float* __restrict__ lb, float* __restrict__ out, int tok, int lane) {
    float x[32], y[32];
#pragma unroll
    for (int j = 0; j < 8; ++j)
#pragma unroll
        for (int i = 0; i < 4; ++i) { x[j * 4 + i] = bf2f(H1[(size_t)tok * 2048 + 256 * j + 4 * lane + i]); y[j * 4 + i] = 0.f; }
    for (int e = 0; e < 128; ++e) {
        const int id = IDS[(size_t)tok * 128 + e]; const float g = GP[(size_t)tok * 128 + e];
        const float4* ur = (const float4*)(U + (size_t)id * 2048) + lane; const float4* vr = (const float4*)(V + (size_t)id * 2048) + lane;
        float a = 0.f;
#pragma unroll
        for (int j = 0; j < 8; ++j) { const float4 u4 = ur[64 * j]; a += u4.x * x[j * 4] + u4.y * x[j * 4 + 1] + u4.z * x[j * 4 + 2] + u4.w * x[j * 4 + 3]; }
        a = wave_sum(a);
        const float w = g * (0.5f * a * (1.f + erff(a * 0.70710678f)));
#pragma unroll
        for (int j = 0; j < 8; ++j) { const float4 v4 = vr[64 * j]; y[j * 4] += w * v4.x; y[j * 4 + 1] += w * v4.y; y[j * 4 + 2] += w * v4.z; y[j * 4 + 3] += w * v4.w; }
    }
    float s = 0.f;
#pragma unroll
    for (int j = 0; j < 8; ++j)
#pragma unroll
        for (int i = 0; i < 4; ++i) { const int c = 256 * j + 4 * lane + i; y[j * 4 + i] += ALPHA * x[j * 4 + i] + bf2f(PLEB[(size_t)tok * 2048 + c]); s += y[j * 4 + i]; }
    const float mean = wave_sum(s) * (1.f / D); float q = 0.f;
#pragma unroll
    for (int i = 0; i < 32; ++i) { y[i] -= mean; q += y[i] * y[i]; }
    const float rstd = rsqrtf(wave_sum(q) * (1.f / D) + LN_EPS);
#pragma unroll
    for (int j = 0; j < 8; ++j) { const int c = 256 * j + 4 * lane; float4 o;
        o.x = y[j * 4] * rstd * lg[c] + lb[c]; o.y = y[j * 4 + 1] * rstd * lg[c + 1] + lb[c + 1]; o.z = y[j * 4 + 2] * rstd * lg[c + 2] + lb[c + 2]; o.w = y[j * 4 + 3] * rstd * lg[c + 3] + lb[c + 3];
        *(float4*)(out + (size_t)tok * 2048 + c) = o; }
}


typedef float f32x2_ __attribute__((ext_vector_type(2)));
DEV unsigned q8_1(float v) { return (unsigned)(__float2int_rn(v) + 128) & 0xffu; }
DEV void fp8_row(const float* __restrict__ src, unsigned char* __restrict__ dst, float* __restrict__ rs, int row, int lane) {
    const float4* sp = (const float4*)(src + (size_t)row * 2048) + lane; float4 v[8]; float m = 0.f;
#pragma unroll
    for (int j = 0; j < 8; ++j) { v[j] = sp[64 * j]; m = fmaxf(fmaxf(m, fmaxf(fabsf(v[j].x), fabsf(v[j].y))), fmaxf(fabsf(v[j].z), fabsf(v[j].w))); }
    m = wave_max(m); const float inv = m > 0.f ? 127.f / m : 0.f;
    unsigned* dp = (unsigned*)(dst + (size_t)row * 2048) + lane;
#pragma unroll
    for (int j = 0; j < 8; ++j) dp[64 * j] = q8_1(v[j].x * inv) | (q8_1(v[j].y * inv) << 8) | (q8_1(v[j].z * inv) << 16) | (q8_1(v[j].w * inv) << 24);
    if (lane == 0) rs[row] = m * (1.f / 127.f);
}
#define PG_ISSUE_U(grp) do { _Pragma("unroll") for (int e_ = 0; e_ < 4; ++e_) { const int ee_ = 4 * (grp) + e_; const int id_ = __builtin_amdgcn_readlane(ee_ < 64 ? id0 : id1, ee_ & 63); \
        const uint4* up_ = (const uint4*)(U8 + (size_t)id_ * 2048) + lane; ub[e_][0] = up_[0]; ub[e_][1] = up_[64]; } } while (0)
#define PG_ISSUE_V(grp) do { _Pragma("unroll") for (int e_ = 0; e_ < 4; ++e_) { const int ee_ = 4 * (grp) + e_; const int id_ = __builtin_amdgcn_readlane(ee_ < 64 ? id0 : id1, ee_ & 63); \
        const uint4* vp_ = (const uint4*)(V8 + (size_t)id_ * 2048) + lane; vb[e_][0] = vp_[0]; vb[e_][1] = vp_[64]; } } while (0)
#define PG_DOT(w4, xo, acc) do { const uint4 w_ = (w4); const unsigned q_[4] = {w_.x, w_.y, w_.z, w_.w}; _Pragma("unroll") for (int qq_ = 0; qq_ < 4; ++qq_) { \
        const f32x2_ lo_ = {(float)(q_[qq_] & 0xffu), (float)((q_[qq_] >> 8) & 0xffu)}, hi_ = {(float)((q_[qq_] >> 16) & 0xffu), (float)(q_[qq_] >> 24)}; \
        acc += lo_ * x2[(xo) + 2 * qq_]; acc += hi_ * x2[(xo) + 2 * qq_ + 1]; } } while (0)
#define PG_AXPY(w4, xo, wv) do { const uint4 w_ = (w4); const unsigned q_[4] = {w_.x, w_.y, w_.z, w_.w}; _Pragma("unroll") for (int qq_ = 0; qq_ < 4; ++qq_) { \
        const f32x2_ lo_ = {(float)(q_[qq_] & 0xffu), (float)((q_[qq_] >> 8) & 0xffu)}, hi_ = {(float)((q_[qq_] >> 16) & 0xffu), (float)(q_[qq_] >> 24)}; \
        y2[(xo) + 2 * qq_] += lo_ * (wv); y2[(xo) + 2 * qq_ + 1] += hi_ * (wv); } } while (0)
#define PG_GROUP(grp, more) do { float a_[4]; \
        _Pragma("unroll") for (int e_ = 0; e_ < 4; ++e_) { f32x2_ acc_ = {0.f, 0.f}; PG_DOT(ub[e_][0], 0, acc_); PG_DOT(ub[e_][1], 8, acc_); a_[e_] = acc_.x + acc_.y - xs128; } \
        if (more) PG_ISSUE_U((grp) + 1); \
        float s0_ = hi32 ? a_[0] : a_[2], s1_ = hi32 ? a_[1] : a_[3], k0_ = hi32 ? a_[2] : a_[0], k1_ = hi32 ? a_[3] : a_[1]; \
        k0_ += __shfl_xor(s0_, 32); k1_ += __shfl_xor(s1_, 32); \
        float sd_ = hi16 ? k0_ : k1_, kk_ = hi16 ? k1_ : k0_; kk_ += __shfl_xor(sd_, 16); \
        kk_ += __shfl_xor(kk_, 8); kk_ += __shfl_xor(kk_, 4); kk_ += __shfl_xor(kk_, 2); kk_ += __shfl_xor(kk_, 1); \
        const int ow_ = (4 * (grp) + (lane >> 4)) & 63; const float su_ = __shfl((grp) < 16 ? su0 : su1, ow_), sv_ = __shfl((grp) < 16 ? sv0 : sv1, ow_); \
        const float hid_ = su_ * kk_; const float wv_ = sv_ * (0.5f * hid_ * (1.f + erff(hid_ * 0.70710678f))); \
        _Pragma("unroll") for (int e_ = 0; e_ < 4; ++e_) { const float we_ = __uint_as_float((unsigned)__builtin_amdgcn_readlane((int)__float_as_uint(wv_), 16 * e_)); wsum += we_; PG_AXPY(vb[e_][0], 0, we_); PG_AXPY(vb[e_][1], 8, we_); } \
        if (more) PG_ISSUE_V((grp) + 1); } while (0)
DEV void peer_gather_tok(const bf16* __restrict__ H1, int id0, int id1, float gp0, float gp1, const unsigned char* __restrict__ U8, const unsigned char* __restrict__ V8,
                         const float* __restrict__ RSU, const float* __restrict__ RSV, const bf16* __restrict__ PLEB, const float* lg, const float* lb, float* __restrict__ out, int tok, int lane) {
    const bool hi32 = (lane & 32) != 0, hi16 = (lane & 16) != 0;
    f32x2_ x2[16], y2[16];
#pragma unroll
    for (int j = 0; j < 2; ++j)
#pragma unroll
        for (int hh = 0; hh < 2; ++hh) { const uint4 w = *(const uint4*)(H1 + (size_t)tok * 2048 + 1024 * j + 16 * lane + 8 * hh); const unsigned q[4] = {w.x, w.y, w.z, w.w};
#pragma unroll
            for (int k = 0; k < 4; ++k) { x2[8 * j + 4 * hh + k] = (f32x2_){__uint_as_float(q[k] << 16), __uint_as_float(q[k] & 0xffff0000u)}; } }
#pragma unroll
    for (int k = 0; k < 16; ++k) y2[k] = (f32x2_){0.f, 0.f};
    const float su0 = RSU[id0], su1 = RSU[id1], sv0 = RSV[id0] * gp0, sv1 = RSV[id1] * gp1;
    float xs128 = 0.f, wsum = 0.f;
#pragma unroll
    for (int k = 0; k < 16; ++k) xs128 += x2[k].x + x2[k].y;
    xs128 *= 128.f;
    uint4 ub[4][2], vb[4][2];
    PG_ISSUE_U(0); PG_ISSUE_V(0);
    for (int g = 0; g < 31; ++g) PG_GROUP(g, true);
    PG_GROUP(31, false);
    wsum *= 128.f;
#pragma unroll
    for (int k = 0; k < 16; ++k) y2[k] -= wsum;
    asm volatile("" : "+s"(lg), "+s"(lb));
    float s = 0.f;
#pragma unroll
    for (int j = 0; j < 2; ++j)
#pragma unroll
        for (int hh = 0; hh < 2; ++hh) { const uint4 w = *(const uint4*)(PLEB + (size_t)tok * 2048 + 1024 * j + 16 * lane + 8 * hh); const unsigned q[4] = {w.x, w.y, w.z, w.w};
#pragma unroll
            for (int k = 0; k < 4; ++k) { const int ix = 8 * j + 4 * hh + k; y2[ix] += x2[ix] * ALPHA + (f32x2_){__uint_as_float(q[k] << 16), __uint_as_float(q[k] & 0xffff0000u)}; s += y2[ix].x + y2[ix].y; } }
    const float mean = wave_sum(s) * (1.f / D); float q = 0.f;
#pragma unroll
    for (int k = 0; k < 16; ++k) { y2[k] -= mean; q += y2[k].x * y2[k].x + y2[k].y * y2[k].y; }
    const float rstd = rsqrtf(wave_sum(q) * (1.f / D) + LN_EPS);
#pragma unroll
    for (int j = 0; j < 2; ++j)
#pragma unroll
        for (int k = 0; k < 4; ++k) { const int c = 1024 * j + 16 * lane + 4 * k; const float4 gg = *(const float4*)(lg + c), bb = *(const float4*)(lb + c); const f32x2_ a = y2[8 * j + 2 * k], b = y2[8 * j + 2 * k + 1];
            float4 o; o.x = a.x * rstd * gg.x + bb.x; o.y = a.y * rstd * gg.y + bb.y; o.z = b.x * rstd * gg.z + bb.z; o.w = b.y * rstd * gg.w + bb.w; *(float4*)(out + (size_t)tok * 2048 + c) = o; }
}

typedef short bf16x8_ __attribute__((ext_vector_type(8)));
typedef float f32x4_ __attribute__((ext_vector_type(4)));
#define LASF __attribute__((address_space(3)))
constexpr int GP_ROW = 528;
constexpr int GP_QD = 0, GP_KI = 64 * GP_ROW, GP_KS = 2 * 64 * GP_ROW, GP_LR = 3 * 64 * GP_ROW, GP_SX = GP_LR + 4096;
typedef __bf16 bf16x2_t_ __attribute__((ext_vector_type(2)));
DEV unsigned cvtpk(float lo, float hi) { const f32x2_ v = {lo, hi}; return __builtin_bit_cast(unsigned, __builtin_convertvector(v, bf16x2_t_)); }
DEV void gla_pre_item(LASF unsigned char* lds, const bf16* __restrict__ GQK, const bf16* __restrict__ LR, const float* __restrict__ up, const float* __restrict__ bias,
                      bf16* __restrict__ QD, bf16* __restrict__ KST, bf16* __restrict__ ATT, float* __restrict__ DEC, int b, int h, int n, int dir, int tid) {
    const int k = tid & 255, ch = tid >> 8, tok0 = b * 2048 + n * 64, cidx = (b * 4 + h) * 32 + n, lane = tid & 63, wave = tid >> 6, fr = lane & 15, g = lane >> 4;
    LASF float* LRs = (LASF float*)(lds + GP_LR); LASF float* Sx = (LASF float*)(lds + GP_SX);
    for (int i = tid; i < 64 * 16; i += 512) LRs[i] = bf2f(LR[(size_t)(tok0 + (i >> 4)) * 256 + dir * 16 + (i & 15)]);
    float upr[16];
#pragma unroll
    for (int r = 0; r < 16; ++r) upr[r] = up[r * 1024 + h * 256 + k];
    const float bs = bias[h * 256 + k];
    __syncthreads();
    float S = 0.f, la[32];
#pragma unroll
    for (int cc = 0; cc < 32; ++cc) { const int c = dir ? 32 * ch + 31 - cc : 32 * ch + cc; float gk = bs;
#pragma unroll
        for (int r4 = 0; r4 < 4; ++r4) { const f32x4_ l4 = *(const LASF f32x4_*)(LRs + c * 16 + 4 * r4); gk += l4[0] * upr[4 * r4] + l4[1] * upr[4 * r4 + 1] + l4[2] * upr[4 * r4 + 2] + l4[3] * upr[4 * r4 + 3]; }
        la[cc] = (fminf(gk, 0.f) - __logf(1.f + __expf(-fabsf(gk)))) * (1.f / 16.f); S += la[cc]; }
    Sx[ch * 256 + k] = S;
    __syncthreads();
    const float Sother = Sx[(1 - ch) * 256 + k], btot = S + Sother, ebt = __expf(btot);
    float cum = (dir ? (ch == 0) : (ch == 1)) ? Sother : 0.f;
#pragma unroll
    for (int cc = 0; cc < 32; ++cc) { const int c = dir ? 32 * ch + 31 - cc : 32 * ch + cc;
        cum += la[cc];
        const size_t tr = (size_t)(tok0 + c) * 2048 + h * 256 + k; const float q = bf2f(GQK[tr]), kk = bf2f(GQK[tr + 1024]);
        const float e = __expf(cum), ie = __builtin_amdgcn_rcpf(e);
        const bf16 qd = f2bf(q * e), ki = f2bf(kk * ie), ks = f2bf(kk * ie * ebt);
        *(LASF bf16*)(lds + GP_QD + c * GP_ROW + k * 2) = qd; *(LASF bf16*)(lds + GP_KI + c * GP_ROW + k * 2) = ki; *(LASF bf16*)(lds + GP_KS + c * GP_ROW + k * 2) = ks;
        QD[(size_t)(tok0 + c) * 1024 + h * 256 + k] = qd; }
    if (ch == 0) DEC[(size_t)cidx * 256 + k] = ebt;
    __syncthreads();
    { const int ti = wave >> 1, tj0 = 2 * (wave & 1);
#pragma unroll
      for (int u = 0; u < 2; ++u) { const int tj = tj0 + u; f32x4_ acc = {0.f, 0.f, 0.f, 0.f};
        if (dir ? (tj >= ti) : (tj <= ti)) {
#pragma unroll
            for (int s8 = 0; s8 < 8; ++s8) { const bf16x8_ a = *(const LASF bf16x8_*)(lds + GP_QD + (16 * ti + fr) * GP_ROW + 64 * s8 + 16 * g), bq = *(const LASF bf16x8_*)(lds + GP_KI + (16 * tj + fr) * GP_ROW + 64 * s8 + 16 * g);
                acc = __builtin_amdgcn_mfma_f32_16x16x32_bf16(a, bq, acc, 0, 0, 0); } }
#pragma unroll
        for (int r = 0; r < 4; ++r) { const int i = 16 * ti + 4 * g + r, j = 16 * tj + fr; const bool keep = dir ? (j > i) : (j <= i);
            ATT[(size_t)cidx * 4096 + i * 64 + j] = f2bf(keep ? acc[r] : 0.f); } } }
#pragma unroll
    for (int qq = 0; qq < 4; ++qq) { const int c0 = 8 * (ch * 4 + qq); unsigned short v[8];
#pragma unroll
        for (int jj = 0; jj < 8; ++jj) v[jj] = *(const LASF bf16*)(lds + GP_KS + (c0 + jj) * GP_ROW + k * 2);
        uint4 o; o.x = v[0] | ((unsigned)v[1] << 16); o.y = v[2] | ((unsigned)v[3] << 16); o.z = v[4] | ((unsigned)v[5] << 16); o.w = v[6] | ((unsigned)v[7] << 16);
        *(uint4*)(KST + ((size_t)cidx * 256 + k) * 64 + c0) = o; }
    __syncthreads();
}
typedef unsigned u32x4_ __attribute__((ext_vector_type(4)));
typedef unsigned u32x2_ __attribute__((ext_vector_type(2)));
constexpr int S2_QT = 0, S2_KT = 64 * 528, S2_VT = S2_KT + 256 * 144, S2_AT = S2_VT + 64 * 144, S2_DC = S2_AT + 64 * 144, S2_P = S2_DC + 1024, S2_PW = 32 * 144;
#define S2_BAR() do { asm volatile("s_waitcnt lgkmcnt(0)" ::: "memory"); __builtin_amdgcn_s_barrier(); asm volatile("" ::: "memory"); } while (0)
DEV void gla_scan_item(LASF unsigned char* lds, const bf16* __restrict__ QD, const bf16* __restrict__ KST, const bf16* __restrict__ ATT, const float* __restrict__ DEC, const bf16* __restrict__ VT,
                       bf16* __restrict__ O, int b, int h, int dir, int sl, int tid) {
    const int lane = tid & 63, wave = __builtin_amdgcn_readfirstlane(tid >> 6), fr = lane & 15, g = lane >> 4, kq = wave >> 1, dh = wave & 1;
    f32x4_ st[4][2];
#pragma unroll
    for (int i = 0; i < 4; ++i)
#pragma unroll
        for (int t = 0; t < 2; ++t) st[i][t] = (f32x4_){0.f, 0.f, 0.f, 0.f};
    u32x4_ sq[4], sk[4], sv, sa, sd = {0u, 0u, 0u, 0u};
#define S2_ISSUE(nn) do { const size_t ci_ = (size_t)((b * 4 + h) * 32 + (nn)); const size_t t0_ = (size_t)b * 2048 + (nn) * 64; \
        _Pragma("unroll") for (int j = 0; j < 4; ++j) { const int ix_ = tid + 512 * j; sq[j] = *(const u32x4_*)(QD + (t0_ + (ix_ >> 5)) * 1024 + h * 256 + (ix_ & 31) * 8); } \
        _Pragma("unroll") for (int j = 0; j < 4; ++j) { const int ix_ = tid + 512 * j; sk[j] = *(const u32x4_*)(KST + (ci_ * 256 + (ix_ >> 3)) * 64 + (ix_ & 7) * 8); } \
        sv = *(const u32x4_*)(VT + (size_t)(1024 + h * 512 + sl * 64 + (tid >> 3)) * T + t0_ + (tid & 7) * 8); sa = *(const u32x4_*)(ATT + ci_ * 4096 + (tid >> 3) * 64 + (tid & 7) * 8); \
        sd = *(const u32x4_*)(DEC + ci_ * 256 + (tid & 63) * 4); } while (0)
#define S2_COMMIT() do { \
        _Pragma("unroll") for (int j = 0; j < 4; ++j) { const int ix_ = tid + 512 * j; *(LASF u32x4_*)(lds + S2_QT + (ix_ >> 5) * 528 + (ix_ & 31) * 16) = sq[j]; *(LASF u32x4_*)(lds + S2_KT + (ix_ >> 3) * 144 + (ix_ & 7) * 16) = sk[j]; } \
        *(LASF u32x4_*)(lds + S2_VT + (tid >> 3) * 144 + (tid & 7) * 16) = sv; *(LASF u32x4_*)(lds + S2_AT + (tid >> 3) * 144 + (tid & 7) * 16) = sa; \
        if (tid < 64) *(LASF u32x4_*)(lds + S2_DC + tid * 16) = sd; } while (0)
    { const int n0 = dir ? 31 : 0; S2_ISSUE(n0); S2_COMMIT(); S2_BAR(); }
    for (int step = 0; step < 32; ++step) {
        const int n = dir ? 31 - step : step, nn = dir ? (n > 0 ? n - 1 : 0) : (n < 31 ? n + 1 : 31);
        S2_ISSUE(nn);
        f32x4_ po[4][2];
        { bf16x8_ bs_[2][2];
#pragma unroll
          for (int t = 0; t < 2; ++t)
#pragma unroll
            for (int s_ = 0; s_ < 2; ++s_) { uint4 w; w.x = cvtpk(st[2 * s_][t][0], st[2 * s_][t][1]); w.y = cvtpk(st[2 * s_][t][2], st[2 * s_][t][3]); w.z = cvtpk(st[2 * s_ + 1][t][0], st[2 * s_ + 1][t][1]); w.w = cvtpk(st[2 * s_ + 1][t][2], st[2 * s_ + 1][t][3]); bs_[t][s_] = __builtin_bit_cast(bf16x8_, w); }
#pragma unroll
          for (int m = 0; m < 4; ++m) { bf16x8_ qa_[2];
#pragma unroll
            for (int s_ = 0; s_ < 2; ++s_) { const LASF unsigned char* qp_ = lds + S2_QT + (16 * m + fr) * 528 + (kq * 64 + 32 * s_ + 4 * g) * 2; const u32x2_ lo = *(const LASF u32x2_*)qp_, hi = *(const LASF u32x2_*)(qp_ + 32);
                uint4 w; w.x = lo.x; w.y = lo.y; w.z = hi.x; w.w = hi.y; qa_[s_] = __builtin_bit_cast(bf16x8_, w); }
#pragma unroll
            for (int t = 0; t < 2; ++t) { f32x4_ a = {0.f, 0.f, 0.f, 0.f}; a = __builtin_amdgcn_mfma_f32_16x16x32_bf16(qa_[0], bs_[t][0], a, 0, 0, 0); a = __builtin_amdgcn_mfma_f32_16x16x32_bf16(qa_[1], bs_[t][1], a, 0, 0, 0); po[m][t] = a; } } }
#pragma unroll
        for (int m = 0; m < 4; ++m)
#pragma unroll
            for (int t = 0; t < 2; ++t) { u32x2_ w; w.x = cvtpk(po[m][t][0], po[m][t][1]); w.y = cvtpk(po[m][t][2], po[m][t][3]); *(LASF u32x2_*)(lds + S2_P + wave * S2_PW + (16 * t + fr) * 144 + (16 * m + 4 * g) * 2) = w; }
        S2_BAR();
        bf16x8_ vb[2][2];
#pragma unroll
        for (int t = 0; t < 2; ++t)
#pragma unroll
            for (int s2 = 0; s2 < 2; ++s2) vb[t][s2] = *(const LASF bf16x8_*)(lds + S2_VT + (dh * 32 + 16 * t + fr) * 144 + (32 * s2 + 8 * g) * 2);
        { const bf16x8_ aa0 = *(const LASF bf16x8_*)(lds + S2_AT + (16 * kq + fr) * 144 + (8 * g) * 2), aa1 = *(const LASF bf16x8_*)(lds + S2_AT + (16 * kq + fr) * 144 + (32 + 8 * g) * 2);
#pragma unroll
          for (int t = 0; t < 2; ++t) { f32x4_ a = {0.f, 0.f, 0.f, 0.f};
#pragma unroll
            for (int w4 = 0; w4 < 4; ++w4) { const u32x2_ pw = *(const LASF u32x2_*)(lds + S2_P + (2 * w4 + dh) * S2_PW + (16 * t + fr) * 144 + (16 * kq + 4 * g) * 2);
                a[0] += __uint_as_float(pw.x << 16); a[1] += __uint_as_float(pw.x & 0xffff0000u); a[2] += __uint_as_float(pw.y << 16); a[3] += __uint_as_float(pw.y & 0xffff0000u); }
            a = __builtin_amdgcn_mfma_f32_16x16x32_bf16(aa0, vb[t][0], a, 0, 0, 0); a = __builtin_amdgcn_mfma_f32_16x16x32_bf16(aa1, vb[t][1], a, 0, 0, 0);
#pragma unroll
            for (int r = 0; r < 4; ++r) O[(size_t)(b * 2048 + n * 64 + 16 * kq + 4 * g + r) * 2048 + h * 512 + sl * 64 + dh * 32 + 16 * t + fr] = f2bf(a[r]); } }
#pragma unroll
        for (int i = 0; i < 4; ++i) { const f32x4_ dc = *(const LASF f32x4_*)(lds + S2_DC + (kq * 64 + 16 * i + 4 * g) * 4);
            const bf16x8_ ka0 = *(const LASF bf16x8_*)(lds + S2_KT + (kq * 64 + 16 * i + fr) * 144 + (8 * g) * 2), ka1 = *(const LASF bf16x8_*)(lds + S2_KT + (kq * 64 + 16 * i + fr) * 144 + (32 + 8 * g) * 2);
#pragma unroll
            for (int t = 0; t < 2; ++t) { f32x4_ a = st[i][t] * dc; a = __builtin_amdgcn_mfma_f32_16x16x32_bf16(ka0, vb[t][0], a, 0, 0, 0); a = __builtin_amdgcn_mfma_f32_16x16x32_bf16(ka1, vb[t][1], a, 0, 0, 0); st[i][t] = a; } }
        S2_BAR();
        asm volatile("s_waitcnt vmcnt(0)" ::: "memory");
        S2_COMMIT();
        S2_BAR();
    }
#undef S2_ISSUE
#undef S2_COMMIT
}

DEV void na_task(const bf16* __restrict__ NAQK, const bf16* __restrict__ VT, const float* __restrict__ rpb, bf16* __restrict__ YNA, int task, int lane) {
    const int w = task & 3, r = (task >> 2) & 31, h = (task >> 7) & 15, b = task >> 11, fr = lane & 15, g = lane >> 4;
    const int r0 = min(max(r - WIN_R / 2, 0), ROWS - WIN_R), cs = min(max(16 * w - 8, 0), GRID_W - 32), qc = 16 * w + fr, c0 = min(max(qc - WIN_C / 2, 0), GRID_W - WIN_C);
    const size_t tokq = (size_t)b * 2048 + r * 64 + qc;
    const bf16x8_ q0 = *(const bf16x8_*)(NAQK + tokq * 2048 + h * 64 + 8 * g), q1 = *(const bf16x8_*)(NAQK + tokq * 2048 + h * 64 + 32 + 8 * g);
    bf16x8_ kf[8][2][2];
#pragma unroll
    for (int i = 0; i < 8; ++i)
#pragma unroll
        for (int ct = 0; ct < 2; ++ct) { const bf16* kp = NAQK + ((size_t)b * 2048 + (r0 + i) * 64 + cs + 16 * ct + fr) * 2048 + 1024 + h * 64 + 8 * g; kf[i][ct][0] = *(const bf16x8_*)kp; kf[i][ct][1] = *(const bf16x8_*)(kp + 32); }
    __builtin_amdgcn_sched_barrier(0);
    f32x4_ sc[8][2];
#pragma unroll
    for (int i = 0; i < 8; ++i)
#pragma unroll
        for (int ct = 0; ct < 2; ++ct) { f32x4_ a = {0.f, 0.f, 0.f, 0.f}; a = __builtin_amdgcn_mfma_f32_16x16x32_bf16(kf[i][ct][0], q0, a, 0, 0, 0); a = __builtin_amdgcn_mfma_f32_16x16x32_bf16(kf[i][ct][1], q1, a, 0, 0, 0); sc[i][ct] = a; }
    __builtin_amdgcn_sched_barrier(0);
    float bs[8][2][4]; uint2 va[4][4][2], vc[4][4][2];
#pragma unroll
    for (int i = 0; i < 8; ++i)
#pragma unroll
        for (int ct = 0; ct < 2; ++ct)
#pragma unroll
            for (int rg = 0; rg < 4; ++rg) bs[i][ct][rg] = rpb[(h * 15 + (r0 + i - r + WIN_R - 1)) * 31 + min(max(cs + 16 * ct + 4 * g + rg - qc + WIN_C - 1, 0), 30)];
#define NA_LDV(dst, ibase) do { _Pragma("unroll") for (int i_ = 0; i_ < 4; ++i_) _Pragma("unroll") for (int mt = 0; mt < 4; ++mt) { \
        const bf16* vp_ = VT + (size_t)(h * 64 + 16 * mt + fr) * T + (size_t)b * 2048 + (r0 + (ibase) + i_) * 64 + cs + 4 * g; dst[i_][mt][0] = *(const uint2*)vp_; dst[i_][mt][1] = *(const uint2*)(vp_ + 16); } } while (0)
    NA_LDV(va, 0);
    __builtin_amdgcn_sched_barrier(0);
    float mx = -3.0e38f;
#pragma unroll
    for (int i = 0; i < 8; ++i)
#pragma unroll
        for (int ct = 0; ct < 2; ++ct)
#pragma unroll
            for (int rg = 0; rg < 4; ++rg) { const int kc = cs + 16 * ct + 4 * g + rg; const bool valid = (kc >= c0) && (kc < c0 + WIN_C);
                const float v = valid ? sc[i][ct][rg] + bs[i][ct][rg] : -3.0e38f; sc[i][ct][rg] = v; mx = fmaxf(mx, v); }
    mx = fmaxf(mx, __shfl_xor(mx, 16)); mx = fmaxf(mx, __shfl_xor(mx, 32));
    NA_LDV(vc, 4);
    __builtin_amdgcn_sched_barrier(0);
    float sum = 0.f;
#pragma unroll
    for (int i = 0; i < 8; ++i)
#pragma unroll
        for (int ct = 0; ct < 2; ++ct)
#pragma unroll
            for (int rg = 0; rg < 4; ++rg) { const float p = sc[i][ct][rg] > -1.0e38f ? __expf(sc[i][ct][rg] - mx) : 0.f; sc[i][ct][rg] = p; sum += p; }
    sum += __shfl_xor(sum, 16); sum += __shfl_xor(sum, 32);
    f32x4_ o[4];
#pragma unroll
    for (int mt = 0; mt < 4; ++mt) o[mt] = (f32x4_){0.f, 0.f, 0.f, 0.f};
#define NA_PV(src, ibase) do { _Pragma("unroll") for (int i_ = 0; i_ < 4; ++i_) { const int i = (ibase) + i_; uint4 pw; pw.x = cvtpk(sc[i][0][0], sc[i][0][1]); pw.y = cvtpk(sc[i][0][2], sc[i][0][3]); pw.z = cvtpk(sc[i][1][0], sc[i][1][1]); pw.w = cvtpk(sc[i][1][2], sc[i][1][3]); \
        const bf16x8_ pb = __builtin_bit_cast(bf16x8_, pw); \
        _Pragma("unroll") for (int mt = 0; mt < 4; ++mt) { uint4 aw; aw.x = src[i_][mt][0].x; aw.y = src[i_][mt][0].y; aw.z = src[i_][mt][1].x; aw.w = src[i_][mt][1].y; \
            o[mt] = __builtin_amdgcn_mfma_f32_16x16x32_bf16(__builtin_bit_cast(bf16x8_, aw), pb, o[mt], 0, 0, 0); } } } while (0)
    NA_PV(va, 0); NA_PV(vc, 4);
#undef NA_LDV
#undef NA_PV
    const float inv = 1.f / sum;
#pragma unroll
    for (int mt = 0; mt < 4; ++mt) { uint2 ow; ow.x = cvtpk(o[mt][0] * inv, o[mt][1] * inv); ow.y = cvtpk(o[mt][2] * inv, o[mt][3] * inv);
        *(uint2*)(YNA + tokq * 1024 + h * 64 + 16 * mt + 4 * g) = ow; }
}

constexpr int NA_KROW = 64 * 144, NA_K = 0, NA_V = 8 * NA_KROW, NA_VP = 1040, NA_BT = NA_V + 64 * NA_VP, NA_EX = NA_BT + 1872;
DEV void na_item(LASF unsigned char* lds, const bf16* __restrict__ NAQK, const bf16* __restrict__ VT, const float* __restrict__ rpb, bf16* __restrict__ YNA, int b, int h, int rb, int tid) {
    const int lane = tid & 63, wave = __builtin_amdgcn_readfirstlane(tid >> 6), fr = lane & 15, g = lane >> 4, w = wave >> 1, dhalf = wave & 1;
    const int cs = min(max(16 * w - 8, 0), GRID_W - 32), qc = 16 * w + fr, c0 = min(max(qc - WIN_C / 2, 0), GRID_W - WIN_C);
    LASF float* BT = (LASF float*)(lds + NA_BT);
    for (int i = tid; i < 15 * 31; i += 512) BT[i] = rpb[h * 465 + i];
    const int kkey = tid >> 3, kch = tid & 7;
#define NA_LDROW(kx, vx, row) do { kx = *(const u32x4_*)(NAQK + ((size_t)b * 2048 + (row) * 64 + kkey) * 2048 + 1024 + h * 64 + kch * 8); vx = *(const u32x4_*)(VT + (size_t)(h * 64 + kkey) * T + (size_t)b * 2048 + (row) * 64 + kch * 8); } while (0)
#define NA_STROW(kx, vx, row) do { const int sl_ = (row) & 7; *(LASF u32x4_*)(lds + NA_K + sl_ * NA_KROW + kkey * 144 + kch * 16) = kx; *(LASF u32x4_*)(lds + NA_V + kkey * NA_VP + (sl_ * 64 + kch * 8) * 2) = vx; } while (0)
    { const int r0i = min(max(8 * rb - WIN_R / 2, 0), ROWS - WIN_R); u32x4_ k8[8], v8[8];
#pragma unroll
      for (int i = 0; i < 8; ++i) NA_LDROW(k8[i], v8[i], r0i + i);
#pragma unroll
      for (int i = 0; i < 8; ++i) NA_STROW(k8[i], v8[i], r0i + i); }
    size_t tokq = (size_t)b * 2048 + (8 * rb) * 64 + qc;
    bf16x8_ q0 = *(const bf16x8_*)(NAQK + tokq * 2048 + h * 64 + 8 * g), q1 = *(const bf16x8_*)(NAQK + tokq * 2048 + h * 64 + 32 + 8 * g);
    int bofs[2][4]; float mneg[2][4];
#pragma unroll
    for (int ct = 0; ct < 2; ++ct)
#pragma unroll
        for (int rg = 0; rg < 4; ++rg) { const int kc = cs + 16 * ct + 4 * g + rg; const bool valid = (kc >= c0) && (kc < c0 + WIN_C);
            bofs[ct][rg] = min(max(kc - qc + WIN_C - 1, 0), 30); mneg[ct][rg] = valid ? 0.f : -3.0e38f; }
    S2_BAR();
    for (int ri = 0; ri < 8; ++ri) {
        const int r = 8 * rb + ri, r0 = min(max(r - WIN_R / 2, 0), ROWS - WIN_R), r0n = min(max(r + 1 - WIN_R / 2, 0), ROWS - WIN_R);
        const bool more = ri < 7, newrow = more && (r0n != r0);
        u32x4_ kx = {0u, 0u, 0u, 0u}, vx = {0u, 0u, 0u, 0u}; bf16x8_ q0n = q0, q1n = q1;
        if (newrow) NA_LDROW(kx, vx, r0n + 7);
        if (more) { const size_t tn = tokq + 64; q0n = *(const bf16x8_*)(NAQK + tn * 2048 + h * 64 + 8 * g); q1n = *(const bf16x8_*)(NAQK + tn * 2048 + h * 64 + 32 + 8 * g); }
        const int i0 = 4 * dhalf;
        f32x4_ sc[4][2];
#pragma unroll
        for (int i = 0; i < 4; ++i)
#pragma unroll
            for (int ct = 0; ct < 2; ++ct) { const LASF unsigned char* kp = lds + NA_K + ((r0 + i0 + i) & 7) * NA_KROW + (cs + 16 * ct + fr) * 144 + 16 * g;
                f32x4_ a = {0.f, 0.f, 0.f, 0.f}; a = __builtin_amdgcn_mfma_f32_16x16x32_bf16(*(const LASF bf16x8_*)kp, q0, a, 0, 0, 0); a = __builtin_amdgcn_mfma_f32_16x16x32_bf16(*(const LASF bf16x8_*)(kp + 64), q1, a, 0, 0, 0); sc[i][ct] = a; }
        float mx = -3.0e38f;
#pragma unroll
        for (int i = 0; i < 4; ++i)
#pragma unroll
            for (int ct = 0; ct < 2; ++ct)
#pragma unroll
                for (int rg = 0; rg < 4; ++rg) { const float v = sc[i][ct][rg] + BT[(r0 + i0 + i - r + WIN_R - 1) * 31 + bofs[ct][rg]] + mneg[ct][rg]; sc[i][ct][rg] = v; mx = fmaxf(mx, v); }
        mx = fmaxf(mx, __shfl_xor(mx, 16)); mx = fmaxf(mx, __shfl_xor(mx, 32));
        float sum = 0.f;
#pragma unroll
        for (int i = 0; i < 4; ++i)
#pragma unroll
            for (int ct = 0; ct < 2; ++ct)
#pragma unroll
                for (int rg = 0; rg < 4; ++rg) { const float p = __builtin_amdgcn_exp2f((sc[i][ct][rg] - mx) * 1.44269504f); sc[i][ct][rg] = p; sum += p; }
        sum += __shfl_xor(sum, 16); sum += __shfl_xor(sum, 32);
        f32x4_ o[4] = {{0.f, 0.f, 0.f, 0.f}, {0.f, 0.f, 0.f, 0.f}, {0.f, 0.f, 0.f, 0.f}, {0.f, 0.f, 0.f, 0.f}};
#pragma unroll
        for (int i = 0; i < 4; ++i) { uint4 pw; pw.x = cvtpk(sc[i][0][0], sc[i][0][1]); pw.y = cvtpk(sc[i][0][2], sc[i][0][3]); pw.z = cvtpk(sc[i][1][0], sc[i][1][1]); pw.w = cvtpk(sc[i][1][2], sc[i][1][3]);
            const bf16x8_ pb = __builtin_bit_cast(bf16x8_, pw);
#pragma unroll
            for (int mm = 0; mm < 4; ++mm) { const LASF unsigned char* vp = lds + NA_V + (16 * ((2 * dhalf + mm) & 3) + fr) * NA_VP + ((((r0 + i0 + i) & 7) * 64) + cs + 4 * g) * 2;
                const u32x2_ lo = *(const LASF u32x2_*)vp, hi = *(const LASF u32x2_*)(vp + 32); uint4 vw; vw.x = lo.x; vw.y = lo.y; vw.z = hi.x; vw.w = hi.y;
                o[mm] = __builtin_amdgcn_mfma_f32_16x16x32_bf16(__builtin_bit_cast(bf16x8_, vw), pb, o[mm], 0, 0, 0); } }
        { LASF unsigned char* ex = lds + NA_EX + wave * 1152; const f32x4_ pa = o[2], pb2 = o[3];
          *(LASF u32x4_*)(ex + 16 * lane) = (u32x4_){cvtpk(pa[0], pa[1]), cvtpk(pa[2], pa[3]), cvtpk(pb2[0], pb2[1]), cvtpk(pb2[2], pb2[3])};
          if (g == 0) *(LASF f32x2_*)(ex + 1024 + 8 * fr) = (f32x2_){mx, sum}; }
        S2_BAR();
        if (newrow) NA_STROW(kx, vx, r0n + 7);
        { const LASF unsigned char* ex = lds + NA_EX + (wave ^ 1) * 1152; const u32x4_ pp = *(const LASF u32x4_*)(ex + 16 * lane); const f32x2_ ps = *(const LASF f32x2_*)(ex + 1024 + 8 * fr);
          const float M = fmaxf(mx, ps[0]), sw = __builtin_amdgcn_exp2f((mx - M) * 1.44269504f), sp = __builtin_amdgcn_exp2f((ps[0] - M) * 1.44269504f), inv = 1.f / (sum * sw + ps[1] * sp);
          const float cw = sw * inv, cp = sp * inv;
#pragma unroll
          for (int mm = 0; mm < 2; ++mm) { const f32x4_ ow_ = o[mm]; const unsigned p0 = pp[2 * mm], p1 = pp[2 * mm + 1];
              const float y0 = ow_[0] * cw + __uint_as_float(p0 << 16) * cp, y1 = ow_[1] * cw + __uint_as_float(p0 & 0xffff0000u) * cp, y2 = ow_[2] * cw + __uint_as_float(p1 << 16) * cp, y3 = ow_[3] * cw + __uint_as_float(p1 & 0xffff0000u) * cp;
              int ow = 0; ow = __builtin_amdgcn_cvt_pk_fp8_f32(y0, y1, ow, false); ow = __builtin_amdgcn_cvt_pk_fp8_f32(y2, y3, ow, true);
              *(int*)((unsigned char*)YNA + tokq * 1024 + h * 64 + 16 * (2 * dhalf + mm) + 4 * g) = ow; } }
        S2_BAR();
        q0 = q0n; q1 = q1n; tokq += 64;
    }
#undef NA_LDROW
#undef NA_STROW
}

DEV void gla_pre_block(LASF unsigned char* lds, const bf16* __restrict__ GQK, const bf16* __restrict__ LR, const float* __restrict__ upf, const float* __restrict__ bif, const float* __restrict__ upb, const float* __restrict__ bib,
                       bf16* __restrict__ QD0, bf16* __restrict__ KST0, bf16* __restrict__ ATT0, float* __restrict__ DEC0, int bx, int G, int tid) {
    const int k = tid & 255, ch = tid >> 8, lane = tid & 63, wave = tid >> 6, fr = lane & 15, g = lane >> 4;
    LASF float* LRs = (LASF float*)(lds + GP_LR); LASF float* Sx = (LASF float*)(lds + GP_SX);
    u32x4_ rq[4], rk[4], rl = {0u, 0u, 0u, 0u};
#define GPB_ISSUE(it_) do { const int dir_ = (it_) & 1, n_ = ((it_) >> 1) & 31, h_ = ((it_) >> 6) & 3, b_ = (it_) >> 8; const size_t t0_ = (size_t)b_ * 2048 + n_ * 64; \
        _Pragma("unroll") for (int j = 0; j < 4; ++j) { const int ix_ = tid + 512 * j; const bf16* p_ = GQK + (t0_ + (ix_ >> 5)) * 2048 + h_ * 256 + (ix_ & 31) * 8; rq[j] = *(const u32x4_*)p_; rk[j] = *(const u32x4_*)(p_ + 1024); } \
        if (tid < 128) rl = *(const u32x4_*)(LR + (t0_ + (tid >> 1)) * 256 + dir_ * 16 + (tid & 1) * 8); } while (0)
#define GPB_COMMIT() do { \
        _Pragma("unroll") for (int j = 0; j < 4; ++j) { const int ix_ = tid + 512 * j; *(LASF u32x4_*)(lds + GP_QD + (ix_ >> 5) * GP_ROW + (ix_ & 31) * 16) = rq[j]; *(LASF u32x4_*)(lds + GP_KI + (ix_ >> 5) * GP_ROW + (ix_ & 31) * 16) = rk[j]; } \
        if (tid < 128) { f32x4_ a_, b_; a_[0] = __uint_as_float(rl[0] << 16); a_[1] = __uint_as_float(rl[0] & 0xffff0000u); a_[2] = __uint_as_float(rl[1] << 16); a_[3] = __uint_as_float(rl[1] & 0xffff0000u); \
            b_[0] = __uint_as_float(rl[2] << 16); b_[1] = __uint_as_float(rl[2] & 0xffff0000u); b_[2] = __uint_as_float(rl[3] << 16); b_[3] = __uint_as_float(rl[3] & 0xffff0000u); \
            *(LASF f32x4_*)(LRs + (tid >> 1) * 16 + (tid & 1) * 8) = a_; *(LASF f32x4_*)(LRs + (tid >> 1) * 16 + (tid & 1) * 8 + 4) = b_; } } while (0)
    if (bx < 1024) GPB_ISSUE(bx);
    const int kp = tid & 127, qd = tid >> 7;
    int hd_cached = -1; float upr0[16], upr1[16], bs0 = 0.f, bs1 = 0.f;
#pragma unroll
    for (int r = 0; r < 16; ++r) { upr0[r] = 0.f; upr1[r] = 0.f; }
    for (int it = bx; it < 1024; it += G) {
        const int dir = it & 1, n = (it >> 1) & 31, h = (it >> 6) & 3, b = it >> 8, tok0 = b * 2048 + n * 64, cidx = (b * 4 + h) * 32 + n;
        bf16* QD = QD0 + (size_t)dir * T * 1024; bf16* KST = KST0 + (size_t)dir * 512 * 256 * 64; bf16* ATT = ATT0 + (size_t)dir * 512 * 4096; float* DEC = DEC0 + (size_t)dir * 512 * 256;
        if (hd_cached != h * 2 + dir) { const float* up = dir ? upb : upf; const float* bias = dir ? bib : bif; hd_cached = h * 2 + dir;
#pragma unroll
            for (int r = 0; r < 16; ++r) { const f32x2_ u2 = *(const f32x2_*)(up + r * 1024 + h * 256 + 2 * kp); upr0[r] = u2[0]; upr1[r] = u2[1]; }
            { const f32x2_ b2 = *(const f32x2_*)(bias + h * 256 + 2 * kp); bs0 = b2[0]; bs1 = b2[1]; } }
        GPB_COMMIT();
        S2_BAR();
        if (it + G < 1024) GPB_ISSUE(it + G);
        float S0 = 0.f, S1 = 0.f, la0[16], la1[16];
#pragma unroll
        for (int cc = 0; cc < 16; ++cc) { const int c = dir ? 16 * qd + 15 - cc : 16 * qd + cc; float g0 = bs0, g1 = bs1;
#pragma unroll
            for (int r4 = 0; r4 < 4; ++r4) { const f32x4_ l4 = *(const LASF f32x4_*)(LRs + c * 16 + 4 * r4);
                g0 += l4[0] * upr0[4 * r4] + l4[1] * upr0[4 * r4 + 1] + l4[2] * upr0[4 * r4 + 2] + l4[3] * upr0[4 * r4 + 3]; g1 += l4[0] * upr1[4 * r4] + l4[1] * upr1[4 * r4 + 1] + l4[2] * upr1[4 * r4 + 2] + l4[3] * upr1[4 * r4 + 3]; }
            la0[cc] = (fminf(g0, 0.f) - __logf(1.f + __expf(-fabsf(g0)))) * (1.f / 16.f); la1[cc] = (fminf(g1, 0.f) - __logf(1.f + __expf(-fabsf(g1)))) * (1.f / 16.f); S0 += la0[cc]; S1 += la1[cc]; }
        *(LASF f32x2_*)(Sx + qd * 256 + 2 * kp) = (f32x2_){S0, S1};
        S2_BAR();
        float cum0 = 0.f, cum1 = 0.f, bt0 = 0.f, bt1 = 0.f;
#pragma unroll
        for (int q4 = 0; q4 < 4; ++q4) { const f32x2_ sq_ = *(const LASF f32x2_*)(Sx + q4 * 256 + 2 * kp); bt0 += sq_[0]; bt1 += sq_[1];
            const bool before = dir ? (q4 > qd) : (q4 < qd); cum0 += before ? sq_[0] : 0.f; cum1 += before ? sq_[1] : 0.f; }
        const float ebt0 = __expf(bt0), ebt1 = __expf(bt1);
#pragma unroll
        for (int cc = 0; cc < 16; ++cc) { const int c = dir ? 16 * qd + 15 - cc : 16 * qd + cc;
            cum0 += la0[cc]; cum1 += la1[cc];
            LASF unsigned* qp = (LASF unsigned*)(lds + GP_QD + c * GP_ROW + kp * 4); LASF unsigned* kq_ = (LASF unsigned*)(lds + GP_KI + c * GP_ROW + kp * 4);
            const unsigned qw = *qp, kw = *kq_; const float q0 = __uint_as_float(qw << 16), q1 = __uint_as_float(qw & 0xffff0000u), k0 = __uint_as_float(kw << 16), k1 = __uint_as_float(kw & 0xffff0000u);
            const float e0 = __expf(cum0), e1 = __expf(cum1), i0 = __builtin_amdgcn_rcpf(e0), i1 = __builtin_amdgcn_rcpf(e1);
            *qp = cvtpk(q0 * e0, q1 * e1); *kq_ = cvtpk(k0 * i0, k1 * i1); *(LASF unsigned*)(lds + GP_KS + c * GP_ROW + kp * 4) = cvtpk(k0 * i0 * ebt0, k1 * i1 * ebt1); }
        if (qd == 0) *(f32x2_*)(DEC + (size_t)cidx * 256 + 2 * kp) = (f32x2_){ebt0, ebt1};
        S2_BAR();
        { const int ti = wave >> 1, tj0 = 2 * (wave & 1);
#pragma unroll
          for (int u = 0; u < 2; ++u) { const int tj = tj0 + u; f32x4_ acc = {0.f, 0.f, 0.f, 0.f};
            if (dir ? (tj >= ti) : (tj <= ti)) {
#pragma unroll
                for (int s8 = 0; s8 < 8; ++s8) { const bf16x8_ a = *(const LASF bf16x8_*)(lds + GP_QD + (16 * ti + fr) * GP_ROW + 64 * s8 + 16 * g), bq = *(const LASF bf16x8_*)(lds + GP_KI + (16 * tj + fr) * GP_ROW + 64 * s8 + 16 * g);
                    acc = __builtin_amdgcn_mfma_f32_16x16x32_bf16(a, bq, acc, 0, 0, 0); } }
#pragma unroll
            for (int r = 0; r < 4; ++r) { const int i = 16 * ti + 4 * g + r, j = 16 * tj + fr; const bool keep = dir ? (j > i) : (j <= i);
                ATT[(size_t)cidx * 4096 + i * 64 + j] = f2bf(keep ? acc[r] : 0.f); } } }
#pragma unroll
        for (int qq = 0; qq < 4; ++qq) { const int c0 = 8 * (ch * 4 + qq); unsigned short v[8];
#pragma unroll
            for (int jj = 0; jj < 8; ++jj) v[jj] = *(const LASF bf16*)(lds + GP_KS + (c0 + jj) * GP_ROW + k * 2);
            uint4 o; o.x = v[0] | ((unsigned)v[1] << 16); o.y = v[2] | ((unsigned)v[3] << 16); o.z = v[4] | ((unsigned)v[5] << 16); o.w = v[6] | ((unsigned)v[7] << 16);
            *(uint4*)(KST + ((size_t)cidx * 256 + k) * 64 + c0) = o; }
#pragma unroll
        for (int j = 0; j < 4; ++j) { const int ix_ = tid + 512 * j; const u32x4_ o = *(const LASF u32x4_*)(lds + GP_QD + (ix_ >> 5) * GP_ROW + (ix_ & 31) * 16); *(u32x4_*)(QD + (size_t)(tok0 + (ix_ >> 5)) * 1024 + h * 256 + (ix_ & 31) * 8) = o; }
        S2_BAR();
    }
#undef GPB_ISSUE
#undef GPB_COMMIT
}

struct __attribute__((aligned(4))) U3_ { unsigned a, b, c; };
DEV void q6_row(const float* __restrict__ src, unsigned char* __restrict__ dst, float* __restrict__ rs, int row, int lane) {
    const float4* sp = (const float4*)(src + (size_t)row * 2048 + 32 * lane); float4 v[8]; float m = 0.f;
#pragma unroll
    for (int j = 0; j < 8; ++j) { v[j] = sp[j]; m = fmaxf(fmaxf(m, fmaxf(fabsf(v[j].x), fabsf(v[j].y))), fmaxf(fabsf(v[j].z), fabsf(v[j].w))); }
    m = wave_max(m); const float inv = m > 0.f ? 31.f / m : 0.f;
    unsigned q[32];
#pragma unroll
    for (int j = 0; j < 8; ++j) { q[4 * j] = (unsigned)(__float2int_rn(v[j].x * inv) + 32); q[4 * j + 1] = (unsigned)(__float2int_rn(v[j].y * inv) + 32); q[4 * j + 2] = (unsigned)(__float2int_rn(v[j].z * inv) + 32); q[4 * j + 3] = (unsigned)(__float2int_rn(v[j].w * inv) + 32); }
#pragma unroll
    for (int t = 0; t < 2; ++t) { const unsigned* p = q + 16 * t; U3_ w;
        w.a = p[0] | (p[1] << 6) | (p[2] << 12) | (p[3] << 18) | (p[4] << 24) | (p[5] << 30);
        w.b = (p[5] >> 2) | (p[6] << 4) | (p[7] << 10) | (p[8] << 16) | (p[9] << 22) | (p[10] << 28);
        w.c = (p[10] >> 4) | (p[11] << 2) | (p[12] << 8) | (p[13] << 14) | (p[14] << 20) | (p[15] << 26);
        *(U3_*)(dst + (size_t)row * 1536 + 24 * lane + 12 * t) = w; }
    if (lane == 0) rs[row] = m * (1.f / 31.f);
}
#define Q6_DEC(T, f) do { const unsigned t0_ = (T).a, t1_ = (T).b, t2_ = (T).c; \
        f[0] = (f32x2_){(float)(t0_ & 63u), (float)((t0_ >> 6) & 63u)}; f[1] = (f32x2_){(float)((t0_ >> 12) & 63u), (float)((t0_ >> 18) & 63u)}; \
        f[2] = (f32x2_){(float)((t0_ >> 24) & 63u), (float)(__builtin_amdgcn_alignbit(t1_, t0_, 30) & 63u)}; f[3] = (f32x2_){(float)((t1_ >> 4) & 63u), (float)((t1_ >> 10) & 63u)}; \
        f[4] = (f32x2_){(float)((t1_ >> 16) & 63u), (float)((t1_ >> 22) & 63u)}; f[5] = (f32x2_){(float)(__builtin_amdgcn_alignbit(t2_, t1_, 28) & 63u), (float)((t2_ >> 2) & 63u)}; \
        f[6] = (f32x2_){(float)((t2_ >> 8) & 63u), (float)((t2_ >> 14) & 63u)}; f[7] = (f32x2_){(float)((t2_ >> 20) & 63u), (float)(t2_ >> 26)}; } while (0)
#define P6_ISSUE_U(grp) do { _Pragma("unroll") for (int e_ = 0; e_ < 8; ++e_) { const int ee_ = 8 * (grp) + e_; const int id_ = __builtin_amdgcn_readlane(ee_ < 64 ? id0 : id1, ee_ & 63); \
        const unsigned char* up_ = U6 + (size_t)id_ * 1536 + 24 * lane; ub[e_][0] = *(const U3_*)up_; ub[e_][1] = *(const U3_*)(up_ + 12); } } while (0)
#define P6_ISSUE_V(grp) do { _Pragma("unroll") for (int e_ = 0; e_ < 8; ++e_) { const int ee_ = 8 * (grp) + e_; const int id_ = __builtin_amdgcn_readlane(ee_ < 64 ? id0 : id1, ee_ & 63); \
        const unsigned char* vp_ = V6 + (size_t)id_ * 1536 + 24 * lane; vb[e_][0] = *(const U3_*)vp_; vb[e_][1] = *(const U3_*)(vp_ + 12); } } while (0)
#define P6_LANE_OF(e) (8 * (e))
#define P6_DPP(x, ctl) __builtin_bit_cast(float, __builtin_amdgcn_mov_dpp(__builtin_bit_cast(int, x), ctl, 0xf, 0xf, true))
#define P6_SW32(a, b) ({ const auto p_ = __builtin_amdgcn_permlane32_swap(__float_as_uint(a), __float_as_uint(b), false, false); __uint_as_float(p_[0]) + __uint_as_float(p_[1]); })
#define P6_SW16(a, b) ({ const auto p_ = __builtin_amdgcn_permlane16_swap(__float_as_uint(a), __float_as_uint(b), false, false); __uint_as_float(p_[0]) + __uint_as_float(p_[1]); })
#define P6_GROUP(grp, more) do { float a_[8]; \
        _Pragma("unroll") for (int e_ = 0; e_ < 8; ++e_) { f32x2_ acc_ = {0.f, 0.f}; \
            _Pragma("unroll") for (int t_ = 0; t_ < 2; ++t_) { f32x2_ f_[8]; Q6_DEC(ub[e_][t_], f_); _Pragma("unroll") for (int p_ = 0; p_ < 8; ++p_) acc_ += f_[p_] * x2[8 * t_ + p_]; } \
            a_[e_] = acc_.x + acc_.y - xs32; } \
        if (more) P6_ISSUE_U((grp) + 1); \
        const int ow_ = (8 * (grp) + (lane >> 3)) & 63; const float su_ = __shfl((grp) < 8 ? su0 : su1, ow_), sv_ = __shfl((grp) < 8 ? sv0 : sv1, ow_); \
          \
        const float h0_ = P6_SW32(a_[0], a_[4]), h1_ = P6_SW32(a_[1], a_[5]), h2_ = P6_SW32(a_[2], a_[6]), h3_ = P6_SW32(a_[3], a_[7]); \
          \
        const float r0_ = P6_SW16(h0_, h2_), r1_ = P6_SW16(h1_, h3_); \
          \
        const bool hi8_ = (lane & 8) != 0; const float keep_ = hi8_ ? r1_ : r0_, send_ = hi8_ ? r0_ : r1_; \
        float kk_ = keep_ + P6_DPP(send_, 0x128); \
        kk_ += P6_DPP(kk_, 0xB1); kk_ += P6_DPP(kk_, 0x4E); kk_ += P6_DPP(kk_, 0x141); \
        const float hid_ = su_ * kk_; const float wv_ = sv_ * (0.5f * hid_ * (1.f + erff(hid_ * 0.70710678f))); \
        _Pragma("unroll") for (int e_ = 0; e_ < 8; ++e_) { const float we_ = __uint_as_float((unsigned)__builtin_amdgcn_readlane((int)__float_as_uint(wv_), P6_LANE_OF(e_))); wsum += we_; \
            _Pragma("unroll") for (int t_ = 0; t_ < 2; ++t_) { f32x2_ f_[8]; Q6_DEC(vb[e_][t_], f_); _Pragma("unroll") for (int p_ = 0; p_ < 8; ++p_) y2[8 * t_ + p_] += f_[p_] * we_; } } \
        if (more) P6_ISSUE_V((grp) + 1); } while (0)
DEV void peer_gather_tok6(const bf16* __restrict__ H1, int id0, int id1, float gp0, float gp1, const unsigned char* __restrict__ U6, const unsigned char* __restrict__ V6,
                          const float* __restrict__ RSU, const float* __restrict__ RSV, const bf16* __restrict__ PLEB, const float* lg, const float* lb, float* __restrict__ out, int tok, int lane) {
    const bool hi32 = (lane & 32) != 0, hi16 = (lane & 16) != 0;
    f32x2_ x2[16], y2[16];
#pragma unroll
    for (int u = 0; u < 4; ++u) { const uint4 w = *(const uint4*)(H1 + (size_t)tok * 2048 + 32 * lane + 8 * u); const unsigned q[4] = {w.x, w.y, w.z, w.w};
#pragma unroll
        for (int k = 0; k < 4; ++k) x2[4 * u + k] = (f32x2_){__uint_as_float(q[k] << 16), __uint_as_float(q[k] & 0xffff0000u)}; }
#pragma unroll
    for (int k = 0; k < 16; ++k) y2[k] = (f32x2_){0.f, 0.f};
    const float su0 = RSU[id0], su1 = RSU[id1], sv0 = RSV[id0] * gp0, sv1 = RSV[id1] * gp1;
    float xs32 = 0.f, wsum = 0.f;
#pragma unroll
    for (int k = 0; k < 16; ++k) xs32 += x2[k].x + x2[k].y;
    xs32 *= 32.f;
    U3_ ub[8][2], vb[8][2];
    P6_ISSUE_U(0); P6_ISSUE_V(0);
    for (int g = 0; g < 15; ++g) P6_GROUP(g, true);
    P6_GROUP(15, false);
    wsum *= 32.f;
#pragma unroll
    for (int k = 0; k < 16; ++k) y2[k] -= wsum;
    asm volatile("" : "+s"(lg), "+s"(lb));
    float s = 0.f;
#pragma unroll
    for (int u = 0; u < 4; ++u) { const uint4 w = *(const uint4*)(PLEB + (size_t)tok * 2048 + 32 * lane + 8 * u); const unsigned q[4] = {w.x, w.y, w.z, w.w};
#pragma unroll
        for (int k = 0; k < 4; ++k) { const int ix = 4 * u + k; y2[ix] += x2[ix] * ALPHA + (f32x2_){__uint_as_float(q[k] << 16), __uint_as_float(q[k] & 0xffff0000u)}; s += y2[ix].x + y2[ix].y; } }
    const float mean = wave_sum(s) * (1.f / D); float q = 0.f;
#pragma unroll
    for (int k = 0; k < 16; ++k) { y2[k] -= mean; q += y2[k].x * y2[k].x + y2[k].y * y2[k].y; }
    const float rstd = rsqrtf(wave_sum(q) * (1.f / D) + LN_EPS);
#pragma unroll
    for (int k = 0; k < 8; ++k) { const int c = 32 * lane + 4 * k; const float4 gg = *(const float4*)(lg + c), bb = *(const float4*)(lb + c); const f32x2_ a = y2[2 * k], b = y2[2 * k + 1];
        float4 o; o.x = a.x * rstd * gg.x + bb.x; o.y = a.y * rstd * gg.y + bb.y; o.z = b.x * rstd * gg.z + bb.z; o.w = b.y * rstd * gg.w + bb.w; *(float4*)(out + (size_t)tok * 2048 + c) = o; }
}

#define FP4_LOW 3
template <bool VLAY> DEV void f6_row(const float* __restrict__ src, unsigned char* __restrict__ dst, unsigned char* __restrict__ dst4, float* __restrict__ rs, int row, int lane) {
    const float4* sp = (const float4*)(src + (size_t)row * 2048 + 32 * lane); float4 v[8]; float m = 0.f;
#pragma unroll
    for (int j = 0; j < 8; ++j) { v[j] = sp[j]; m = fmaxf(fmaxf(m, fmaxf(fabsf(v[j].x), fabsf(v[j].y))), fmaxf(fabsf(v[j].z), fabsf(v[j].w))); }
    m = wave_max(m); const float inv = m > 0.f ? 7.5f / m : 0.f;
    unsigned q[32];
#define F6_CODE(xv) ({ const float x_ = (xv); const float a_ = fabsf(x_) * inv; const float t_ = fminf(fminf(8.f * a_, 4.f * a_ + 8.f), 2.f * a_ + 16.f); \
        (__float_as_uint(t_ + 8388608.f) & 31u) | ((__float_as_uint(x_) >> 26) & 32u); })
#pragma unroll
    for (int j = 0; j < 8; ++j) { q[4 * j] = F6_CODE(v[j].x); q[4 * j + 1] = F6_CODE(v[j].y); q[4 * j + 2] = F6_CODE(v[j].z); q[4 * j + 3] = F6_CODE(v[j].w); }
#undef F6_CODE
    unsigned w6[6];
#pragma unroll
    for (int t = 0; t < 2; ++t) { const unsigned* p = q + 16 * t;
        w6[3 * t] = p[0] | (p[1] << 6) | (p[2] << 12) | (p[3] << 18) | (p[4] << 24) | (p[5] << 30);
        w6[3 * t + 1] = (p[5] >> 2) | (p[6] << 4) | (p[7] << 10) | (p[8] << 16) | (p[9] << 22) | (p[10] << 28);
        w6[3 * t + 2] = (p[10] >> 4) | (p[11] << 2) | (p[12] << 8) | (p[13] << 14) | (p[14] << 20) | (p[15] << 26); }
    unsigned char* rp = dst + (size_t)row * 1536;
    if (VLAY) { rp += 384 * (lane >> 4); *(u32x4_*)(rp + 16 * (lane & 15)) = (u32x4_){w6[0], w6[1], w6[2], w6[3]}; *(u32x2_*)(rp + 256 + 8 * (lane & 15)) = (u32x2_){w6[4], w6[5]}; }
    else { *(u32x4_*)(rp + 16 * lane) = (u32x4_){w6[0], w6[1], w6[2], w6[3]}; *(u32x2_*)(rp + 1024 + 8 * lane) = (u32x2_){w6[4], w6[5]}; }
    if (lane == 0) rs[row] = m * (1.f / 7.5f);
#if FP4_LOW
    { const float inv4 = m > 0.f ? 6.f / m : 0.f; unsigned w4[4];
#pragma unroll
      for (int j = 0; j < 4; ++j) { unsigned w = 0u;
          w = __builtin_amdgcn_cvt_scalef32_pk_fp4_f32(w, v[2 * j].x * inv4, v[2 * j].y * inv4, 1.0f, 0); w = __builtin_amdgcn_cvt_scalef32_pk_fp4_f32(w, v[2 * j].z * inv4, v[2 * j].w * inv4, 1.0f, 1);
          w = __builtin_amdgcn_cvt_scalef32_pk_fp4_f32(w, v[2 * j + 1].x * inv4, v[2 * j + 1].y * inv4, 1.0f, 2); w = __builtin_amdgcn_cvt_scalef32_pk_fp4_f32(w, v[2 * j + 1].z * inv4, v[2 * j + 1].w * inv4, 1.0f, 3); w4[j] = w; }
      *(u32x4_*)(dst4 + (size_t)row * 1024 + 16 * lane) = (u32x4_){w4[0], w4[1], w4[2], w4[3]};
      if (lane == 0) rs[PNK * PNK + row] = m * (1.f / 6.f); }
#endif
}
DEV void f4_row(const float* __restrict__ src, unsigned char* __restrict__ dst4, float* __restrict__ rs, int row, int lane) {
    const float4* sp = (const float4*)(src + (size_t)row * 2048 + 32 * lane); float4 v[8]; float q = 0.f;
#pragma unroll
    for (int j = 0; j < 8; ++j) { v[j] = sp[j]; q += (v[j].x * v[j].x + v[j].y * v[j].y) + (v[j].z * v[j].z + v[j].w * v[j].w); }
    const float rms = sqrtf(wave_sum(q) * (1.f / 2048.f)); const float inv4 = rms > 0.f ? 2.f / rms : 0.f; unsigned w4[4];
#pragma unroll
    for (int j = 0; j < 4; ++j) { unsigned w = 0u;
        w = __builtin_amdgcn_cvt_scalef32_pk_fp4_f32(w, v[2 * j].x * inv4, v[2 * j].y * inv4, 1.0f, 0); w = __builtin_amdgcn_cvt_scalef32_pk_fp4_f32(w, v[2 * j].z * inv4, v[2 * j].w * inv4, 1.0f, 1);
        w = __builtin_amdgcn_cvt_scalef32_pk_fp4_f32(w, v[2 * j + 1].x * inv4, v[2 * j + 1].y * inv4, 1.0f, 2); w = __builtin_amdgcn_cvt_scalef32_pk_fp4_f32(w, v[2 * j + 1].z * inv4, v[2 * j + 1].w * inv4, 1.0f, 3); w4[j] = w; }
    *(u32x4_*)(dst4 + (size_t)row * 1024 + 16 * lane) = (u32x4_){w4[0], w4[1], w4[2], w4[3]};
    if (lane == 0) rs[PNK * PNK + row] = rms * 0.5f;
}
struct R6_ { u32x4_ a; u32x2_ b; };
typedef int i32x8g_ __attribute__((ext_vector_type(8)));
#define M6_MFMA(a, b, c, sa) __builtin_amdgcn_mfma_scale_f32_16x16x128_f8f6f4(a, b, c, 2, 2, 0, sa, 0, 127)
#define M4_MFMA(a, b, c, sa) __builtin_amdgcn_mfma_scale_f32_16x16x128_f8f6f4(a, b, c, 2, 4, 0, sa, 0, 127)
#define M6_B(r) ((i32x8g_){(int)(r).a[0], (int)(r).a[1], (int)(r).a[2], (int)(r).a[3], (int)(r).b[0], (int)(r).b[1], 0, 0})
#define M4_B(r) ((i32x8g_){(int)(r).a[0], (int)(r).a[1], (int)(r).a[2], (int)(r).a[3], 0, 0, 0, 0})
#define M6_ISSUE_U(grp) do { _Pragma("unroll") for (int e_ = 0; e_ < 8; ++e_) { const int ee_ = 8 * (grp) + e_; const int id_ = __builtin_amdgcn_readlane(ee_ < 64 ? id0 : id1, ee_ & 63); \
        const unsigned char* up_ = U6 + (size_t)id_ * 1536; ub[e_].a = *(const u32x4_*)(up_ + 16 * lane); ub[e_].b = *(const u32x2_*)(up_ + 1024 + 8 * lane); } } while (0)
#define M6_ISSUE_V(grp) do { _Pragma("unroll") for (int q_ = 0; q_ < 2; ++q_) { const int idv_ = __shfl((grp) < 8 ? id0 : id1, (8 * (grp) + 4 * q_ + kg) & 63); \
        const unsigned char* vp_ = V6 + (unsigned)(idv_ * 1536 + n16); const unsigned char* vq_ = V6 + (unsigned)(idv_ * 1536 + 256 + n8); \
        _Pragma("unroll") for (int t_ = 0; t_ < 4; ++t_) { vb[q_][t_].a = *(const u32x4_*)(vp_ + 384 * t_); vb[q_][t_].b = *(const u32x2_*)(vq_ + 384 * t_); } } } while (0)
#define M4_ISSUE_U(grp) do { _Pragma("unroll") for (int e_ = 0; e_ < 8; ++e_) { const int ee_ = 8 * (grp) + e_; const int id_ = __builtin_amdgcn_readlane(ee_ < 64 ? id0 : id1, ee_ & 63); \
        ub[e_].a = *(const u32x4_*)(U4 + (size_t)id_ * 1024 + 16 * lane); } } while (0)
#define M4_ISSUE_V(grp) do { _Pragma("unroll") for (int q_ = 0; q_ < 2; ++q_) { const int idv_ = __shfl((grp) < 8 ? id0 : id1, (8 * (grp) + 4 * q_ + kg) & 63); \
        const unsigned char* vp_ = V4 + (unsigned)(idv_ * 1024 + n16); \
        _Pragma("unroll") for (int t_ = 0; t_ < 4; ++t_) vb[q_][t_].a = *(const u32x4_*)(vp_ + 256 * t_); } } while (0)
#define MQ_ISSUE_U(grp) do { _Pragma("unroll") for (int e_ = 0; e_ < 8; ++e_) { const int ee_ = 8 * (grp) + e_; const int id_ = __builtin_amdgcn_readlane(ee_ < 64 ? id0 : id1, ee_ & 63); \
        if (e_ < 4) { const unsigned char* up_ = U6 + (size_t)id_ * 1536; ub[e_].a = *(const u32x4_*)(up_ + 16 * lane); ub[e_].b = *(const u32x2_*)(up_ + 1024 + 8 * lane); } \
        else ub[e_].a = *(const u32x4_*)(U4 + (size_t)id_ * 1024 + 16 * lane); } } while (0)
#define MQ_ISSUE_V(grp) do { { const int idv_ = __shfl((grp) < 8 ? id0 : id1, (8 * (grp) + kg) & 63); \
        const unsigned char* vp_ = V6 + (unsigned)(idv_ * 1536 + n16); const unsigned char* vq_ = V6 + (unsigned)(idv_ * 1536 + 256 + n8); \
        _Pragma("unroll") for (int t_ = 0; t_ < 4; ++t_) { vb[0][t_].a = *(const u32x4_*)(vp_ + 384 * t_); vb[0][t_].b = *(const u32x2_*)(vq_ + 384 * t_); } } \
      { const int idv_ = __shfl((grp) < 8 ? id0 : id1, (8 * (grp) + 4 + kg) & 63); const unsigned char* vp_ = V4 + (unsigned)(idv_ * 1024 + n16); \
        _Pragma("unroll") for (int t_ = 0; t_ < 4; ++t_) vb[1][t_].a = *(const u32x4_*)(vp_ + 256 * t_); } } while (0)
#define MQ_U(e_) ((e_) < 4 ? M6_MFMA(xa, M6_B(ub[e_]), zero4, xsb) : M4_MFMA(xa, M4_B(ub[e_]), zero4, xsb))
#define MQ_V(q_, A_, t_, c_, s_) ((q_) == 0 ? M6_MFMA(A_, M6_B(vb[q_][t_]), c_, s_) : M4_MFMA(A_, M4_B(vb[q_][t_]), c_, s_))
#define M6_U(e_) M6_MFMA(xa, M6_B(ub[e_]), zero4, xsb)
#define M4_U(e_) M4_MFMA(xa, M4_B(ub[e_]), zero4, xsb)
#define M6_V(q_, A_, t_, c_, s_) M6_MFMA(A_, M6_B(vb[q_][t_]), c_, s_)
#define M4_V(q_, A_, t_, c_, s_) M4_MFMA(A_, M4_B(vb[q_][t_]), c_, s_)
#define MX_GROUP(grp, UOP, VOP, NEXT_U, NEXT_V) do { float a_[8]; \
        _Pragma("unroll") for (int e_ = 0; e_ < 8; ++e_) { const f32x4_ c_ = UOP(e_); \
            const float t0_ = lb0 ? c_[1] : c_[0], t1_ = lb0 ? c_[3] : c_[2]; const float s_ = lb1 ? t1_ : t0_; a_[e_] = dg ? s_ : 0.f; } \
        NEXT_U; \
        const int ow_ = (8 * (grp) + (lane >> 3)) & 63; const float su_ = __shfl((grp) < 8 ? su0 : su1, ow_), sv_ = __shfl((grp) < 8 ? sv0 : sv1, ow_); \
        const float h0_ = P6_SW32(a_[0], a_[4]), h1_ = P6_SW32(a_[1], a_[5]), h2_ = P6_SW32(a_[2], a_[6]), h3_ = P6_SW32(a_[3], a_[7]); \
        const float r0_ = P6_SW16(h0_, h2_), r1_ = P6_SW16(h1_, h3_); \
        const bool hi8_ = (lane & 8) != 0; const float keep_ = hi8_ ? r1_ : r0_, send_ = hi8_ ? r0_ : r1_; \
        float kk_ = keep_ + P6_DPP(send_, 0x128); \
        kk_ += P6_DPP(kk_, 0xB1); kk_ += P6_DPP(kk_, 0x4E); kk_ += P6_DPP(kk_, 0x141); \
        const float hid_ = su_ * kk_; const float wv_ = sv_ * (0.5f * hid_ * (1.f + erff(hid_ * 0.70710678f))); \
        _Pragma("unroll") for (int q_ = 0; q_ < 2; ++q_) { const float wq_ = __shfl(wv_, 32 * q_ + 8 * kg); \
            const unsigned wb_ = __float_as_uint(wq_), wr_ = wb_ + 0x00080000u; const int wsb_ = (int)((wr_ >> 23) & 255u); \
            const unsigned cd_ = 8u | ((wr_ >> 20) & 7u) | ((wb_ >> 26) & 32u); const unsigned lo_ = cd_ << wsh, hi_ = (cd_ >> 1) >> (31 - wsh); \
            const int a0_ = (int)(wrl == 0 ? lo_ : 0u), a1_ = (int)(wrl == 1 ? lo_ : (wrl == 0 ? hi_ : 0u)), a2_ = (int)(wrl == 2 ? lo_ : (wrl == 1 ? hi_ : 0u)); \
            const i32x8g_ A0_ = {a0_, a1_, a2_, 0, 0, 0, 0, 0}, A1_ = {0, 0, 0, a0_, a1_, a2_, 0, 0}; \
            _Pragma("unroll") for (int t_ = 0; t_ < 4; ++t_) { acc[t_][0] = VOP(q_, A0_, t_, acc[t_][0], wsb_); acc[t_][1] = VOP(q_, A1_, t_, acc[t_][1], wsb_); } } \
        NEXT_V; } while (0)
DEV void peer_gather_tokm(const bf16* __restrict__ H1, int id0, int id1, float gp0, float gp1, const unsigned char* __restrict__ U6, const unsigned char* __restrict__ V6,
                          const unsigned char* __restrict__ U4, const unsigned char* __restrict__ V4, const float* __restrict__ RSU, const float* __restrict__ RSV,
                          const bf16* __restrict__ PLEB, const float* lg, const float* lb, float* __restrict__ out, int tok, int lane) {
    const int kg = lane >> 4, n16 = (lane & 15) * 16, n8 = (lane & 15) * 8, r4 = (lane & 15) >> 2, wsh = (6 * (lane & 15)) & 31, wrl = (6 * (lane & 15)) >> 5;
    const bool lb0 = (lane & 1) != 0, lb1 = (lane & 2) != 0, dg = kg == r4;
    i32x8g_ xa; int xsb;
    { float xf[32]; float m = 0.f;
#pragma unroll
      for (int u = 0; u < 4; ++u) { const uint4 w = *(const uint4*)(H1 + (size_t)tok * 2048 + 32 * lane + 8 * u); const unsigned q[4] = {w.x, w.y, w.z, w.w};
#pragma unroll
          for (int k = 0; k < 4; ++k) { xf[8 * u + 2 * k] = __uint_as_float(q[k] << 16); xf[8 * u + 2 * k + 1] = __uint_as_float(q[k] & 0xffff0000u); m = fmaxf(m, fmaxf(fabsf(xf[8 * u + 2 * k]), fabsf(xf[8 * u + 2 * k + 1]))); } }
      const unsigned eb = (__float_as_uint(m * 1.0666667f) >> 23) & 255u; const bool ok = eb >= 3u;
      xsb = ok ? (int)eb - 2 : 0; const float inv = ok ? __uint_as_float((256u - eb) << 23) : 0.f;
      unsigned p[32];
#pragma unroll
      for (int i = 0; i < 32; ++i) { const float a = fabsf(xf[i]) * inv; const float t = fminf(fminf(8.f * a, 4.f * a + 8.f), 2.f * a + 16.f); p[i] = (__float_as_uint(t + 8388608.f) & 31u) | ((__float_as_uint(xf[i]) >> 26) & 32u); }
      unsigned w6[6];
#pragma unroll
      for (int t = 0; t < 2; ++t) { const unsigned* c = p + 16 * t;
          w6[3 * t] = c[0] | (c[1] << 6) | (c[2] << 12) | (c[3] << 18) | (c[4] << 24) | (c[5] << 30);
          w6[3 * t + 1] = (c[5] >> 2) | (c[6] << 4) | (c[7] << 10) | (c[8] << 16) | (c[9] << 22) | (c[10] << 28);
          w6[3 * t + 2] = (c[10] >> 4) | (c[11] << 2) | (c[12] << 8) | (c[13] << 14) | (c[14] << 20) | (c[15] << 26); }
      xa = (i32x8g_){(int)w6[0], (int)w6[1], (int)w6[2], (int)w6[3], (int)w6[4], (int)w6[5], 0, 0}; }
    const f32x4_ zero4 = {0.f, 0.f, 0.f, 0.f};
    f32x4_ acc[4][2];
#pragma unroll
    for (int t = 0; t < 4; ++t) { acc[t][0] = zero4; acc[t][1] = zero4; }
    const int so = (FP4_LOW == 1 && (lane & 8)) || (FP4_LOW == 2 && (lane & 12)) || FP4_LOW == 3 ? PNK * PNK : 0;
    const float su0 = RSU[id0 + so], su1 = RSU[id1 + so], sv0 = RSV[id0 + so] * gp0, sv1 = RSV[id1 + so] * gp1;
    R6_ ub[8], vb[2][4];
#if FP4_LOW == 1
    M6_ISSUE_U(0); M6_ISSUE_V(0);
    for (int g = 0; g < 14; g += 2) { MX_GROUP(g, M6_U, M6_V, M4_ISSUE_U(g + 1), M4_ISSUE_V(g + 1)); MX_GROUP(g + 1, M4_U, M4_V, M6_ISSUE_U(g + 2), M6_ISSUE_V(g + 2)); }
    MX_GROUP(14, M6_U, M6_V, M4_ISSUE_U(15), M4_ISSUE_V(15)); MX_GROUP(15, M4_U, M4_V, (void)0, (void)0);
#elif FP4_LOW == 2
    MQ_ISSUE_U(0); MQ_ISSUE_V(0);
    for (int g = 0; g < 14; g += 2) { MX_GROUP(g, MQ_U, MQ_V, M4_ISSUE_U(g + 1), M4_ISSUE_V(g + 1)); MX_GROUP(g + 1, M4_U, M4_V, MQ_ISSUE_U(g + 2), MQ_ISSUE_V(g + 2)); }
    MX_GROUP(14, MQ_U, MQ_V, M4_ISSUE_U(15), M4_ISSUE_V(15)); MX_GROUP(15, M4_U, M4_V, (void)0, (void)0);
#elif FP4_LOW == 3
    M4_ISSUE_U(0); M4_ISSUE_V(0);
    for (int g = 0; g < 14; ++g) MX_GROUP(g, M4_U, M4_V, M4_ISSUE_U(g + 1), M4_ISSUE_V(g + 1));
    MX_GROUP(14, M4_U, M4_V, M4_ISSUE_U(15), M4_ISSUE_V(15)); MX_GROUP(15, M4_U, M4_V, (void)0, (void)0);
#else
    M6_ISSUE_U(0); M6_ISSUE_V(0);
    for (int g = 0; g < 15; ++g) MX_GROUP(g, M6_U, M6_V, M6_ISSUE_U(g + 1), M6_ISSUE_V(g + 1));
    MX_GROUP(15, M6_U, M6_V, (void)0, (void)0);
#endif
    asm volatile("" : "+s"(lg), "+s"(lb));
    const int dl = 32 * (lane & 15) + 4 * kg; float s = 0.f;
#pragma unroll
    for (int t = 0; t < 4; ++t)
#pragma unroll
        for (int h = 0; h < 2; ++h) { const size_t o = (size_t)tok * 2048 + 512 * t + 16 * h + dl; const u32x2_ hw = *(const u32x2_*)(H1 + o), pw = *(const u32x2_*)(PLEB + o);
            f32x4_ y = acc[t][h];
            y[0] += __uint_as_float(hw.x << 16) * ALPHA + __uint_as_float(pw.x << 16); y[1] += __uint_as_float(hw.x & 0xffff0000u) * ALPHA + __uint_as_float(pw.x & 0xffff0000u);
            y[2] += __uint_as_float(hw.y << 16) * ALPHA + __uint_as_float(pw.y << 16); y[3] += __uint_as_float(hw.y & 0xffff0000u) * ALPHA + __uint_as_float(pw.y & 0xffff0000u);
            acc[t][h] = y; s += (y[0] + y[1]) + (y[2] + y[3]); }
    const float mean = wave_sum(s) * (1.f / D); float q = 0.f;
#pragma unroll
    for (int t = 0; t < 4; ++t)
#pragma unroll
        for (int h = 0; h < 2; ++h) { acc[t][h] -= mean; const f32x4_ y = acc[t][h]; q += (y[0] * y[0] + y[1] * y[1]) + (y[2] * y[2] + y[3] * y[3]); }
    const float rstd = rsqrtf(wave_sum(q) * (1.f / D) + LN_EPS);
#pragma unroll
    for (int t = 0; t < 4; ++t)
#pragma unroll
        for (int h = 0; h < 2; ++h) { const int c = 512 * t + 16 * h + dl; const f32x4_ gg = *(const f32x4_*)(lg + c), bb = *(const f32x4_*)(lb + c);
            *(f32x4_*)(out + (size_t)tok * 2048 + c) = acc[t][h] * rstd * gg + bb; }
}

constexpr int PS_ROW = 528, PS_IDS = 256 * PS_ROW, PS_GT = PS_IDS + 8192;
#define TOPK_INSERT(tv, ti, xv, xi) do { if ((xv) > tv[15]) { tv[15] = (xv); ti[15] = (xi); \
        _Pragma("unroll") for (int k_ = 15; k_ > 0; --k_) { const bool sw_ = tv[k_] > tv[k_ - 1]; const float fa_ = tv[k_ - 1], fb_ = tv[k_]; const int ia_ = ti[k_ - 1], ib_ = ti[k_]; \
            tv[k_ - 1] = sw_ ? fb_ : fa_; tv[k_] = sw_ ? fa_ : fb_; ti[k_ - 1] = sw_ ? ib_ : ia_; ti[k_] = sw_ ? ia_ : ib_; } } } while (0)
#define M4N_ISSUE_U(grp) do { _Pragma("unroll") for (int e_ = 0; e_ < 8; ++e_) { const int ee_ = 8 * (grp) + e_; const int id_ = __builtin_amdgcn_readlane(ee_ < 64 ? nid0 : nid1, ee_ & 63); \
        ub[e_].a = *(const u32x4_*)(U4 + (size_t)id_ * 1024 + 16 * lane); } } while (0)
#define M4N_ISSUE_V(grp) do { _Pragma("unroll") for (int q_ = 0; q_ < 2; ++q_) { const int idv_ = __shfl((grp) < 8 ? nid0 : nid1, (8 * (grp) + 4 * q_ + kg) & 63); \
        const unsigned char* vp_ = V4 + (unsigned)(idv_ * 1024 + n16); \
        _Pragma("unroll") for (int t_ = 0; t_ < 4; ++t_) vb[q_][t_].a = *(const u32x4_*)(vp_ + 256 * t_); } } while (0)
DEV void peer_gather_pair(const bf16* __restrict__ H1, const LASF int* LIDp, const LASF float* LGTp, const unsigned char* __restrict__ U4, const unsigned char* __restrict__ V4,
                          const float* __restrict__ RSU, const float* __restrict__ RSV, const bf16* __restrict__ PLEB, const float* lg, const float* lb, float* __restrict__ out, int tok0, int lane) {
    const int kg = lane >> 4, n16 = (lane & 15) * 16, r4 = (lane & 15) >> 2, wsh = (6 * (lane & 15)) & 31, wrl = (6 * (lane & 15)) >> 5, dl = 32 * (lane & 15) + 4 * kg;
    const bool lb0 = (lane & 1) != 0, lb1 = (lane & 2) != 0, dg = kg == r4; const f32x4_ zero4 = {0.f, 0.f, 0.f, 0.f};
    int id0 = LIDp[lane], id1 = LIDp[64 + lane];
    float su0 = RSU[PNK * PNK + id0], su1 = RSU[PNK * PNK + id1], sv0 = RSV[PNK * PNK + id0] * LGTp[lane], sv1 = RSV[PNK * PNK + id1] * LGTp[64 + lane];
    uint4 xr[4];
#pragma unroll
    for (int u = 0; u < 4; ++u) xr[u] = *(const uint4*)(H1 + (size_t)tok0 * 2048 + 32 * lane + 8 * u);
    R6_ ub[8], vb[2][4];
    M4_ISSUE_U(0); M4_ISSUE_V(0);
#pragma unroll 1
    for (int q = 0; q < 2; ++q) { const int tok = tok0 + q; const bool more = q == 0;
        i32x8g_ xa; int xsb;
        { float xf[32]; float m = 0.f;
#pragma unroll
          for (int u = 0; u < 4; ++u) { const unsigned qw[4] = {xr[u].x, xr[u].y, xr[u].z, xr[u].w};
#pragma unroll
              for (int k = 0; k < 4; ++k) { xf[8 * u + 2 * k] = __uint_as_float(qw[k] << 16); xf[8 * u + 2 * k + 1] = __uint_as_float(qw[k] & 0xffff0000u); m = fmaxf(m, fmaxf(fabsf(xf[8 * u + 2 * k]), fabsf(xf[8 * u + 2 * k + 1]))); } }
          const unsigned eb = (__float_as_uint(m * 1.0666667f) >> 23) & 255u; const bool ok = eb >= 3u;
          xsb = ok ? (int)eb - 2 : 0; const float inv = ok ? __uint_as_float((256u - eb) << 23) : 0.f;
          unsigned p[32];
#pragma unroll
          for (int i = 0; i < 32; ++i) { const float a = fabsf(xf[i]) * inv; const float t = fminf(fminf(8.f * a, 4.f * a + 8.f), 2.f * a + 16.f); p[i] = (__float_as_uint(t + 8388608.f) & 31u) | ((__float_as_uint(xf[i]) >> 26) & 32u); }
          unsigned w6[6];
#pragma unroll
          for (int t = 0; t < 2; ++t) { const unsigned* c = p + 16 * t;
              w6[3 * t] = c[0] | (c[1] << 6) | (c[2] << 12) | (c[3] << 18) | (c[4] << 24) | (c[5] << 30);
              w6[3 * t + 1] = (c[5] >> 2) | (c[6] << 4) | (c[7] << 10) | (c[8] << 16) | (c[9] << 22) | (c[10] << 28);
              w6[3 * t + 2] = (c[10] >> 4) | (c[11] << 2) | (c[12] << 8) | (c[13] << 14) | (c[14] << 20) | (c[15] << 26); }
          xa = (i32x8g_){(int)w6[0], (int)w6[1], (int)w6[2], (int)w6[3], (int)w6[4], (int)w6[5], 0, 0}; }
        const int nid0 = LIDp[128 + lane], nid1 = LIDp[192 + lane];
        f32x4_ acc[4][2];
#pragma unroll
        for (int t = 0; t < 4; ++t) { acc[t][0] = zero4; acc[t][1] = zero4; }
#pragma unroll 1
        for (int g = 0; g < 14; ++g) MX_GROUP(g, M4_U, M4_V, M4_ISSUE_U(g + 1), M4_ISSUE_V(g + 1));
        const float nsu0 = RSU[PNK * PNK + nid0], nsu1 = RSU[PNK * PNK + nid1], nsv0 = RSV[PNK * PNK + nid0] * LGTp[128 + lane], nsv1 = RSV[PNK * PNK + nid1] * LGTp[192 + lane];
        if (more) {
#pragma unroll
            for (int u = 0; u < 4; ++u) xr[u] = *(const uint4*)(H1 + (size_t)(tok + 1) * 2048 + 32 * lane + 8 * u); }
        MX_GROUP(14, M4_U, M4_V, M4_ISSUE_U(15), M4_ISSUE_V(15));
        MX_GROUP(15, M4_U, M4_V, if (more) M4N_ISSUE_U(0), if (more) M4N_ISSUE_V(0));
        asm volatile("" : "+s"(lg), "+s"(lb));
        float s = 0.f;
#pragma unroll
        for (int t = 0; t < 4; ++t)
#pragma unroll
            for (int h = 0; h < 2; ++h) { const size_t o = (size_t)tok * 2048 + 512 * t + 16 * h + dl; const u32x2_ hw = *(const u32x2_*)(H1 + o), pw = *(const u32x2_*)(PLEB + o); f32x4_ y = acc[t][h];
                y[0] += __uint_as_float(hw.x << 16) * ALPHA + __uint_as_float(pw.x << 16); y[1] += __uint_as_float(hw.x & 0xffff0000u) * ALPHA + __uint_as_float(pw.x & 0xffff0000u);
                y[2] += __uint_as_float(hw.y << 16) * ALPHA + __uint_as_float(pw.y << 16); y[3] += __uint_as_float(hw.y & 0xffff0000u) * ALPHA + __uint_as_float(pw.y & 0xffff0000u);
                acc[t][h] = y; s += (y[0] + y[1]) + (y[2] + y[3]); }
        const float mean = wave_sum(s) * (1.f / D); float qq = 0.f;
#pragma unroll
        for (int t = 0; t < 4; ++t)
#pragma unroll
            for (int h = 0; h < 2; ++h) { acc[t][h] -= mean; const f32x4_ y = acc[t][h]; qq += (y[0] * y[0] + y[1] * y[1]) + (y[2] * y[2] + y[3] * y[3]); }
        const float rstd = rsqrtf(wave_sum(qq) * (1.f / D) + LN_EPS);
#pragma unroll
        for (int t = 0; t < 4; ++t)
#pragma unroll
            for (int h = 0; h < 2; ++h) { const int c = 512 * t + 16 * h + dl; const f32x4_ gg = *(const f32x4_*)(lg + c), bb = *(const f32x4_*)(lb + c);
                *(f32x4_*)(out + (size_t)tok * 2048 + c) = acc[t][h] * rstd * gg + bb; }
        id0 = nid0; id1 = nid1; su0 = nsu0; su1 = nsu1; sv0 = nsv0; sv1 = nsv1;
    }
}

template <bool DESC> DEV void sort16(unsigned (&a)[16]) {
#pragma unroll
    for (int k = 2; k <= 16; k <<= 1)
#pragma unroll
        for (int j = k >> 1; j > 0; j >>= 1)
#pragma unroll
            for (int i = 0; i < 16; ++i) { const int l = i ^ j; if (l > i) { const bool up = ((i & k) == 0) != DESC; const unsigned lo = a[i] < a[l] ? a[i] : a[l], hi = a[i] < a[l] ? a[l] : a[i]; a[i] = up ? lo : hi; a[l] = up ? hi : lo; } }
}
DEV void merge16(unsigned (&top)[16], const unsigned (&asc)[16]) {
#pragma unroll
    for (int i = 0; i < 16; ++i) top[i] = top[i] > asc[i] ? top[i] : asc[i];
#pragma unroll
    for (int j = 8; j > 0; j >>= 1)
#pragma unroll
        for (int i = 0; i < 16; ++i) if ((i & j) == 0) { const unsigned hi = top[i] > top[i + j] ? top[i] : top[i + j], lo = top[i] > top[i + j] ? top[i + j] : top[i]; top[i] = hi; top[i + j] = lo; }
}
DEV void peer_tile(LASF unsigned char* lds, const bf16* __restrict__ QP, const bf16* __restrict__ KEYS, const bf16* __restrict__ H1, const unsigned char* __restrict__ U8, const unsigned char* __restrict__ V8, const unsigned char* __restrict__ U4, const unsigned char* __restrict__ V4,
                   const float* __restrict__ RSU, const float* __restrict__ RSV, const bf16* __restrict__ PLEB, const float* __restrict__ lg, const float* __restrict__ lb, float* __restrict__ out, int tile, int tid) {
    const int lane = tid & 63, wave = __builtin_amdgcn_readfirstlane(tid >> 6), fr = lane & 15, g = lane >> 4, tok0 = tile * 16;
    LASF float* SC = (LASF float*)lds; LASF int* LID = (LASF int*)(lds + PS_IDS); LASF float* LGT = (LASF float*)(lds + PS_GT);
#pragma unroll
    for (int half = 0; half < 2; ++half) {
        bf16x8_ qa[4];
#pragma unroll
        for (int ks = 0; ks < 4; ++ks) qa[ks] = *(const bf16x8_*)(QP + (size_t)(tok0 + fr) * 2048 + wave * 256 + half * 128 + 32 * ks + 8 * g);
        const bf16* kb = KEYS + ((size_t)(wave * 2 + half) * 128 + fr) * 128 + 8 * g;
#pragma unroll
        for (int nt = 0; nt < 8; ++nt) { f32x4_ acc = {0.f, 0.f, 0.f, 0.f};
#pragma unroll
            for (int ks = 0; ks < 4; ++ks) acc = __builtin_amdgcn_mfma_f32_16x16x32_bf16(qa[ks], *(const bf16x8_*)(kb + (size_t)nt * 16 * 128 + 32 * ks), acc, 0, 0, 0);
#pragma unroll
            for (int r = 0; r < 4; ++r) SC[((wave * 2 + half) * 16 + 4 * g + r) * (PS_ROW / 4) + 16 * nt + fr] = acc[r]; } }
    __syncthreads();
#define KEY_OF(f, low, mask) ({ const unsigned u_ = __float_as_uint(f); ((u_ ^ ((unsigned)((int)u_ >> 31) | 0x80000000u)) & ~(mask)) | (low); })
#define VAL_OF(kk, mask) ({ const unsigned k_ = (kk) & ~(mask); __uint_as_float(k_ ^ ((k_ >> 31) ? 0x80000000u : 0xffffffffu)); })
#define KEY_INSERT(tk, key) do { if ((key) > tk[15]) { const unsigned ky_ = (key); \
        _Pragma("unroll") for (int k_ = 15; k_ > 0; --k_) { const unsigned m_ = tk[k_] > ky_ ? tk[k_] : ky_; tk[k_] = tk[k_ - 1] < m_ ? tk[k_ - 1] : m_; } \
        tk[0] = tk[0] > ky_ ? tk[0] : ky_; } } while (0)
    if (tid < 256) { LASF float* row = SC + tid * (PS_ROW / 4); unsigned tk[16];
#pragma unroll 1
        for (int bt = 0; bt < 8; ++bt) { unsigned nk[16];
#pragma unroll
            for (int c4 = 0; c4 < 4; ++c4) { const f32x4_ v = *(const LASF f32x4_*)(row + 16 * bt + 4 * c4);
#pragma unroll
                for (int j = 0; j < 4; ++j) nk[4 * c4 + j] = KEY_OF(v[j], (unsigned)(127 - (16 * bt + 4 * c4 + j)), 127u); }
            if (bt == 0) { sort16<true>(nk);
#pragma unroll
                for (int k = 0; k < 16; ++k) tk[k] = nk[k]; }
            else { sort16<false>(nk); merge16(tk, nk); } }
#pragma unroll
        for (int k = 0; k < 16; ++k) { row[k] = VAL_OF(tk[k], 127u); ((LASF int*)row)[16 + k] = 127 - (int)(tk[k] & 127u); } }
    __syncthreads();
    if (tid < 128) { int tc_ = tid; asm volatile("" : "+v"(tc_));
        const int tk_ = tc_ & 15, hh = tc_ >> 4; const LASF float* ra = SC + ((hh * 2) * 16 + tk_) * (PS_ROW / 4); const LASF float* rb = SC + ((hh * 2 + 1) * 16 + tk_) * (PS_ROW / 4);
        unsigned tk[16], cd[64]; float fa[16], fb[16];
#pragma unroll
        for (int k4 = 0; k4 < 4; ++k4) { const f32x4_ va = *(const LASF f32x4_*)(ra + 4 * k4), vb_ = *(const LASF f32x4_*)(rb + 4 * k4);
#pragma unroll
            for (int r = 0; r < 4; ++r) { fa[4 * k4 + r] = va[r]; fb[4 * k4 + r] = vb_[r]; } }
        { int c = 0;
#pragma unroll
          for (int i = 0; i < 16; ++i)
#pragma unroll
              for (int j = 0; j < 16; ++j) if ((i + 1) * (j + 1) <= 16) { cd[c] = KEY_OF(fa[i] + fb[j], (unsigned)(255 - (16 * i + j)), 255u); ++c; }
#pragma unroll
          for (int k = 50; k < 64; ++k) cd[k] = 0u; }
#pragma unroll
        for (int bt = 0; bt < 4; ++bt) { unsigned nk[16];
#pragma unroll
            for (int k = 0; k < 16; ++k) nk[k] = cd[16 * bt + k];
            if (bt == 0) { sort16<true>(nk);
#pragma unroll
                for (int k = 0; k < 16; ++k) tk[k] = nk[k]; }
            else { sort16<false>(nk); merge16(tk, nk); } }
        float tv[16]; const float mx = VAL_OF(tk[0], 255u); float sum = 0.f;
#pragma unroll
        for (int k = 0; k < 16; ++k) { tv[k] = __expf(VAL_OF(tk[k], 255u) - mx); sum += tv[k]; }
        const float inv = 1.f / sum;
#pragma unroll
        for (int k = 0; k < 16; ++k) { const int slot = 255 - (int)(tk[k] & 255u); LID[tk_ * 128 + hh * 16 + k] = ((const LASF int*)ra)[16 + (slot >> 4)] * 128 + ((const LASF int*)rb)[16 + (slot & 15)]; LGT[tk_ * 128 + hh * 16 + k] = tv[k] * inv; } }
    __syncthreads();
#undef KEY_OF
#undef VAL_OF
#undef KEY_INSERT
    if (FP4_LOW == 3) peer_gather_pair(H1, LID + 2 * wave * 128, LGT + 2 * wave * 128, U4, V4, RSU, RSV, PLEB, lg, lb, out, tok0 + 2 * wave, lane);
    else
#pragma unroll 1
    for (int u = 0; u < 2; ++u) { const int tl = 2 * wave + u;
        peer_gather_tokm(H1, LID[tl * 128 + lane], LID[tl * 128 + 64 + lane], LGT[tl * 128 + lane], LGT[tl * 128 + 64 + lane], U8, V8, U4, V4, RSU, RSV, PLEB, lg, lb, out, tok0 + tl, lane); }
    __syncthreads();
}

namespace pg8 {
#define PG8_LAS __attribute__((address_space(3)))
typedef unsigned short bf16_t;
typedef short bf16x8 __attribute__((ext_vector_type(8)));
typedef float f32x4 __attribute__((ext_vector_type(4)));
typedef unsigned u32x4 __attribute__((ext_vector_type(4)));
constexpr int BM = 256, BK = 64, HALF = 128, HTB = HALF * BK * 2  , STAGE_BYTES = 8 * HTB, NXCD = 8, WGM = 8;
__host__ __device__ __forceinline__ int lds_byte(int r, int c) { const int st = (r >> 4) * 2 + (c >> 5), rr = r & 15, cc = c & 31, ob = rr * 64 + cc * 2; return st * 1024 + (ob ^ (((ob >> 9) & 1) << 5)); }
__host__ __device__ __forceinline__ void stage_rc(int b, int& R, int& C) { const int st = b / 1024, sb = b % 1024, swz = sb ^ (((sb >> 9) & 1) << 5); R = (st >> 1) * 16 + swz / 64; C = (st & 1) * 32 + (swz % 64) / 2; }
__host__ __device__ __forceinline__ int perm32(int rho) { const int n = rho >> 4, i = rho & 15; return 8 * (i >> 2) + 4 * n + (i & 3); }
struct Unit { int pm, pn, which; };
struct Gemm { const bf16_t* A; const bf16_t* Bt; const bf16_t* A2; const bf16_t* Bt2; int K; };

struct StaticOrder {
    int nM, nN, nwg, G, c;
    __host__ __device__ void init(int M, int N, int G_, int c_) { nM = M / BM; nN = N / BM; nwg = nM * nN; G = G_; c = c_; }
    __host__ __device__ bool next(int i, Unit& u) const {
        const long L = (long)i * G + c; if (L >= nwg) return false;
        int wgid = (int)L; { const int q = nwg / NXCD, r = nwg % NXCD, xcd = wgid % NXCD, off = wgid / NXCD; wgid = (xcd < r ? xcd * (q + 1) : r * (q + 1) + (xcd - r) * q) + off; }
        const int nig = WGM * nN, gid = wgid / nig, fm = gid * WGM, gsz = (nM - fm) < WGM ? (nM - fm) : WGM;
        u.pm = fm + ((wgid % nig) % gsz); u.pn = (wgid % nig) / gsz; return true;
    }
    __device__ __forceinline__ void a_ready(const Unit&) const {}
    __device__ __forceinline__ void done(const Unit&) const {}
};
typedef __bf16 bf16x2_t __attribute__((ext_vector_type(2)));
typedef float f32x2_t __attribute__((ext_vector_type(2)));
__device__ __forceinline__ unsigned cvt_pk_bf16(float lo, float hi) { const f32x2_t v = {lo, hi}; return __builtin_bit_cast(unsigned, __builtin_convertvector(v, bf16x2_t)); }
typedef float f32x2 __attribute__((ext_vector_type(2)));
__device__ __forceinline__ f32x2 gelu_pk(f32x2 v) {
    const f32x2 av = __builtin_elementwise_abs(v), d = av * 0.2316418882f + 1.0f;
    f32x2 t; t.x = __builtin_amdgcn_rcpf(d.x); t.y = __builtin_amdgcn_rcpf(d.y);
    f32x2 q = t * 0.5307027145f + (-0.7265760135f); q = q * t + 0.7107068705f; q = q * t + (-0.142248368f); q = q * t + 0.127414796f; q = q * t;
    const f32x2 s = (v * v) * (-0.72134752044f);
    f32x2 e; e.x = __builtin_amdgcn_exp2f(s.x); e.y = __builtin_amdgcn_exp2f(s.y);
    const f32x2 m = v * (q * e), r = v - m;
    f32x2 o; o.x = v.x < 0.f ? m.x : r.x; o.y = v.y < 0.f ? m.y : r.y; return o;
}


struct Order2 {
    int nM0, nN0, n0, nM1, nN1, n1, G, c;
    __device__ __forceinline__ void init(int M0, int N0, int M1, int N1_, int G_, int c_) { nM0 = M0 / BM; nN0 = N0 / BM; n0 = nM0 * nN0; nM1 = M1 / BM; nN1 = N1_ / BM; n1 = nM1 * nN1; G = G_; c = c_; }
    static __device__ __forceinline__ void map(int wgid, int nwg, int nM, int nN, Unit& u) {
        { const int q = nwg / NXCD, r = nwg % NXCD, xcd = wgid % NXCD, off = wgid / NXCD; wgid = (xcd < r ? xcd * (q + 1) : r * (q + 1) + (xcd - r) * q) + off; }
        const int nig = WGM * nN, gid = wgid / nig, fm = gid * WGM, gsz = (nM - fm) < WGM ? (nM - fm) : WGM;
        u.pm = fm + ((wgid % nig) % gsz); u.pn = (wgid % nig) / gsz; }
    __device__ __forceinline__ bool next(int i, Unit& u) const {
        int L = i * G + c;
        if (L < n0) { map(L, n0, nM0, nN0, u); u.which = 0; return true; }
        L -= n0; if (L < n1) { map(L, n1, nM1, nN1, u); u.which = 1; return true; }
        return false; }
    __device__ __forceinline__ void a_ready(const Unit&) const {}
    __device__ __forceinline__ void done(const Unit&) const {}
};
__device__ __forceinline__ void st8bf(bf16_t* p, f32x4 v0, f32x4 v1) { u32x4 w; w.x = cvt_pk_bf16(v0[0], v0[1]); w.y = cvt_pk_bf16(v0[2], v0[3]); w.z = cvt_pk_bf16(v1[0], v1[1]); w.w = cvt_pk_bf16(v1[2], v1[3]); *(u32x4*)p = w; }
__device__ __forceinline__ void st8f8(unsigned char* p, f32x4 v0, f32x4 v1) { int a = 0, b = 0; a = __builtin_amdgcn_cvt_pk_fp8_f32(v0[0], v0[1], a, false); a = __builtin_amdgcn_cvt_pk_fp8_f32(v0[2], v0[3], a, true);
    b = __builtin_amdgcn_cvt_pk_fp8_f32(v1[0], v1[1], b, false); b = __builtin_amdgcn_cvt_pk_fp8_f32(v1[2], v1[3], b, true); typedef int i32x2_ __attribute__((ext_vector_type(2))); *(i32x2_*)p = (i32x2_){a, b}; }
__device__ __forceinline__ void ld8bf(const bf16_t* p, f32x4& v0, f32x4& v1) { const u32x4 w = *(const u32x4*)p;
    v0[0] = __uint_as_float(w.x << 16); v0[1] = __uint_as_float(w.x & 0xffff0000u); v0[2] = __uint_as_float(w.y << 16); v0[3] = __uint_as_float(w.y & 0xffff0000u);
    v1[0] = __uint_as_float(w.z << 16); v1[1] = __uint_as_float(w.z & 0xffff0000u); v1[2] = __uint_as_float(w.w << 16); v1[3] = __uint_as_float(w.w & 0xffff0000u); }
__device__ __forceinline__ f32x4 sig4(f32x4 v) { f32x4 r; r[0] = sigmoidf_(v[0]); r[1] = sigmoidf_(v[1]); r[2] = sigmoidf_(v[2]); r[3] = sigmoidf_(v[3]); return r; }
template <int KIND> struct Epi {
    static constexpr bool PERM = true, AFTER_DRAIN = false;
    EpiArgs e;
    __device__ __forceinline__ void operator()(const f32x4 (&acc)[2][2][4][2], const Unit& u, int wr, int wc, int fr, int fq) const {
        const int row0 = u.pm * BM + wr * 64 + fr, colu = u.pn * BM + wc * 32 + 8 * fq;
        if (KIND == EK_MAIN && u.which == 1) {
#pragma unroll
            for (int ai = 0; ai < 2; ++ai)
#pragma unroll
                for (int m = 0; m < 4; ++m) { const int row = row0 + ai * HALF + m * 16; const float bv = e.bias2[row];
#pragma unroll
                    for (int bj = 0; bj < 2; ++bj) st8bf(e.o5 + (size_t)row * T + colu + bj * HALF, acc[ai][bj][m][0] + bv, acc[ai][bj][m][1] + bv); }
            return; }
        bf16_t* ob = e.o0; int ldc = 2048, c0 = colu, mode = 0; float sc = 1.f;
        if (KIND == EK_MAIN) { const int pn = u.pn, cw = wc * 32 + 8 * fq;
            if (pn < 8) { ob = e.o0; c0 = pn * 256 + cw; sc = pn < 4 ? 0.125f : 1.f; }
            else if (pn < 16) { ob = e.o1; c0 = (pn - 8) * 256 + cw; sc = pn < 12 ? 0.0625f : 1.f; }
            else if (pn < 24) { ob = e.o2; c0 = (pn - 16) * 256 + cw; mode = 1; }
            else if (pn < 40) { ob = e.o3; c0 = (pn - 24) * 256 + cw; ldc = 4096; mode = 2; }
            else { ob = e.o4; c0 = cw; ldc = 256; } }
        if (KIND == EK_2) { if (e.qonly) { ob = e.o1; mode = 1; } else if (u.pn >= 8) { ob = e.o1; c0 = colu - 2048; mode = 1; } }
        if (KIND == EK_MAIN) {
#pragma unroll
            for (int bj = 0; bj < 2; ++bj) { const float* bp_ = e.bias + colu + bj * HALF; asm volatile("" : "+v"(bp_)); const f32x4 bs0 = *(const f32x4*)bp_, bs1 = *(const f32x4*)(bp_ + 4); const int cc = c0 + bj * HALF;
#pragma unroll
                for (int ai = 0; ai < 2; ++ai)
#pragma unroll
                    for (int m = 0; m < 4; ++m) { const int row = row0 + ai * HALF + m * 16; f32x4 v0 = acc[ai][bj][m][0] + bs0, v1 = acc[ai][bj][m][1] + bs1;
                        if (mode == 0) { v0 *= sc; v1 *= sc; } else if (mode == 1) { v0 *= sig4(v0); v1 *= sig4(v1); } else { v0 = sig4(v0); v1 = sig4(v1); }
                        st8bf(ob + (size_t)row * ldc + cc, v0, v1); } }
            return; }
#pragma unroll
        for (int ai = 0; ai < 2; ++ai)
#pragma unroll
            for (int m = 0; m < 4; ++m) { const int row = row0 + ai * HALF + m * 16;
#pragma unroll
                for (int bj = 0; bj < 2; ++bj) { f32x4 v0 = acc[ai][bj][m][0], v1 = acc[ai][bj][m][1]; const int cc = c0 + bj * HALF;
                    if (KIND == EK_MAIN) { const float* bp_ = e.bias + colu + bj * HALF; asm volatile("" : "+v"(bp_));
                        v0 += *(const f32x4*)bp_; v1 += *(const f32x4*)(bp_ + 4);
                        if (mode == 0) { v0 *= sc; v1 *= sc; } else if (mode == 1) { v0 *= sig4(v0); v1 *= sig4(v1); } else { v0 = sig4(v0); v1 = sig4(v1); }
                        st8bf(ob + (size_t)row * ldc + cc, v0, v1); }
                    else if (KIND == EK_A) { f32x4 g0, g1; ld8bf(e.a0 + (size_t)row * 4096 + cc, g0, g1); st8bf(ob + (size_t)row * 2048 + cc, g0 * v0, g1 * v1); }
                    else if (KIND == EK_B) { f32x4 g0, g1, t0, t1; ld8bf(e.a0 + (size_t)row * 4096 + 2048 + cc, g0, g1); ld8bf(e.a1 + (size_t)row * 2048 + cc, t0, t1); st8f8((unsigned char*)ob + (size_t)row * 2048 + cc, t0 + g0 * v0, t1 + g1 * v1); }
                    else if (KIND == EK_OUT) { f32x4 h0, h1; ld8bf(e.a0 + (size_t)row * 2048 + cc, h0, h1); float* op = e.of + (size_t)row * 2048 + cc; *(f32x4*)op = h0 * ALPHA + v0; *(f32x4*)(op + 4) = h1 * ALPHA + v1; }
                    else if (KIND == EK_PLE) { st8bf(ob + (size_t)row * 2048 + cc, v0, v1); }
                    else if (KIND == EK_2) { if (mode == 0) { f32x4 p0, p1; ld8bf(e.a0 + (size_t)row * 2048 + cc, p0, p1); st8bf(ob + (size_t)row * 2048 + cc, p0 * sig4(v0), p1 * sig4(v1)); } else st8bf(ob + (size_t)row * 2048 + cc, v0, v1); }
                } }
    }
};

struct EpiLnOut {
    static constexpr bool PERM = true, AFTER_DRAIN = true;
    const bf16_t* h0; const float* lng; const float* lnb; bf16_t* h1; unsigned char* h1f8; unsigned long long* xbuf; unsigned* cnt; unsigned* tmo;
    __device__ __forceinline__ void operator()(const f32x4 (&)[2][2][4][2], const Unit&, int, int, int, int) const {}
    __device__ __forceinline__ void fused(f32x4 (&acc)[2][2][4][2], const Unit& u, int wr, int wc, int fr, int fq, PG8_LAS unsigned char* lds, int wid, int lane) const {
        typedef float f32x2v __attribute__((ext_vector_type(2)));
        PG8_LAS f32x2v* P = (PG8_LAS f32x2v*)lds; PG8_LAS f32x2v* S = (PG8_LAS f32x2v*)(lds + 8192);
        const int row0 = u.pm * BM + wr * 64 + fr, colu = u.pn * BM + wc * 32 + 8 * fq, tid = wid * 64 + lane;
#define LNO_BAR() do { asm volatile("s_waitcnt lgkmcnt(0)" ::: "memory"); __builtin_amdgcn_s_barrier(); asm volatile("" ::: "memory"); } while (0)
#pragma unroll
        for (int ai = 0; ai < 2; ++ai)
#pragma unroll
            for (int m = 0; m < 4; ++m) { const int row = row0 + ai * HALF + m * 16; float s1 = 0.f, s2 = 0.f;
#pragma unroll
                for (int bj = 0; bj < 2; ++bj) { f32x4 ha, hb; ld8bf(h0 + (size_t)row * 2048 + colu + bj * HALF, ha, hb);
                    const f32x4 v0 = acc[ai][bj][m][0] + ha * ALPHA, v1 = acc[ai][bj][m][1] + hb * ALPHA; acc[ai][bj][m][0] = v0; acc[ai][bj][m][1] = v1;
                    s1 += (v0[0] + v0[1]) + (v0[2] + v0[3]) + (v1[0] + v1[1]) + (v1[2] + v1[3]); s2 += (v0[0] * v0[0] + v0[1] * v0[1]) + (v0[2] * v0[2] + v0[3] * v0[3]) + (v1[0] * v1[0] + v1[1] * v1[1]) + (v1[2] * v1[2] + v1[3] * v1[3]); }
                s1 += __shfl_xor(s1, 16); s1 += __shfl_xor(s1, 32); s2 += __shfl_xor(s2, 16); s2 += __shfl_xor(s2, 32);
                if (fq == 0) P[(ai * HALF + wr * 64 + m * 16 + fr) * 4 + wc] = (f32x2v){s1, s2}; }
        LNO_BAR();
        if (tid < 256) { const f32x2v a = P[tid * 4], b = P[tid * 4 + 1], c = P[tid * 4 + 2], d = P[tid * 4 + 3]; const float t1 = (a.x + b.x) + (c.x + d.x), t2 = (a.y + b.y) + (c.y + d.y);
            __hip_atomic_store(xbuf + ((size_t)(u.pm * BM + tid) * 8 + u.pn), ((unsigned long long)__float_as_uint(t2) << 32) | __float_as_uint(t1), __ATOMIC_RELAXED, __HIP_MEMORY_SCOPE_AGENT); }
        asm volatile("s_waitcnt vmcnt(0)" ::: "memory");
        LNO_BAR();
        if (tid == 0) { __hip_atomic_fetch_add(cnt + 64 * u.pm, 1u, __ATOMIC_RELAXED, __HIP_MEMORY_SCOPE_AGENT);
            unsigned sp = 0; while (__hip_atomic_load(cnt + 64 * u.pm, __ATOMIC_RELAXED, __HIP_MEMORY_SCOPE_AGENT) < 8u) { __builtin_amdgcn_s_sleep(1);
                if ((++sp & 255u) == 0u) { if (__hip_atomic_load(tmo, __ATOMIC_RELAXED, __HIP_MEMORY_SCOPE_AGENT)) break; if (sp > (1u << 18)) { atomicAdd(tmo, 1u); break; } } }
            __builtin_amdgcn_fence(__ATOMIC_ACQUIRE, "agent"); asm volatile("s_waitcnt vmcnt(0)" ::: "memory"); }
        LNO_BAR();
        if (tid < 256) { float t1 = 0.f, t2 = 0.f;
#pragma unroll
            for (int t = 0; t < 8; ++t) { const unsigned long long w = __hip_atomic_load(xbuf + ((size_t)(u.pm * BM + tid) * 8 + t), __ATOMIC_RELAXED, __HIP_MEMORY_SCOPE_AGENT); t1 += __uint_as_float((unsigned)w); t2 += __uint_as_float((unsigned)(w >> 32)); }
            const float mean = t1 * (1.f / 2048.f), var = fmaxf(t2 * (1.f / 2048.f) - mean * mean, 0.f); S[tid] = (f32x2v){mean, rsqrtf(var + LN_EPS)}; }
        LNO_BAR();
#pragma unroll
        for (int ai = 0; ai < 2; ++ai)
#pragma unroll
            for (int m = 0; m < 4; ++m) { const int rl = ai * HALF + wr * 64 + m * 16 + fr, row = u.pm * BM + rl; const f32x2v ms = S[rl];
#pragma unroll
                for (int bj = 0; bj < 2; ++bj) { const int cc = colu + bj * HALF; const f32x4 g0 = *(const f32x4*)(lng + cc), g1 = *(const f32x4*)(lng + cc + 4), b0 = *(const f32x4*)(lnb + cc), b1 = *(const f32x4*)(lnb + cc + 4);
                    const f32x4 y0 = (acc[ai][bj][m][0] - ms.x) * ms.y * g0 + b0, y1 = (acc[ai][bj][m][1] - ms.x) * ms.y * g1 + b1;
                    st8bf(h1 + (size_t)row * 2048 + cc, y0, y1); st8f8(h1f8 + (size_t)row * 2048 + cc, y0, y1); } }
#undef LNO_BAR
    }
};
typedef int i32x8_ __attribute__((ext_vector_type(8)));
template <class Epi, class Sched, bool ALIGN_EPI = false, bool SP2 = false, bool F8 = false>
__device__ __forceinline__ void gemm_phase(PG8_LAS unsigned char* lds, const Gemm g, const Sched& S, const Epi& E) {
    const int tid = threadIdx.x, wid = __builtin_amdgcn_readfirstlane(tid >> 6), lane = tid & 63, wr = wid >> 2, wc = wid & 3, fr = lane & 15, fq = lane >> 4;
    const int K = g.K, nt = K / BK;
    unsigned voffA[2], voffB[2];
#pragma unroll
    for (int i = 0; i < 2; ++i) { int R, C; stage_rc(tid * 16 + i * 8192, R, C); const int Rb = Epi::PERM ? ((R & ~31) + perm32(R & 31)) : R;
        voffA[i] = (unsigned)(R * K + C) * 2u; voffB[i] = (unsigned)(Rb * K + C) * 2u; }
    const size_t kstep = (size_t)(BK * 2);
    const size_t hstep = (size_t)HALF * K * 2;
    const size_t tstep = 2 * hstep;
    const unsigned ldsw = (unsigned)wid * 1024u;
    const int aoff = lds_byte(wr * 64 + fr, fq * 8), boff = lds_byte(wc * 32 + fr, fq * 8);
#define PG8_SA(b, h) (((b) * 2 + (h)) * HTB)
#define PG8_SB(b, h) ((4 + (b) * 2 + (h)) * HTB)
#define PG8_STAGE(bufoff, gbase, voff) do { _Pragma("unroll") for (int _i = 0; _i < 2; ++_i) \
        __builtin_amdgcn_global_load_lds((const unsigned*)((const char*)(gbase) + (voff)[_i]), (PG8_LAS unsigned*)(lds + (bufoff) + ldsw + _i * 8192), 16, 0, 0); } while (0)
#define PG8_LDA(dst, b, h) do { _Pragma("unroll") for (int m = 0; m < 4; ++m) { if constexpr (F8) { const u32x4 l_ = *(const PG8_LAS u32x4*)(lds + PG8_SA(b, h) + aoff + m * 2048), h_ = *(const PG8_LAS u32x4*)(lds + PG8_SA(b, h) + aoff + m * 2048 + 1024); dst##8[m] = __builtin_shufflevector(l_, h_, 0, 1, 2, 3, 4, 5, 6, 7); } \
        else { _Pragma("unroll") for (int k = 0; k < 2; ++k) dst[m][k] = *(const PG8_LAS bf16x8*)(lds + PG8_SA(b, h) + aoff + m * 2048 + k * 1024); } } } while (0)
#define PG8_LDB(dst, b, h) do { _Pragma("unroll") for (int n = 0; n < 2; ++n) { if constexpr (F8) { const u32x4 l_ = *(const PG8_LAS u32x4*)(lds + PG8_SB(b, h) + boff + n * 2048), h_ = *(const PG8_LAS u32x4*)(lds + PG8_SB(b, h) + boff + n * 2048 + 1024); dst##8[n] = __builtin_shufflevector(l_, h_, 0, 1, 2, 3, 4, 5, 6, 7); } \
        else { _Pragma("unroll") for (int k = 0; k < 2; ++k) dst[n][k] = *(const PG8_LAS bf16x8*)(lds + PG8_SB(b, h) + boff + n * 2048 + k * 1024); } } } while (0)
#define PG8_MMA(ai, bj, At, Bt) do { __builtin_amdgcn_s_setprio(1); _Pragma("unroll") for (int m = 0; m < 4; ++m) _Pragma("unroll") for (int n = 0; n < 2; ++n) { \
        if constexpr (F8) asm volatile("v_mfma_scale_f32_16x16x128_f8f6f4 %0, %1, %2, %0, %3, %4 op_sel_hi:[0,0,0]" : "+v"(acc[ai][bj][m][n]) : "v"(Bt##8[n]), "v"(At##8[m]), "v"(sclB), "v"(sclA)); \
        else { _Pragma("unroll") for (int k = 0; k < 2; ++k) acc[ai][bj][m][n] = __builtin_amdgcn_mfma_f32_16x16x32_bf16(Bt[n][k], At[m][k], acc[ai][bj][m][n], 0, 0, 0); } } __builtin_amdgcn_s_setprio(0); } while (0)
#define PG8_WAIT_V(n) asm volatile("s_waitcnt vmcnt(" #n ")" ::: "memory")
#define PG8_WAIT_L(n) asm volatile("s_waitcnt lgkmcnt(" #n ")" ::: "memory")
#define PG8_BAR __builtin_amdgcn_s_barrier()
#define PG8_SCHED __builtin_amdgcn_sched_barrier(0)
    Unit cur, nxt; int ui = 0;
    if (!S.next(0, cur)) return;
    f32x4 acc[2][2][4][2];
#pragma unroll
    for (int a = 0; a < 2; ++a)
#pragma unroll
        for (int b = 0; b < 2; ++b)
#pragma unroll
            for (int m = 0; m < 4; ++m)
#pragma unroll
                for (int n = 0; n < 2; ++n) acc[a][b][m][n] = (f32x4){0.f, 0.f, 0.f, 0.f};
    int sclB = 0x79797979, sclA = 0x7f7f7f7f; asm volatile("" : "+v"(sclB), "+v"(sclA));
    bf16x8 At[4][2], B0[2][2], B1[2][2]; typedef unsigned u32x8 __attribute__((ext_vector_type(8))); u32x8 At8[4], B08[2], B18[2]; (void)At; (void)B0; (void)B1; (void)At8; (void)B08; (void)B18;
    const char* cA = (const char*)(cur.which ? g.A2 : g.A) + (size_t)cur.pm * tstep; const char* cB = (const char*)(cur.which ? g.Bt2 : g.Bt) + (size_t)cur.pn * tstep;
    S.a_ready(cur);
    if constexpr (SP2) {
        PG8_STAGE(PG8_SB(0, 0), cB, voffB); PG8_STAGE(PG8_SB(0, 1), cB + hstep, voffB); PG8_STAGE(PG8_SA(0, 0), cA, voffA); PG8_STAGE(PG8_SA(0, 1), cA + hstep, voffA);
        if (wr == 1) PG8_BAR;
        PG8_WAIT_V(2); PG8_BAR;
        PG8_STAGE(PG8_SB(1, 0), cB + kstep, voffB); PG8_STAGE(PG8_SA(1, 0), cA + kstep, voffA); PG8_STAGE(PG8_SB(1, 1), cB + hstep + kstep, voffB);
        PG8_WAIT_V(6); PG8_BAR;
    } else {
        PG8_STAGE(PG8_SB(0, 0), cB, voffB); PG8_STAGE(PG8_SA(0, 0), cA, voffA); PG8_STAGE(PG8_SB(0, 1), cB + hstep, voffB); PG8_STAGE(PG8_SA(0, 1), cA + hstep, voffA);
        if (wr == 1) PG8_BAR;
        PG8_WAIT_V(4); PG8_BAR;
        PG8_STAGE(PG8_SB(1, 0), cB + kstep, voffB); PG8_STAGE(PG8_SA(1, 0), cA + kstep, voffA); PG8_STAGE(PG8_SB(1, 1), cB + hstep + kstep, voffB);
        PG8_WAIT_V(6); PG8_BAR;
    }
    for (;;) {
        const bool has_next = S.next(ui + 1, nxt);
        const char* nA = has_next ? (const char*)(nxt.which ? g.A2 : g.A) + (size_t)nxt.pm * tstep : cA; const char* nB = has_next ? (const char*)(nxt.which ? g.Bt2 : g.Bt) + (size_t)nxt.pn * tstep : cB;
        for (int t = 0; t < nt; t += 2) {
            const bool last = (t == nt - 2);
            const char* a1 = cA + (size_t)(t + 1) * kstep;
            const char* a2 = last ? nA : cA + (size_t)(t + 2) * kstep; const char* b2 = last ? nB : cB + (size_t)(t + 2) * kstep;
            const char* a3 = a2 + kstep; const char* b3 = b2 + kstep;
            if (last && has_next) S.a_ready(nxt);
            if constexpr (SP2) {
            PG8_LDB(B0, 0, 0); PG8_LDB(B1, 0, 1); PG8_SCHED; PG8_LDA(At, 0, 0); PG8_STAGE(PG8_SA(1, 1), a1 + hstep, voffA);
            PG8_WAIT_V(8); PG8_WAIT_L(0); PG8_BAR; PG8_MMA(0, 0, At, B0); PG8_MMA(0, 1, At, B1); PG8_BAR; PG8_SCHED;
            PG8_LDA(At, 0, 1); PG8_STAGE(PG8_SB(0, 0), b2, voffB); PG8_STAGE(PG8_SB(0, 1), b2 + hstep, voffB); PG8_STAGE(PG8_SA(0, 0), a2, voffA);
            PG8_WAIT_V(8); PG8_WAIT_L(0); PG8_BAR; PG8_MMA(1, 0, At, B0); PG8_MMA(1, 1, At, B1); PG8_BAR; PG8_SCHED;
            PG8_LDB(B0, 1, 0); PG8_LDB(B1, 1, 1); PG8_SCHED; PG8_LDA(At, 1, 0); PG8_STAGE(PG8_SA(0, 1), a2 + hstep, voffA);
            PG8_WAIT_V(8); PG8_WAIT_L(0); PG8_BAR; PG8_MMA(0, 0, At, B0); PG8_MMA(0, 1, At, B1); PG8_BAR; PG8_SCHED;
            PG8_LDA(At, 1, 1); PG8_STAGE(PG8_SB(1, 0), b3, voffB); PG8_STAGE(PG8_SB(1, 1), b3 + hstep, voffB); PG8_STAGE(PG8_SA(1, 0), a3, voffA);
            PG8_WAIT_V(8); PG8_WAIT_L(0); PG8_BAR; PG8_MMA(1, 0, At, B0); PG8_MMA(1, 1, At, B1); PG8_BAR; PG8_SCHED;
            } else {
            PG8_LDB(B0, 0, 0); PG8_SCHED; PG8_LDA(At, 0, 0); PG8_STAGE(PG8_SA(1, 1), a1 + hstep, voffA);
            PG8_WAIT_L(8); PG8_BAR; PG8_WAIT_L(0); PG8_MMA(0, 0, At, B0); PG8_BAR; PG8_SCHED;
            PG8_LDB(B1, 0, 1); PG8_STAGE(PG8_SB(0, 0), b2, voffB);
            PG8_BAR; PG8_WAIT_L(0); PG8_MMA(0, 1, At, B1); PG8_BAR;
            PG8_LDA(At, 0, 1); PG8_STAGE(PG8_SA(0, 0), a2, voffA);
            PG8_BAR; PG8_WAIT_L(0); PG8_MMA(1, 0, At, B0); PG8_BAR; PG8_SCHED;
            PG8_STAGE(PG8_SB(0, 1), b2 + hstep, voffB);
            PG8_WAIT_V(6); PG8_BAR; PG8_MMA(1, 1, At, B1); PG8_BAR;
            PG8_LDB(B0, 1, 0); PG8_SCHED; PG8_LDA(At, 1, 0); PG8_STAGE(PG8_SA(0, 1), a2 + hstep, voffA);
            PG8_WAIT_L(8); PG8_BAR; PG8_WAIT_L(0); PG8_MMA(0, 0, At, B0); PG8_BAR; PG8_SCHED;
            PG8_LDB(B1, 1, 1); PG8_STAGE(PG8_SB(1, 0), b3, voffB);
            PG8_BAR; PG8_WAIT_L(0); PG8_MMA(0, 1, At, B1); PG8_BAR;
            PG8_LDA(At, 1, 1); PG8_STAGE(PG8_SA(1, 0), a3, voffA);
            PG8_BAR; PG8_WAIT_L(0); PG8_MMA(1, 0, At, B0); PG8_BAR; PG8_SCHED;
            PG8_STAGE(PG8_SB(1, 1), b3 + hstep, voffB);
            PG8_WAIT_V(6); PG8_BAR; PG8_MMA(1, 1, At, B1); PG8_BAR;
            }
        }
        if constexpr (F8) asm volatile("s_nop 15\n\ts_nop 15" ::: "memory");
        if constexpr (ALIGN_EPI) { if (wr == 0) PG8_BAR; }
        if constexpr (!Epi::AFTER_DRAIN) { E(acc, cur, wr, wc, fr, fq); S.done(cur); }
        if (!has_next) break;
#pragma unroll
        for (int a = 0; a < 2; ++a)
#pragma unroll
            for (int b = 0; b < 2; ++b)
#pragma unroll
                for (int m = 0; m < 4; ++m)
#pragma unroll
                    for (int n = 0; n < 2; ++n) acc[a][b][m][n] = (f32x4){0.f, 0.f, 0.f, 0.f};
        cur = nxt; cA = nA; cB = nB; ++ui;
        if constexpr (ALIGN_EPI) { if (wr == 1) PG8_BAR; }
    }
    PG8_WAIT_V(0);
    if constexpr (!ALIGN_EPI) { if (wr == 0) PG8_BAR; }
    PG8_BAR;
    if constexpr (Epi::AFTER_DRAIN) { E.fused(acc, cur, wr, wc, fr, fq, lds, wid, lane); S.done(cur); }
#undef PG8_SA
#undef PG8_SB
#undef PG8_STAGE
#undef PG8_LDA
#undef PG8_LDB
#undef PG8_MMA
#undef PG8_WAIT_V
#undef PG8_WAIT_L
#undef PG8_BAR
#undef PG8_SCHED
}
}

constexpr int NWAVES = 8;
constexpr int RING_BYTES = 131072, LDSCTL_OFF = 256 * 528 + 16384, MISC_OFF = LDSCTL_OFF + 320, LDS_BYTES = LDSCTL_OFF + 1024;
#define GAS __attribute__((address_space(1)))
#define LAS __attribute__((address_space(3)))
typedef GAS unsigned gu32;
constexpr int CW_TMO = 0, CW_CODE = 1, CW_BAR = 4096;
#define XB_TMO      128
#define XB_XCNT(j)  (256  + 64 * (j))
#define XB_XSUB(j)  (1280 + 64 * (j))
#define XB_XGEN(j)  (2304 + 64 * (j))
#define XB_TOP      3328
#define XB_TOPGEN   3392
#define XCD_BAR_WORDS 3456
#define XB_SPIN_CAP (1u << 18)

__device__ __forceinline__ unsigned xb_ld(unsigned* p)              { return __hip_atomic_load(p, __ATOMIC_RELAXED, __HIP_MEMORY_SCOPE_AGENT); }
__device__ __forceinline__ unsigned xb_add(unsigned* p, unsigned v) { return __hip_atomic_fetch_add(p, v, __ATOMIC_RELAXED, __HIP_MEMORY_SCOPE_AGENT); }
__device__ __forceinline__ unsigned xb_xcc_id() { return (unsigned)__builtin_amdgcn_s_getreg((3 << 11) | 20) & 0xFu; }
#define XB_SPIN(cond, bar) do { unsigned _sp = 0; while (cond) { __builtin_amdgcn_s_sleep(1); \
    if ((++_sp & 255u) == 0u) { if (xb_ld(&(bar)[XB_TMO])) break; if (_sp > XB_SPIN_CAP) { atomicAdd(&(bar)[XB_TMO], 1u); break; } } } } while (0)

struct XcdBarrier {
    unsigned* bar; unsigned x;
    volatile LAS unsigned* st;
};

__device__ __forceinline__ XcdBarrier xcd_barrier_post(unsigned* bar, volatile LAS unsigned* st) {
    XcdBarrier b; b.bar = bar; b.x = xb_xcc_id(); b.st = st;
    if (threadIdx.x == 0) (void)xb_add(&bar[XB_XCNT(b.x)], 1u);
    return b;
}
__device__ __forceinline__ void xcd_barrier_complete(unsigned* bar, unsigned x, unsigned& nloc, unsigned& nx) {
    const unsigned G = gridDim.x * gridDim.y * gridDim.z;
    unsigned sum, cnt, mine, sp = 0u;
    for (;;) {
        sum = 0u; cnt = 0u; mine = 0u;
#pragma unroll
        for (unsigned j = 0; j < 16; ++j) { const unsigned c = xb_ld(&bar[XB_XCNT(j)]); sum += c; cnt += (c > 0u) ? 1u : 0u; mine = (j == x) ? c : mine; }
        if (sum == G) break;
        __builtin_amdgcn_s_sleep(1);
        if ((++sp & 255u) == 0u) { if (xb_ld(&bar[XB_TMO])) break; if (sp > XB_SPIN_CAP) { atomicAdd(&bar[XB_TMO], 1u); break; } }
    }
    nloc = mine > 0u ? mine : 1u; nx = cnt > 0u ? cnt : 1u;
}

__device__ __forceinline__ void xcd_barrier(const XcdBarrier& b) {
    asm volatile("s_waitcnt vmcnt(0)" ::: "memory");
    __syncthreads();
    if (threadIdx.x == 0) {
        unsigned* bar = b.bar;
        __builtin_amdgcn_s_waitcnt(0);
        unsigned nloc = b.st[0], nx = b.st[1];
        if (nloc == 0u) { xcd_barrier_complete(bar, b.x, nloc, nx); b.st[0] = nloc; b.st[1] = nx; }
        const unsigned old = xb_add(&bar[XB_XSUB(b.x)], 1u);
        const unsigned gen = old / nloc;
        if (old + 1u == (gen + 1u) * nloc) {
            __builtin_amdgcn_fence(__ATOMIC_RELEASE, "agent");
            asm volatile("s_waitcnt vmcnt(0)" ::: "memory");
            const unsigned og = xb_add(&bar[XB_TOP], 1u);
            const unsigned tg = og / nx;
            if (og + 1u == (tg + 1u) * nx) xb_add(&bar[XB_TOPGEN], 1u);
            else XB_SPIN(xb_ld(&bar[XB_TOPGEN]) == tg, bar);
            __builtin_amdgcn_fence(__ATOMIC_ACQUIRE, "agent");
            xb_add(&bar[XB_XGEN(b.x)], 1u);
            asm volatile("s_waitcnt vmcnt(0)" ::: "memory");
        } else {
            XB_SPIN(xb_ld(&bar[XB_XGEN(b.x)]) == gen, bar);
            __builtin_amdgcn_fence(__ATOMIC_ACQUIRE, "agent");
            asm volatile("s_waitcnt vmcnt(0)" ::: "memory");
        }
    }
    __syncthreads();
}

struct Args { const float* in[25]; float* out; unsigned char* ws; int ph_lo, ph_hi, li, flags; };
#ifndef PROBE_PHASE
#define PROBE_PHASE -1
#endif

__device__ __forceinline__ void p0_transpose_item(const float* W, int ldw, int K, bf16* WT, LAS float* scr, int k0, int n0, int lane) {
#pragma unroll 8
    for (int i = 0; i < 32; ++i) { const int kk = 2 * i + (lane >> 5); scr[kk * 33 + (lane & 31)] = W[(size_t)(k0 + kk) * ldw + n0 + (lane & 31)]; }
    asm volatile("s_waitcnt lgkmcnt(0)" ::: "memory");
    const int c = lane & 7;
#pragma unroll
    for (int j = 0; j < 4; ++j) { const int n = (lane >> 3) + 8 * j; const LAS float* s = scr + (8 * c) * 33 + n;
        uint4 o; o.x = f2bf(s[0 * 33]) | ((unsigned)f2bf(s[1 * 33]) << 16); o.y = f2bf(s[2 * 33]) | ((unsigned)f2bf(s[3 * 33]) << 16); o.z = f2bf(s[4 * 33]) | ((unsigned)f2bf(s[5 * 33]) << 16); o.w = f2bf(s[6 * 33]) | ((unsigned)f2bf(s[7 * 33]) << 16);
        *(uint4*)(WT + (size_t)(n0 + n) * K + k0 + 8 * c) = o; }
    asm volatile("s_waitcnt lgkmcnt(0)" ::: "memory");
}
__device__ __forceinline__ void p0_transpose_item64(const float* W, int ldw, int K, bf16* WT, LAS unsigned char* scr, int k0, int n0, int lane) {
    const int q = lane >> 4, n4 = (lane & 15) * 4;
    float4 v[16];
#pragma unroll
    for (int i = 0; i < 16; ++i) v[i] = *(const float4*)(W + (size_t)(k0 + 8 * (i >> 1) + 2 * q + (i & 1)) * ldw + n0 + n4);
#pragma unroll
    for (int p = 0; p < 8; ++p) { const int kb = (8 * p + 2 * q) * 2;
        *(LAS unsigned*)(scr + (n4 + 0) * 144 + kb) = f2bf(v[2 * p].x) | ((unsigned)f2bf(v[2 * p + 1].x) << 16); *(LAS unsigned*)(scr + (n4 + 1) * 144 + kb) = f2bf(v[2 * p].y) | ((unsigned)f2bf(v[2 * p + 1].y) << 16);
        *(LAS unsigned*)(scr + (n4 + 2) * 144 + kb) = f2bf(v[2 * p].z) | ((unsigned)f2bf(v[2 * p + 1].z) << 16); *(LAS unsigned*)(scr + (n4 + 3) * 144 + kb) = f2bf(v[2 * p].w) | ((unsigned)f2bf(v[2 * p + 1].w) << 16); }
    asm volatile("s_waitcnt lgkmcnt(0)" ::: "memory");
    const int c = lane & 7;
#pragma unroll
    for (int jj = 0; jj < 8; ++jj) { const int n = (lane >> 3) + 8 * jj; const pg8::u32x4 o = *(const LAS pg8::u32x4*)(scr + n * 144 + c * 16); *(pg8::u32x4*)(WT + (size_t)(n0 + n) * K + k0 + 8 * c) = o; }
    asm volatile("s_waitcnt lgkmcnt(0)" ::: "memory");
}
__device__ __forceinline__ void p0_transpose_item64_f8(const float* W, int ldw, int K, unsigned char* WT8, LAS unsigned char* scr, int k0, int n0, int lane, float sc) {
    const int q = lane >> 4, n4 = (lane & 15) * 4;
    float4 v[16];
#pragma unroll
    for (int i = 0; i < 16; ++i) v[i] = *(const float4*)(W + (size_t)(k0 + 16 * (i >> 2) + 4 * q + (i & 3)) * ldw + n0 + n4);
#pragma unroll
    for (int p = 0; p < 4; ++p) { const int kb = 16 * p + 4 * q;
#define P0_PK4(comp) ({ int w_ = 0; w_ = __builtin_amdgcn_cvt_pk_fp8_f32(v[4 * p].comp * sc, v[4 * p + 1].comp * sc, w_, false); w_ = __builtin_amdgcn_cvt_pk_fp8_f32(v[4 * p + 2].comp * sc, v[4 * p + 3].comp * sc, w_, true); w_; })
        *(LAS int*)(scr + (n4 + 0) * 80 + kb) = P0_PK4(x); *(LAS int*)(scr + (n4 + 1) * 80 + kb) = P0_PK4(y); *(LAS int*)(scr + (n4 + 2) * 80 + kb) = P0_PK4(z); *(LAS int*)(scr + (n4 + 3) * 80 + kb) = P0_PK4(w);
#undef P0_PK4
    }
    asm volatile("s_waitcnt lgkmcnt(0)" ::: "memory");
    const int c = lane & 3;
#pragma unroll
    for (int jj = 0; jj < 4; ++jj) { const int n = (lane >> 2) + 16 * jj; const pg8::u32x4 o = *(const LAS pg8::u32x4*)(scr + n * 80 + c * 16); *(pg8::u32x4*)(WT8 + (size_t)(n0 + n) * K + k0 + 16 * c) = o; }
    asm volatile("s_waitcnt lgkmcnt(0)" ::: "memory");
}
__device__ __forceinline__ void ln_row_dev(const float* __restrict__ xrow, const float* __restrict__ g, const float* __restrict__ b, bf16* __restrict__ orow, int lane, unsigned char* __restrict__ o8 = nullptr) {
    const float4* xr = (const float4*)xrow + lane;
    float4 v[8]; float s = 0.f;
#pragma unroll
    for (int j = 0; j < 8; ++j) { v[j] = xr[64 * j]; s += (v[j].x + v[j].y) + (v[j].z + v[j].w); }
    const float mean = wave_sum(s) * (1.f / D); float q = 0.f;
#pragma unroll
    for (int j = 0; j < 8; ++j) { v[j].x -= mean; v[j].y -= mean; v[j].z -= mean; v[j].w -= mean; q += (v[j].x * v[j].x + v[j].y * v[j].y) + (v[j].z * v[j].z + v[j].w * v[j].w); }
    const float rstd = rsqrtf(wave_sum(q) * (1.f / D) + LN_EPS);
#pragma unroll
    for (int j = 0; j < 8; ++j) {
        const int c = 4 * lane + 256 * j; const float4 gg = *(const float4*)(g + c), bb = *(const float4*)(b + c);
        ushort4 o; o.x = f2bf(v[j].x * rstd * gg.x + bb.x); o.y = f2bf(v[j].y * rstd * gg.y + bb.y); o.z = f2bf(v[j].z * rstd * gg.z + bb.z); o.w = f2bf(v[j].w * rstd * gg.w + bb.w);
        *(ushort4*)(orow + c) = o;
        if (o8) { int w = 0; w = __builtin_amdgcn_cvt_pk_fp8_f32(v[j].x * rstd * gg.x + bb.x, v[j].y * rstd * gg.y + bb.y, w, false); w = __builtin_amdgcn_cvt_pk_fp8_f32(v[j].z * rstd * gg.z + bb.z, v[j].w * rstd * gg.w + bb.w, w, true); *(int*)(o8 + c) = w; } }
}

__global__ void __launch_bounds__(NWAVES * 64, 2) mk_fwd(Args args) {
    extern __shared__ __attribute__((aligned(16))) unsigned char lds_raw[];
    LAS unsigned char* lds = (LAS unsigned char*)lds_raw;
    volatile LAS unsigned* MISC = (volatile LAS unsigned*)(lds + MISC_OFF);
    const int tid = threadIdx.x, lane = tid & 63, wave = __builtin_amdgcn_readfirstlane(tid >> 6);
    const int G = gridDim.x, bx = blockIdx.x, vcu = (G % 8 == 0) ? (bx % 8) * (G / 8) + bx / 8 : bx;
    unsigned char* ws = args.ws; gu32* ctl = (gu32*)(ws + WS_CTL);
    for (int u = tid; u < (LDS_BYTES - LDSCTL_OFF) / 4; u += NWAVES * 64) ((LAS unsigned*)(lds + LDSCTL_OFF))[u] = 0u;
    __syncthreads();
    XcdBarrier bar = xcd_barrier_post((unsigned*)(ctl + CW_BAR) + args.li * XCD_BAR_WORDS, MISC + 8);
    const int lo = args.ph_lo, hi = args.ph_hi;
#define IN(k) (lo <= (k) && (k) < hi)
#define BOTH(k) (IN(k) && IN((k) + 1))
#define WSP(T_, off) ((T_*)(ws + (off)))
    bf16 *H0 = WSP(bf16, WS_H0), *W1T = WSP(bf16, WS_W1T), *WVT = WSP(bf16, WS_WVT), *WAT = WSP(bf16, WS_WAT), *WBT = WSP(bf16, WS_WBT), *WOT = WSP(bf16, WS_WOT), *W2T = WSP(bf16, WS_W2T),
         *WPT = WSP(bf16, WS_WPT), *PB = WSP(bf16, WS_PB), *KEYS = WSP(bf16, WS_KEYS), *NAQK = WSP(bf16, WS_NAQK), *GQK = WSP(bf16, WS_GQK),
         *GOUT = WSP(bf16, WS_GOUT), *GATES = WSP(bf16, WS_GATES), *LR = WSP(bf16, WS_LR), *VT = WSP(bf16, WS_VT);
    float *B1 = WSP(float, WS_B1), *BV = WSP(float, WS_BV);
    const int gw = vcu * NWAVES + wave, NGW = G * NWAVES;

    if (IN(0)) { for (int rep_ = 0; rep_ < (PROBE_PHASE == 0 ? 2 : 1); ++rep_) {
        const float* w_in = args.in[4];
        LAS float* scr = (LAS float*)(lds + wave * 16384);
        for (int m = gw; m < T; m += NGW) ln_row_dev(args.in[0] + (size_t)m * D, args.in[2], args.in[3], H0 + (size_t)m * D, lane, WSP(unsigned char, WS_H0F8) + (size_t)m * D);
        struct Seg { const float* W; bf16* WT; int ldw, col0, ncols, K, row0, pad; };
        LAS unsigned long long* segp = (LAS unsigned long long*)(lds + 8 * 16384); LAS int* segi = (LAS int*)(lds + 8 * 16384 + 512);
        if (tid < 16) { Seg sg{};
            switch (tid) {
                case 0: sg = Seg{w_in, W1T, IN_W, C_NAQ, 1024, D, 0, 0}; break; case 1: sg = Seg{w_in, W1T, IN_W, C_NAK, 1024, D, 1024, 0}; break;
                case 2: sg = Seg{w_in, W1T, IN_W, C_GQ, 1024, D, 2048, 0}; break; case 3: sg = Seg{w_in, W1T, IN_W, C_GK, 1024, D, 3072, 0}; break;
                case 4: sg = Seg{w_in, W1T, IN_W, C_GOUT, 2048, D, 4096, 0}; break; case 5: sg = Seg{w_in, W1T, IN_W, C_GA, 2048, D, 6144, 0}; break;
                case 6: sg = Seg{w_in, W1T, IN_W, C_GB, 2048, D, 8192, 0}; break; case 7: sg = Seg{w_in, W1T, IN_W, C_LRF, 32, D, 10240, 0}; break;
                case 8: sg = Seg{w_in, WVT, IN_W, C_NAV, 1024, D, 0, 0}; break; case 9: sg = Seg{w_in, WVT, IN_W, C_GV, 2048, D, 1024, 0}; break;
                case 10: sg = Seg{args.in[12], WAT, D, 0, D, NA_W, 0, 0}; break; case 11: sg = Seg{args.in[13], WBT, D, 0, D, GV, 0, 0}; break;
                case 12: sg = Seg{args.in[14], WOT, D, 0, D, D, 0, 0}; break; case 13: sg = Seg{args.in[22], W2T, D, 0, D, D, 0, 0}; break;
                case 14: sg = Seg{args.in[17], W2T, D, 0, D, D, 2048, 0}; break; default: sg = Seg{args.in[21], WPT, D, 0, D, PLE, 0, 0}; break; }
            segp[2 * tid] = (unsigned long long)sg.W; segp[2 * tid + 1] = (unsigned long long)sg.WT; segi[8 * tid] = sg.ldw; segi[8 * tid + 1] = sg.col0; segi[8 * tid + 2] = sg.ncols; segi[8 * tid + 3] = sg.K; segi[8 * tid + 4] = sg.row0; }
        __syncthreads();
        int base = 0;
        for (int sgi = 0; sgi < 16; ++sgi) { Seg sg; sg.W = (const float*)segp[2 * sgi]; sg.WT = (bf16*)segp[2 * sgi + 1]; sg.ldw = segi[8 * sgi]; sg.col0 = segi[8 * sgi + 1]; sg.ncols = segi[8 * sgi + 2]; sg.K = segi[8 * sgi + 3]; sg.row0 = segi[8 * sgi + 4]; const bool wide = (sg.ncols % 64) == 0; const int nblk = sg.ncols / (wide ? 64 : 32), nit = nblk * (sg.K / 64);
            int first = gw - (base % NGW); if (first < 0) first += NGW;
            for (int it = first; it < nit; it += NGW) { if (wide && sgi <= 13) p0_transpose_item64_f8(sg.W + sg.col0, sg.ldw, sg.K, (sgi < 8 ? WSP(unsigned char, WS_W1F8) : sgi < 10 ? WSP(unsigned char, WS_WVF8) : sgi == 10 ? WSP(unsigned char, WS_WAT) : sgi == 11 ? WSP(unsigned char, WS_WBT) : sgi == 12 ? WSP(unsigned char, WS_WOT) : WSP(unsigned char, WS_W2F8)) + (size_t)sg.row0 * sg.K, (LAS unsigned char*)scr, 64 * (it / nblk), 64 * (it % nblk), lane, 64.f);
                else if (wide) p0_transpose_item64(sg.W + sg.col0, sg.ldw, sg.K, sg.WT + (size_t)sg.row0 * sg.K, (LAS unsigned char*)scr, 64 * (it / nblk), 64 * (it % nblk), lane);
                else if (sgi != 7) p0_transpose_item(sg.W + sg.col0, sg.ldw, sg.K, sg.WT + (size_t)sg.row0 * sg.K, scr, 64 * (it / nblk), 32 * (it % nblk), lane); }
            base += nit; }
        const int gt = vcu * NWAVES * 64 + tid, NGT = G * NWAVES * 64;
        for (int i = gt; i < (N1 - 10272) * D / 16; i += NGT) ((uint4*)(WSP(unsigned char, WS_W1F8) + (size_t)10272 * D))[i] = make_uint4(0u, 0u, 0u, 0u);
        for (int i = gt; i < 32 * D / 4; i += NGT) { const int n = i / (D / 4), k4 = (i % (D / 4)) * 4; const float* wp = w_in + (size_t)k4 * IN_W + C_LRF + n;
            int w = 0; w = __builtin_amdgcn_cvt_pk_fp8_f32(wp[0] * 64.f, wp[IN_W] * 64.f, w, false); w = __builtin_amdgcn_cvt_pk_fp8_f32(wp[2 * (size_t)IN_W] * 64.f, wp[3 * (size_t)IN_W] * 64.f, w, true);
            *(int*)(WSP(unsigned char, WS_W1F8) + (size_t)(10240 + n) * D + k4) = w; }
        for (int i = gt; i < T * PLE / 4; i += NGT) { const float4 v = ((const float4*)args.in[1])[i]; ushort4 o; o.x = f2bf(v.x); o.y = f2bf(v.y); o.z = f2bf(v.z); o.w = f2bf(v.w); ((ushort4*)PB)[i] = o; }
        for (int i = gt; i < PH * 2 * PNK * 128 / 4; i += NGT) { const float4 v = ((const float4*)args.in[18])[i]; ushort4 o; o.x = f2bf(v.x); o.y = f2bf(v.y); o.z = f2bf(v.z); o.w = f2bf(v.w); ((ushort4*)KEYS)[i] = o; }
        for (int i = gt; i < N1; i += NGT) { const int c = orig_col_main(i); B1[i] = c >= 0 ? args.in[5][c] : 0.f; }
        for (int i = gt; i < 3072; i += NGT) BV[i] = args.in[5][i < 1024 ? C_NAV + i : C_GV + (i - 1024)];
        if (PROBE_PHASE == 0) __syncthreads(); }
        if (BOTH(0)) xcd_barrier(bar);
    }
    if (IN(1)) { for (int rep_ = 0; rep_ < (PROBE_PHASE == 1 ? 2 : 1); ++rep_) {
        pg8::Gemm g{(const bf16*)WSP(unsigned char, WS_H0F8), (const bf16*)WSP(unsigned char, WS_W1F8), (const bf16*)WSP(unsigned char, WS_WVF8), (const bf16*)WSP(unsigned char, WS_H0F8), D / 2}; pg8::Order2 S; S.init(T, N1, 3072, T, G, bx);
        pg8::Epi<EK_MAIN> E; E.e = EpiArgs{}; E.e.bias = B1; E.e.bias2 = BV; E.e.o0 = NAQK; E.e.o1 = GQK; E.e.o2 = GOUT; E.e.o3 = GATES; E.e.o4 = LR; E.e.o5 = VT;
        pg8::gemm_phase<pg8::Epi<EK_MAIN>, pg8::Order2, true, true, true>(lds, g, S, E);
        { const int n1u = (T / 256) * (N1 / 256) + (3072 / 256) * (T / 256), rem = n1u % G;
          if (rem != 0 && bx >= rem) { int kple = PLE; asm volatile("" : "+s"(kple));
            pg8::Gemm g2{PB, WPT, PB, WPT, kple}; pg8::Order2 S2; S2.init(T, D, 0, 0, G - rem, bx - rem);
            pg8::Epi<EK_PLE> E2; E2.e = EpiArgs{}; E2.e.o0 = WSP(bf16, WS_PLELIN);
            pg8::gemm_phase<pg8::Epi<EK_PLE>, pg8::Order2, true, true>(lds, g2, S2, E2); } }
        if (PROBE_PHASE == 1) __syncthreads(); }
        if (BOTH(1)) xcd_barrier(bar);
    }
    bf16 *YNA = WSP(bf16, WS_YNA), *TMP = WSP(bf16, WS_TMP), *OG = WSP(bf16, WS_OG), *MERGED = WSP(bf16, WS_MERGED), *H1 = WSP(bf16, WS_H1), *PLELIN = WSP(bf16, WS_PLELIN), *PLEB = WSP(bf16, WS_PLEB), *QP = WSP(bf16, WS_QP);
    float* R1 = WSP(float, WS_R1);
    const bf16* OF = (args.flags & 1) ? WSP(bf16, WS_OF) : WSP(bf16, WS_NAQK); const bf16* OB = (args.flags & 1) ? WSP(bf16, WS_OB) : WSP(bf16, WS_GQK);
    float *AF = WSP(float, WS_AF), *AB = WSP(float, WS_AB), *GP = WSP(float, WS_GATEP); int* IDS = WSP(int, WS_IDS);
    const int gt_ = vcu * NWAVES * 64 + tid, NGT_ = G * NWAVES * 64;
    if (IN(2)) { for (int rep_ = 0; rep_ < (PROBE_PHASE == 2 ? 2 : 1); ++rep_) {
        for (int rr_ = 0; rr_ < (PROBE_PHASE == 20 ? 2 : 1); ++rr_)
        for (int it = bx; it < BATCH * NA_H * (ROWS / 8); it += G) na_item(lds, NAQK, VT, args.in[6], YNA, it >> 6, (it >> 2) & 15, it & 3, tid);
        __syncthreads();
        for (int rr_ = 0; rr_ < (PROBE_PHASE == 21 ? 2 : 1); ++rr_)
        gla_pre_block(lds, GQK, LR, args.in[7], args.in[8], args.in[9], args.in[10], WSP(bf16, WS_QD), WSP(bf16, WS_KST), WSP(bf16, WS_ATT), WSP(float, WS_DEC), bx, G, tid);
        __syncthreads();
        if (PROBE_PHASE == 2) __syncthreads(); }
        if (BOTH(2)) xcd_barrier(bar);
    }
    if (IN(3)) { for (int rep_ = 0; rep_ < (PROBE_PHASE == 3 ? 2 : 1); ++rep_) {
        for (int rr_ = 0; rr_ < (PROBE_PHASE == 30 ? 2 : 1); ++rr_)
        for (int it = bx; it < 256; it += G) { const int grp_ = (it & 7) * 4 + (it >> 6), sl = (it >> 3) & 7, dir = grp_ & 1, h = (grp_ >> 1) & 3, b = grp_ >> 3;
            gla_scan_item(lds, WSP(bf16, WS_QD) + (size_t)dir * T * 1024, WSP(bf16, WS_KST) + (size_t)dir * 512 * 256 * 64, WSP(bf16, WS_ATT) + (size_t)dir * 512 * 4096, WSP(float, WS_DEC) + (size_t)dir * 512 * 256,
                          VT, dir ? WSP(bf16, WS_GQK) : WSP(bf16, WS_NAQK), b, h, dir, sl, tid); }
        __syncthreads();
        pg8::Gemm g{YNA, WAT, YNA, WAT, NA_W / 2}; pg8::Order2 S; S.init(T, D, 0, 0, G, bx);
        pg8::Epi<EK_A> E; E.e = EpiArgs{}; E.e.o0 = TMP; E.e.a0 = GATES;
        pg8::gemm_phase<pg8::Epi<EK_A>, pg8::Order2, true, true, true>(lds, g, S, E);
        if (PROBE_PHASE == 3) __syncthreads(); }
        if (BOTH(3)) xcd_barrier(bar);
    }
    if (IN(4)) { for (int rep_ = 0; rep_ < (PROBE_PHASE == 4 ? 2 : 1); ++rep_) {
        const float* ng = args.in[11];
        const pg8::f32x4 n0 = *(const pg8::f32x4*)(ng + lane * 8), n1 = *(const pg8::f32x4*)(ng + lane * 8 + 4);
        for (int task = gw; task < T * GH; task += 2 * NGW) {
            const int task2 = task + NGW; const bool two = task2 < T * GH; const int tk2 = two ? task2 : task;
            const size_t base = (size_t)(task >> 2) * 2048 + (task & 3) * 512 + lane * 8, base2 = (size_t)(tk2 >> 2) * 2048 + (tk2 & 3) * 512 + lane * 8;
            pg8::f32x4 a0, a1, b0, b1, g0, g1, c0, c1, d0, d1, e0, e1;
            pg8::ld8bf(OF + base, a0, a1); pg8::ld8bf(OB + base, b0, b1); pg8::ld8bf(GOUT + base, g0, g1); pg8::ld8bf(OF + base2, c0, c1); pg8::ld8bf(OB + base2, d0, d1); pg8::ld8bf(GOUT + base2, e0, e1);
            a0 += b0; a1 += b1; c0 += d0; c1 += d1; const pg8::f32x4 q4 = a0 * a0 + a1 * a1, q5 = c0 * c0 + c1 * c1;
            const float r = rsqrtf(wave_sum((q4[0] + q4[1]) + (q4[2] + q4[3])) * (1.f / 512.f) + LN_EPS), r2 = rsqrtf(wave_sum((q5[0] + q5[1]) + (q5[2] + q5[3])) * (1.f / 512.f) + LN_EPS);
            pg8::st8f8((unsigned char*)OG + base, a0 * r * n0 * g0, a1 * r * n1 * g1);
            if (two) pg8::st8f8((unsigned char*)OG + base2, c0 * r2 * n0 * e0, c1 * r2 * n1 * e1); }
        if (PROBE_PHASE == 4) __syncthreads(); }
        if (BOTH(4)) xcd_barrier(bar);
    }
    if (IN(5)) { for (int rep_ = 0; rep_ < (PROBE_PHASE == 5 ? 2 : 1); ++rep_) {
        pg8::Gemm g{OG, WBT, OG, WBT, GV / 2}; pg8::Order2 S; S.init(T, D, 0, 0, G, bx);
        pg8::Epi<EK_B> E; E.e = EpiArgs{}; E.e.o0 = MERGED; E.e.a0 = GATES; E.e.a1 = TMP;
        pg8::gemm_phase<pg8::Epi<EK_B>, pg8::Order2, true, true, true>(lds, g, S, E);
        if (PROBE_PHASE == 5) __syncthreads(); }
        if (BOTH(5)) xcd_barrier(bar);
    }
    if (IN(6)) { for (int rep_ = 0; rep_ < (PROBE_PHASE == 6 ? 2 : 1); ++rep_) {
        pg8::Gemm g{MERGED, WOT, MERGED, WOT, D / 2}; pg8::Order2 S; S.init(T, D, 0, 0, G, bx);
        if (G == 256) { pg8::EpiLnOut E{H0, args.in[15], args.in[16], H1, WSP(unsigned char, WS_H1F8), WSP(unsigned long long, WS_LNX), (unsigned*)(ctl + 16384), (unsigned*)(ctl + CW_TMO)};
            pg8::gemm_phase<pg8::EpiLnOut, pg8::Order2, false, true, true>(lds, g, S, E); }
        else { pg8::Epi<EK_OUT> E; E.e = EpiArgs{}; E.e.of = R1; E.e.a0 = H0;
            pg8::gemm_phase<pg8::Epi<EK_OUT>, pg8::Order2, true, true, true>(lds, g, S, E); }
#if FP4_LOW == 3
        for (int r = gw; r < 2 * PNK * PNK; r += NGW) { if (r < PNK * PNK) f4_row(args.in[19], WSP(unsigned char, WS_U4), WSP(float, WS_RSU), r, lane); else f4_row(args.in[20], WSP(unsigned char, WS_V4), WSP(float, WS_RSV), r - PNK * PNK, lane); }
#else
        for (int r = gw; r < 2 * PNK * PNK; r += NGW) { if (r < PNK * PNK) f6_row<false>(args.in[19], WSP(unsigned char, WS_U8), WSP(unsigned char, WS_U4), WSP(float, WS_RSU), r, lane); else f6_row<true>(args.in[20], WSP(unsigned char, WS_V8), WSP(unsigned char, WS_V4), WSP(float, WS_RSV), r - PNK * PNK, lane); }
#endif
        if (PROBE_PHASE == 6) __syncthreads(); }
        if (BOTH(6)) xcd_barrier(bar);
    }
    const bool p7_needed = (G != 256) || ((((T / 256) * (N1 / 256) + (3072 / 256) * (T / 256)) % G) == 0);
    if (IN(7) && p7_needed) { for (int rep_ = 0; rep_ < (PROBE_PHASE == 7 ? 2 : 1); ++rep_) {
        if (G != 256) for (int m = gw; m < T; m += NGW) ln_row_dev(R1 + (size_t)m * D, args.in[15], args.in[16], H1 + (size_t)m * D, lane, WSP(unsigned char, WS_H1F8) + (size_t)m * D);
        if ((((T / 256) * (N1 / 256) + (3072 / 256) * (T / 256)) % G) == 0) {
        int kple = PLE; asm volatile("" : "+s"(kple));
        pg8::Gemm g{PB, WPT, PB, WPT, kple}; pg8::Order2 S; S.init(T, D, 0, 0, G, bx);
        pg8::Epi<EK_PLE> E; E.e = EpiArgs{}; E.e.o0 = PLELIN;
        pg8::gemm_phase<pg8::Epi<EK_PLE>, pg8::Order2, true, true>(lds, g, S, E); }
        if (PROBE_PHASE == 7) __syncthreads(); }
        if (BOTH(7)) xcd_barrier(bar);
    }
    if (IN(8)) { for (int rep_ = 0; rep_ < (PROBE_PHASE == 8 ? 2 : 1); ++rep_) {
        { pg8::Gemm g{(const bf16*)WSP(unsigned char, WS_H1F8), (const bf16*)WSP(unsigned char, WS_W2F8), (const bf16*)WSP(unsigned char, WS_H1F8), (const bf16*)WSP(unsigned char, WS_W2F8), D / 2}; pg8::Order2 S; S.init(T, D, 0, 0, G, bx);
          pg8::Epi<EK_2> E; E.e = EpiArgs{}; E.e.o0 = PLEB; E.e.o1 = QP; E.e.a0 = PLELIN;
          pg8::gemm_phase<pg8::Epi<EK_2>, pg8::Order2, true, true, true>(lds, g, S, E); }
        { pg8::Gemm g{H1, W2T + (size_t)2048 * D, H1, W2T + (size_t)2048 * D, D}; pg8::Order2 S; S.init(T, D, 0, 0, G, bx);
          pg8::Epi<EK_2> E; E.e = EpiArgs{}; E.e.o0 = PLEB; E.e.o1 = QP; E.e.a0 = PLELIN; E.e.qonly = 1;
          pg8::gemm_phase<pg8::Epi<EK_2>, pg8::Order2, true, true, false>(lds, g, S, E); }
        if (PROBE_PHASE == 8) __syncthreads(); }
        if (BOTH(8)) xcd_barrier(bar);
    }
    if (IN(9)) { for (int rep_ = 0; rep_ < (PROBE_PHASE == 9 ? 2 : 1); ++rep_) {
        for (int tile = bx; tile < T / 16; tile += G)
            peer_tile(lds, QP, KEYS, H1, WSP(unsigned char, WS_U8), WSP(unsigned char, WS_V8), WSP(unsigned char, WS_U4), WSP(unsigned char, WS_V4), WSP(float, WS_RSU), WSP(float, WS_RSV), PLEB, args.in[23], args.in[24], args.out, tile, tid);
    } }
#undef IN
#undef BOTH
#undef WSP
}

extern "C" void kernel_launch(void* const* d_in, const int* in_sizes, int n_in, void* d_out, int out_size, void* d_ws, size_t ws_size, hipStream_t stream) {
    (void)in_sizes; (void)n_in; (void)out_size; (void)ws_size;
    const float* x = (const float*)d_in[0]; const float* p = (const float*)d_in[1]; const float* ln_e_g = (const float*)d_in[2]; const float* ln_e_b = (const float*)d_in[3];
    const float* w_in = (const float*)d_in[4]; const float* b_in = (const float*)d_in[5]; const float* rpb = (const float*)d_in[6];
    const float* up_f = (const float*)d_in[7]; const float* gb_f = (const float*)d_in[8]; const float* up_b = (const float*)d_in[9]; const float* gb_b = (const float*)d_in[10];
    const float* norm_g = (const float*)d_in[11]; const float* w_pa = (const float*)d_in[12]; const float* w_pb = (const float*)d_in[13]; const float* w_out = (const float*)d_in[14];
    const float* ln_a_g = (const float*)d_in[15]; const float* ln_a_b = (const float*)d_in[16]; const float* peer_wq = (const float*)d_in[17]; const float* sub_keys = (const float*)d_in[18];
    const float* peer_u = (const float*)d_in[19]; const float* peer_v = (const float*)d_in[20]; const float* w_ple = (const float*)d_in[21]; const float* w_pg = (const float*)d_in[22];
    const float* ln_b_g = (const float*)d_in[23]; const float* ln_b_b = (const float*)d_in[24];
    unsigned char* ws = (unsigned char*)d_ws; float* out = (float*)d_out;
#define WSP(T_, off) ((T_*)(ws + (off)))
    static int grid = 0;
    if (grid == 0) {
        int dev = 0, cus = 0; (void)hipGetDevice(&dev); (void)hipDeviceGetAttribute(&cus, hipDeviceAttributeMultiprocessorCount, dev);
        if (hipFuncSetAttribute((const void*)mk_fwd, hipFuncAttributeMaxDynamicSharedMemorySize, LDS_BYTES) != hipSuccess) { fprintf(stderr, "hipFuncSetAttribute failed\n"); grid = -1; return; }
        int per_cu = 0; (void)hipOccupancyMaxActiveBlocksPerMultiprocessor(&per_cu, (const void*)mk_fwd, NWAVES * 64, LDS_BYTES); (void)hipGetLastError();
        if (per_cu < 1) fprintf(stderr, "occupancy query reports %d blocks per CU\n", per_cu);
        grid = cus;
    }
    if (grid < 0) return;
    (void)hipMemsetAsync(ws + WS_CTL, 0, 1 * MiB, stream);
    { Args a{}; for (int i = 0; i < 25; ++i) a.in[i] = (const float*)d_in[i]; a.out = out; a.ws = ws; a.ph_lo = 0; a.ph_hi = 10; a.li = 0; a.flags = 0;
      hipLaunchKernelGGL(mk_fwd, dim3(grid), dim3(NWAVES * 64), LDS_BYTES, stream, a); }
}
```

```cpp
#include <hip/hip_runtime.h>
#include <cstdio>
#include <cstdint>

typedef unsigned short bf16;
#define DEV __device__ __forceinline__

constexpr int D = 2048, BATCH = 4, SEQ = 2048, T = BATCH * SEQ;
constexpr int GRID_W = 64, ROWS = SEQ / GRID_W;
constexpr int NA_H = 16, NA_DH = 64, NA_W = 1024, WIN_R = 8, WIN_C = 16;
constexpr int GH = 4, GDK = 256, GDV = 512, GK = 1024, GV = 2048, GRANK = 16;
constexpr int PH = 8, PNK = 128, PTOPK = 16, PLE = 256;
constexpr int IN_W = 13344;
constexpr float LN_EPS = 1e-5f;
constexpr float ALPHA = 1.189207115002721f;

constexpr int C_NAQ = 0, C_NAK = 1024, C_NAV = 2048, C_GQ = 3072, C_GK = 4096, C_GV = 5120, C_GOUT = 7168, C_LRF = 9216, C_LRB = 9232, C_GA = 9248, C_GB = 11296;
constexpr int N1 = 10496;

constexpr size_t MiB = 1u << 20;
constexpr size_t WS_CTL = 0, WS_H0 = 1 * MiB, WS_W1T = 33 * MiB, WS_WVT = 74 * MiB, WS_WAT = 86 * MiB, WS_WBT = 90 * MiB, WS_WOT = 98 * MiB, WS_W2T = 106 * MiB,
                 WS_WPT = 122 * MiB, WS_PB = 123 * MiB, WS_KEYS = 127 * MiB, WS_B1 = 127 * MiB + 512 * 1024, WS_BV = 127 * MiB + 640 * 1024,
                 WS_RSU = 127 * MiB + 768 * 1024, WS_RSV = 127 * MiB + 896 * 1024,
                 WS_U8 = 192 * MiB, WS_V8 = 160 * MiB,
                 WS_U4 = 352 * MiB, WS_V4 = 368 * MiB,
                 WS_AF = 128 * MiB, WS_AB = 160 * MiB,
                 WS_OF = 192 * MiB, WS_OB = 224 * MiB,
                 WS_NAQK = 256 * MiB, WS_GQK = 288 * MiB, WS_GOUT = 320 * MiB, WS_GATES = 352 * MiB, WS_LR = 416 * MiB,
                 WS_VT = 420 * MiB, WS_YNA = 468 * MiB, WS_IDS = 484 * MiB, WS_GATEP = 488 * MiB,
                 WS_W1F8 = 33 * MiB, WS_H0F8 = 54 * MiB, WS_WVF8 = 74 * MiB, WS_W2F8 = 106 * MiB, WS_H1F8 = 54 * MiB,
                 WS_LNX = 502 * MiB,
                 WS_QD = 192 * MiB, WS_KST = 224 * MiB,
                 WS_ATT = 493 * MiB, WS_DEC = 501 * MiB,
                 WS_TMP = 33 * MiB,
                 WS_OG = 192 * MiB,
                 WS_MERGED = 224 * MiB,
                 WS_R1 = 256 * MiB,
                 WS_H1 = 320 * MiB,
                 WS_PLELIN = 128 * MiB, WS_PLEB = 384 * MiB,
                 WS_QP = 420 * MiB;

DEV float bf2f(bf16 v) { return __uint_as_float((unsigned)v << 16); }
DEV bf16 f2bf(float f) { unsigned u = __float_as_uint(f); return (bf16)((u + 0x7fffu + ((u >> 16) & 1u)) >> 16); }
DEV float sigmoidf_(float x) { return __builtin_amdgcn_rcpf(1.f + __builtin_amdgcn_exp2f(x * -1.44269504f)); }
#define WR_DPP(x, ctl) __builtin_bit_cast(float, __builtin_amdgcn_mov_dpp(__builtin_bit_cast(int, x), ctl, 0xf, 0xf, true))
DEV float wave_sum(float v) {
    v += WR_DPP(v, 0xB1); v += WR_DPP(v, 0x4E); v += WR_DPP(v, 0x141); v += WR_DPP(v, 0x140);
    { const auto p = __builtin_amdgcn_permlane16_swap(__float_as_uint(v), __float_as_uint(v), false, false); v = __uint_as_float(p[0]) + __uint_as_float(p[1]); }
    { const auto p = __builtin_amdgcn_permlane32_swap(__float_as_uint(v), __float_as_uint(v), false, false); v = __uint_as_float(p[0]) + __uint_as_float(p[1]); }
    return v;
}
DEV float wave_max(float v) {
    v = fmaxf(v, WR_DPP(v, 0xB1)); v = fmaxf(v, WR_DPP(v, 0x4E)); v = fmaxf(v, WR_DPP(v, 0x141)); v = fmaxf(v, WR_DPP(v, 0x140));
    { const auto p = __builtin_amdgcn_permlane16_swap(__float_as_uint(v), __float_as_uint(v), false, false); v = fmaxf(__uint_as_float(p[0]), __uint_as_float(p[1])); }
    { const auto p = __builtin_amdgcn_permlane32_swap(__float_as_uint(v), __float_as_uint(v), false, false); v = fmaxf(__uint_as_float(p[0]), __uint_as_float(p[1])); }
    return v;
}

DEV int orig_col_main(int n) {
    if (n < 1024) return C_NAQ + n; if (n < 2048) return C_NAK + (n - 1024); if (n < 3072) return C_GQ + (n - 2048); if (n < 4096) return C_GK + (n - 3072);
    if (n < 6144) return C_GOUT + (n - 4096); if (n < 8192) return C_GA + (n - 6144); if (n < 10240) return C_GB + (n - 8192); if (n < 10272) return C_LRF + (n - 10240); return -1; }
struct EpiArgs { const float* bias; const float* bias2; bf16* o0; bf16* o1; bf16* o2; bf16* o3; bf16* o4; bf16* o5; float* of; const bf16* a0; const bf16* a1; int qonly; int pad; };
enum { EK_MAIN = 0, EK_VT = 1, EK_A = 2, EK_B = 3, EK_OUT = 4, EK_PLE = 5, EK_2 = 6 };
DEV void na_naive_task(const bf16* __restrict__ NAQK, const bf16* __restrict__ VT, const float* __restrict__ rpb, bf16* __restrict__ YNA, int task, int lane) {
    const int tok = task >> 4, h = task & 15, b = tok >> 11, s = tok & 2047, r = s >> 6, c = s & 63;
    const int r0 = min(max(r - WIN_R / 2, 0), ROWS - WIN_R), c0 = min(max(c - WIN_C / 2, 0), GRID_W - WIN_C);
    const bf16* q = NAQK + (size_t)tok * 2048 + h * 64;
    float sc[2];
#pragma unroll
    for (int u = 0; u < 2; ++u) {
        const int kidx = lane + 64 * u, i = kidx >> 4, j = kidx & 15, kt = b * 2048 + (r0 + i) * 64 + c0 + j;
        const bf16* kp = NAQK + (size_t)kt * 2048 + 1024 + h * 64; float a = 0.f;
        for (int d = 0; d < 64; ++d) a += bf2f(q[d]) * bf2f(kp[d]);
        sc[u] = a + rpb[(h * 15 + (r0 + i - r + WIN_R - 1)) * 31 + (c0 + j - c + WIN_C - 1)];
    }
    const float mx = wave_max(fmaxf(sc[0], sc[1]));
    const float p0 = __expf(sc[0] - mx), p1 = __expf(sc[1] - mx), inv = 1.f / wave_sum(p0 + p1);
    float o = 0.f;
    const bf16* vrow = VT + (size_t)(h * 64 + lane) * T;
    for (int kidx = 0; kidx < 128; ++kidx) {
        const float p = __shfl(kidx < 64 ? p0 : p1, kidx & 63);
        const int i = kidx >> 4, j = kidx & 15, kt = b * 2048 + (r0 + i) * 64 + c0 + j;
        o += p * bf2f(vrow[kt]);
    }
    YNA[(size_t)tok * 1024 + h * 64 + lane] = f2bf(o * inv);
}

DEV void gla_decay_elem(const bf16* __restrict__ LR, const float* __restrict__ upf, const float* __restrict__ bf_, const float* __restrict__ upb, const float* __restrict__ bb_, float* __restrict__ AF, float* __restrict__ AB, size_t i) {
    const int tok = (int)(i >> 10), ch = (int)(i & 1023);
    float gf = bf_[ch], gb = bb_[ch];
#pragma unroll
    for (int r = 0; r < 16; ++r) { gf += bf2f(LR[(size_t)tok * 256 + r]) * upf[r * 1024 + ch]; gb += bf2f(LR[(size_t)tok * 256 + 16 + r]) * upb[r * 1024 + ch]; }
    const float lf = fminf(gf, 0.f) - log1pf(__expf(-fabsf(gf))), lb = fminf(gb, 0.f) - log1pf(__expf(-fabsf(gb)));
    AF[i] = __expf(lf * (1.f / 16.f)); AB[i] = __expf(lb * (1.f / 16.f));
}
DEV void gla_naive_thread(const bf16* __restrict__ GQK, const bf16* __restrict__ VT, const float* __restrict__ AF, const float* __restrict__ AB, bf16* __restrict__ OF, bf16* __restrict__ OB, int gid) {
    const int kq = gid & 3, dv = (gid >> 2) & 511, bhd = gid >> 11, dir = bhd & 1, h = (bhd >> 1) & 3, b = bhd >> 3;
    const float* Adec = dir ? AB : AF; bf16* O = dir ? OB : OF;
    const bf16* vrow = VT + (size_t)(1024 + h * 512 + dv) * T + (size_t)b * 2048;
    float s[64];
#pragma unroll
    for (int k = 0; k < 64; ++k) s[k] = 0.f;
    for (int tt = 0; tt < SEQ; ++tt) {
        const int t = dir ? SEQ - 1 - tt : tt; const size_t tok = (size_t)b * 2048 + t;
        const bf16* qp = GQK + tok * 2048 + h * 256 + kq * 64; const bf16* kp = qp + 1024; const float* ap = Adec + tok * 1024 + h * 256 + kq * 64;
        const float v = bf2f(vrow[t]); float o = 0.f;
        if (dir == 0) {
#pragma unroll
            for (int k = 0; k < 64; ++k) { s[k] = ap[k] * s[k] + bf2f(kp[k]) * v; o += bf2f(qp[k]) * s[k]; }
        } else {
#pragma unroll
            for (int k = 0; k < 64; ++k) { const float sd = ap[k] * s[k]; o += bf2f(qp[k]) * sd; s[k] = sd + bf2f(kp[k]) * v; }
        }
        o += __shfl_xor(o, 1); o += __shfl_xor(o, 2);
        if (kq == 0) O[tok * 2048 + h * 512 + dv] = f2bf(o);
    }
}
DEV void peer_topk_task(const bf16* __restrict__ QP, const bf16* __restrict__ KEYS, int* __restrict__ IDS, float* __restrict__ GP, int task, int n, __attribute__((address_space(3))) float* sm) {
    __attribute__((address_space(3))) float (*sc)[128] = (__attribute__((address_space(3))) float (*)[128])sm;
    __attribute__((address_space(3))) float (*tv)[16] = (__attribute__((address_space(3))) float (*)[16])(sm + 256);
    __attribute__((address_space(3))) int (*ti)[16] = (__attribute__((address_space(3))) int (*)[16])(sm + 288);
    __attribute__((address_space(3))) float* cv = sm + 320; __attribute__((address_space(3))) float* fv = sm + 576; __attribute__((address_space(3))) int* fi = (__attribute__((address_space(3))) int*)(sm + 592);
    const int tok = task >> 3, h = task & 7;
#pragma unroll
    for (int half = 0; half < 2; ++half) {
        const bf16* q = QP + (size_t)tok * 2048 + h * 256 + half * 128; const bf16* kp = KEYS + ((size_t)(h * 2 + half) * 128 + n) * 128; float a = 0.f;
        for (int k = 0; k < 128; ++k) a += bf2f(q[k]) * bf2f(kp[k]);
        sc[half][n] = a;
    }
    __syncthreads();
#pragma unroll
    for (int half = 0; half < 2; ++half) { const float v = sc[half][n]; int rank = 0;
        for (int m = 0; m < 128; ++m) { const float w = sc[half][m]; rank += (w > v || (w == v && m < n)) ? 1 : 0; }
        if (rank < 16) { tv[half][rank] = v; ti[half][rank] = n; } }
    __syncthreads();
    for (int c = n; c < 256; c += 128) cv[c] = tv[0][c >> 4] + tv[1][c & 15];
    __syncthreads();
    for (int c = n; c < 256; c += 128) { const float v = cv[c]; int rank = 0;
        for (int m = 0; m < 256; ++m) { const float w = cv[m]; rank += (w > v || (w == v && m < c)) ? 1 : 0; }
        if (rank < 16) { fv[rank] = v; fi[rank] = ti[0][c >> 4] * 128 + ti[1][c & 15]; } }
    __syncthreads();
    if (n < 16) { float mx = fv[0], sum = 0.f;
        for (int m = 0; m < 16; ++m) sum += __expf(fv[m] - mx);
        IDS[(size_t)tok * 128 + h * 16 + n] = fi[n]; GP[(size_t)tok * 128 + h * 16 + n] = __expf(fv[n] - mx) / sum; }
}
DEV void peer_gather_naive_tok(const bf16* __restrict__ H1, const int* __restrict__ IDS, const float* __restrict__ GP, const float* __restrict__ U, const float* __restrict__ V,
                              const bf16* __restrict__ PLEB, const float* __restrict__ lg, const float* __restrict__ lb, float* __restrict__ out, int tok, int lane) {
    float x[32], y[32];
#pragma unroll
    for (int j = 0; j < 8; ++j)
#pragma unroll
        for (int i = 0; i < 4; ++i) { x[j * 4 + i] = bf2f(H1[(size_t)tok * 2048 + 256 * j + 4 * lane + i]); y[j * 4 + i] = 0.f; }
    for (int e = 0; e < 128; ++e) {
        const int id = IDS[(size_t)tok * 128 + e]; const float g = GP[(size_t)tok * 128 + e];
        const float4* ur = (const float4*)(U + (size_t)id * 2048) + lane; const float4* vr = (const float4*)(V + (size_t)id * 2048) + lane;
        float a = 0.f;
#pragma unroll
        for (int j = 0; j < 8; ++j) { const float4 u4 = ur[64 * j]; a += u4.x * x[j * 4] + u4.y * x[j * 4 + 1] + u4.z * x[j * 4 + 2] + u4.w * x[j * 4 + 3]; }
        a = wave_sum(a);
        const float w = g * (0.5f * a * (1.f + erff(a * 0.70710678f)));
#pragma unroll
        for (int j = 0; j < 8; ++j) { const float4 v4 = vr[64 * j]; y[j * 4] += w * v4.x; y[j * 4 + 1] += w * v4.y; y[j * 4 + 2] += w * v4.z; y[j * 4 + 3] += w * v4.w; }
    }
    float s = 0.f;
#pragma unroll
    for (int j = 0; j < 8; ++j)
#pragma unroll
        for (int i = 0; i < 4; ++i) { const int c = 256 * j + 4 * lane + i; y[j * 4 + i] += ALPHA * x[j * 4 + i] + bf2f(PLEB[(size_t)tok * 2048 + c]); s += y[j * 4 + i]; }
    const float mean = wave_sum(s) * (1.f / D); float q = 0.f;
#pragma unroll
    for (int i = 0; i < 32; ++i) { y[i] -= mean; q += y[i] * y[i]; }
    const float rstd = rsqrtf(wave_sum(q) * (1.f / D) + LN_EPS);
#pragma unroll
    for (int j = 0; j < 8; ++j) { const int c = 256 * j + 4 * lane; float4 o;
        o.x = y[j * 4] * rstd * lg[c] + lb[c]; o.y = y[j * 4 + 1] * rstd * lg[c + 1] + lb[c + 1]; o.z = y[j * 4 + 2] * rstd * lg[c + 2] + lb[c + 2]; o.w = y[j * 4 + 3] * rstd * lg[c + 3] + lb[c + 3];
        *(float4*)(out + (size_t)tok * 2048 + c) = o; }
}


typedef float f32x2_ __attribute__((ext_vector_type(2)));
DEV unsigned q8_1(float v) { return (unsigned)(__float2int_rn(v) + 128) & 0xffu; }
DEV void fp8_row(const float* __restrict__ src, unsigned char* __restrict__ dst, float* __restrict__ rs, int row, int lane) {
    const float4* sp = (const float4*)(src + (size_t)row * 2048) + lane; float4 v[8]; float m = 0.f;
#pragma unroll
    for (int j = 0; j < 8; ++j) { v[j] = sp[64 * j]; m = fmaxf(fmaxf(m, fmaxf(fabsf(v[j].x), fabsf(v[j].y))), fmaxf(fabsf(v[j].z), fabsf(v[j].w))); }
    m = wave_max(m); const float inv = m > 0.f ? 127.f / m : 0.f;
    unsigned* dp = (unsigned*)(dst + (size_t)row * 2048) + lane;
#pragma unroll
    for (int j = 0; j < 8; ++j) dp[64 * j] = q8_1(v[j].x * inv) | (q8_1(v[j].y * inv) << 8) | (q8_1(v[j].z * inv) << 16) | (q8_1(v[j].w * inv) << 24);
    if (lane == 0) rs[row] = m * (1.f / 127.f);
}
#define PG_ISSUE_U(grp) do { _Pragma("unroll") for (int e_ = 0; e_ < 4; ++e_) { const int ee_ = 4 * (grp) + e_; const int id_ = __builtin_amdgcn_readlane(ee_ < 64 ? id0 : id1, ee_ & 63); \
        const uint4* up_ = (const uint4*)(U8 + (size_t)id_ * 2048) + lane; ub[e_][0] = up_[0]; ub[e_][1] = up_[64]; } } while (0)
#define PG_ISSUE_V(grp) do { _Pragma("unroll") for (int e_ = 0; e_ < 4; ++e_) { const int ee_ = 4 * (grp) + e_; const int id_ = __builtin_amdgcn_readlane(ee_ < 64 ? id0 : id1, ee_ & 63); \
        const uint4* vp_ = (const uint4*)(V8 + (size_t)id_ * 2048) + lane; vb[e_][0] = vp_[0]; vb[e_][1] = vp_[64]; } } while (0)
#define PG_DOT(w4, xo, acc) do { const uint4 w_ = (w4); const unsigned q_[4] = {w_.x, w_.y, w_.z, w_.w}; _Pragma("unroll") for (int qq_ = 0; qq_ < 4; ++qq_) { \
        const f32x2_ lo_ = {(float)(q_[qq_] & 0xffu), (float)((q_[qq_] >> 8) & 0xffu)}, hi_ = {(float)((q_[qq_] >> 16) & 0xffu), (float)(q_[qq_] >> 24)}; \
        acc += lo_ * x2[(xo) + 2 * qq_]; acc += hi_ * x2[(xo) + 2 * qq_ + 1]; } } while (0)
#define PG_AXPY(w4, xo, wv) do { const uint4 w_ = (w4); const unsigned q_[4] = {w_.x, w_.y, w_.z, w_.w}; _Pragma("unroll") for (int qq_ = 0; qq_ < 4; ++qq_) { \
        const f32x2_ lo_ = {(float)(q_[qq_] & 0xffu), (float)((q_[qq_] >> 8) & 0xffu)}, hi_ = {(float)((q_[qq_] >> 16) & 0xffu), (float)(q_[qq_] >> 24)}; \
        y2[(xo) + 2 * qq_] += lo_ * (wv); y2[(xo) + 2 * qq_ + 1] += hi_ * (wv); } } while (0)
#define PG_GROUP(grp, more) do { float a_[4]; \
        _Pragma("unroll") for (int e_ = 0; e_ < 4; ++e_) { f32x2_ acc_ = {0.f, 0.f}; PG_DOT(ub[e_][0], 0, acc_); PG_DOT(ub[e_][1], 8, acc_); a_[e_] = acc_.x + acc_.y - xs128; } \
        if (more) PG_ISSUE_U((grp) + 1); \
        float s0_ = hi32 ? a_[0] : a_[2], s1_ = hi32 ? a_[1] : a_[3], k0_ = hi32 ? a_[2] : a_[0], k1_ = hi32 ? a_[3] : a_[1]; \
        k0_ += __shfl_xor(s0_, 32); k1_ += __shfl_xor(s1_, 32); \
        float sd_ = hi16 ? k0_ : k1_, kk_ = hi16 ? k1_ : k0_; kk_ += __shfl_xor(sd_, 16); \
        kk_ += __shfl_xor(kk_, 8); kk_ += __shfl_xor(kk_, 4); kk_ += __shfl_xor(kk_, 2); kk_ += __shfl_xor(kk_, 1); \
        const int ow_ = (4 * (grp) + (lane >> 4)) & 63; const float su_ = __shfl((grp) < 16 ? su0 : su1, ow_), sv_ = __shfl((grp) < 16 ? sv0 : sv1, ow_); \
        const float hid_ = su_ * kk_; const float wv_ = sv_ * (0.5f * hid_ * (1.f + erff(hid_ * 0.70710678f))); \
        _Pragma("unroll") for (int e_ = 0; e_ < 4; ++e_) { const float we_ = __uint_as_float((unsigned)__builtin_amdgcn_readlane((int)__float_as_uint(wv_), 16 * e_)); wsum += we_; PG_AXPY(vb[e_][0], 0, we_); PG_AXPY(vb[e_][1], 8, we_); } \
        if (more) PG_ISSUE_V((grp) + 1); } while (0)
DEV void peer_gather_tok(const bf16* __restrict__ H1, int id0, int id1, float gp0, float gp1, const unsigned char* __restrict__ U8, const unsigned char* __restrict__ V8,
                         const float* __restrict__ RSU, const float* __restrict__ RSV, const bf16* __restrict__ PLEB, const float* lg, const float* lb, float* __restrict__ out, int tok, int lane) {
    const bool hi32 = (lane & 32) != 0, hi16 = (lane & 16) != 0;
    f32x2_ x2[16], y2[16];
#pragma unroll
    for (int j = 0; j < 2; ++j)
#pragma unroll
        for (int hh = 0; hh < 2; ++hh) { const uint4 w = *(const uint4*)(H1 + (size_t)tok * 2048 + 1024 * j + 16 * lane + 8 * hh); const unsigned q[4] = {w.x, w.y, w.z, w.w};
#pragma unroll
            for (int k = 0; k < 4; ++k) { x2[8 * j + 4 * hh + k] = (f32x2_){__uint_as_float(q[k] << 16), __uint_as_float(q[k] & 0xffff0000u)}; } }
#pragma unroll
    for (int k = 0; k < 16; ++k) y2[k] = (f32x2_){0.f, 0.f};
    const float su0 = RSU[id0], su1 = RSU[id1], sv0 = RSV[id0] * gp0, sv1 = RSV[id1] * gp1;
    float xs128 = 0.f, wsum = 0.f;
#pragma unroll
    for (int k = 0; k < 16; ++k) xs128 += x2[k].x + x2[k].y;
    xs128 *= 128.f;
    uint4 ub[4][2], vb[4][2];
    PG_ISSUE_U(0); PG_ISSUE_V(0);
    for (int g = 0; g < 31; ++g) PG_GROUP(g, true);
    PG_GROUP(31, false);
    wsum *= 128.f;
#pragma unroll
    for (int k = 0; k < 16; ++k) y2[k] -= wsum;
    asm volatile("" : "+s"(lg), "+s"(lb));
    float s = 0.f;
#pragma unroll
    for (int j = 0; j < 2; ++j)
#pragma unroll
        for (int hh = 0; hh < 2; ++hh) { const uint4 w = *(const uint4*)(PLEB + (size_t)tok * 2048 + 1024 * j + 16 * lane + 8 * hh); const unsigned q[4] = {w.x, w.y, w.z, w.w};
#pragma unroll
            for (int k = 0; k < 4; ++k) { const int ix = 8 * j + 4 * hh + k; y2[ix] += x2[ix] * ALPHA + (f32x2_){__uint_as_float(q[k] << 16), __uint_as_float(q[k] & 0xffff0000u)}; s += y2[ix].x + y2[ix].y; } }
    const float mean = wave_sum(s) * (1.f / D); float q = 0.f;
#pragma unroll
    for (int k = 0; k < 16; ++k) { y2[k] -= mean; q += y2[k].x * y2[k].x + y2[k].y * y2[k].y; }
    const float rstd = rsqrtf(wave_sum(q) * (1.f / D) + LN_EPS);
#pragma unroll
    for (int j = 0; j < 2; ++j)
#pragma unroll
        for (int k = 0; k < 4; ++k) { const int c = 1024 * j + 16 * lane + 4 * k; const float4 gg = *(const float4*)(lg + c), bb = *(const float4*)(lb + c); const f32x2_ a = y2[8 * j + 2 * k], b = y2[8 * j + 2 * k + 1];
            float4 o; o.x = a.x * rstd * gg.x + bb.x; o.y = a.y * rstd * gg.y + bb.y; o.z = b.x * rstd * gg.z + bb.z; o.w = b.y * rstd * gg.w + bb.w; *(float4*)(out + (size_t)tok * 2048 + c) = o; }
}

typedef short bf16x8_ __attribute__((ext_vector_type(8)));
typedef float f32x4_ __attribute__((ext_vector_type(4)));
#define LASF __attribute__((address_space(3)))
constexpr int GP_ROW = 528;
constexpr int GP_QD = 0, GP_KI = 64 * GP_ROW, GP_KS = 2 * 64 * GP_ROW, GP_LR = 3 * 64 * GP_ROW, GP_SX = GP_LR + 4096, GP_GK = GP_SX + 4096;
typedef __bf16 bf16x2_t_ __attribute__((ext_vector_type(2)));
DEV unsigned cvtpk(float lo, float hi) { const f32x2_ v = {lo, hi}; return __builtin_bit_cast(unsigned, __builtin_convertvector(v, bf16x2_t_)); }
DEV void gla_pre_item(LASF unsigned char* lds, const bf16* __restrict__ GQK, const bf16* __restrict__ LR, const float* __restrict__ up, const float* __restrict__ bias,
                      bf16* __restrict__ QD, bf16* __restrict__ KST, bf16* __restrict__ ATT, float* __restrict__ DEC, int b, int h, int n, int dir, int tid) {
    const int k = tid & 255, ch = tid >> 8, tok0 = b * 2048 + n * 64, cidx = (b * 4 + h) * 32 + n, lane = tid & 63, wave = tid >> 6, fr = lane & 15, g = lane >> 4;
    LASF float* LRs = (LASF float*)(lds + GP_LR); LASF float* Sx = (LASF float*)(lds + GP_SX);
    for (int i = tid; i < 64 * 16; i += 512) LRs[i] = bf2f(LR[(size_t)(tok0 + (i >> 4)) * 256 + dir * 16 + (i & 15)]);
    float upr[16];
#pragma unroll
    for (int r = 0; r < 16; ++r) upr[r] = up[r * 1024 + h * 256 + k];
    const float bs = bias[h * 256 + k];
    __syncthreads();
    float S = 0.f, la[32];
#pragma unroll
    for (int cc = 0; cc < 32; ++cc) { const int c = dir ? 32 * ch + 31 - cc : 32 * ch + cc; float gk = bs;
#pragma unroll
        for (int r4 = 0; r4 < 4; ++r4) { const f32x4_ l4 = *(const LASF f32x4_*)(LRs + c * 16 + 4 * r4); gk += l4[0] * upr[4 * r4] + l4[1] * upr[4 * r4 + 1] + l4[2] * upr[4 * r4 + 2] + l4[3] * upr[4 * r4 + 3]; }
        la[cc] = (fminf(gk, 0.f) - __logf(1.f + __expf(-fabsf(gk)))) * (1.f / 16.f); S += la[cc]; }
    Sx[ch * 256 + k] = S;
    __syncthreads();
    const float Sother = Sx[(1 - ch) * 256 + k], btot = S + Sother, ebt = __expf(btot);
    float cum = (dir ? (ch == 0) : (ch == 1)) ? Sother : 0.f;
#pragma unroll
    for (int cc = 0; cc < 32; ++cc) { const int c = dir ? 32 * ch + 31 - cc : 32 * ch + cc;
        cum += la[cc];
        const size_t tr = (size_t)(tok0 + c) * 2048 + h * 256 + k; const float q = bf2f(GQK[tr]), kk = bf2f(GQK[tr + 1024]);
        const float e = __expf(cum), ie = __builtin_amdgcn_rcpf(e);
        const bf16 qd = f2bf(q * e), ki = f2bf(kk * ie), ks = f2bf(kk * ie * ebt);
        *(LASF bf16*)(lds + GP_QD + c * GP_ROW + k * 2) = qd; *(LASF bf16*)(lds + GP_KI + c * GP_ROW + k * 2) = ki; *(LASF bf16*)(lds + GP_KS + c * GP_ROW + k * 2) = ks;
        QD[(size_t)(tok0 + c) * 1024 + h * 256 + k] = qd; }
    if (ch == 0) DEC[(size_t)cidx * 256 + k] = ebt;
    __syncthreads();
    { const int ti = wave >> 1, tj0 = 2 * (wave & 1);
#pragma unroll
      for (int u = 0; u < 2; ++u) { const int tj = tj0 + u; f32x4_ acc = {0.f, 0.f, 0.f, 0.f};
        if (dir ? (tj >= ti) : (tj <= ti)) {
#pragma unroll
            for (int s8 = 0; s8 < 8; ++s8) { const bf16x8_ a = *(const LASF bf16x8_*)(lds + GP_QD + (16 * ti + fr) * GP_ROW + 64 * s8 + 16 * g), bq = *(const LASF bf16x8_*)(lds + GP_KI + (16 * tj + fr) * GP_ROW + 64 * s8 + 16 * g);
                acc = __builtin_amdgcn_mfma_f32_16x16x32_bf16(a, bq, acc, 0, 0, 0); } }
#pragma unroll
        for (int r = 0; r < 4; ++r) { const int i = 16 * ti + 4 * g + r, j = 16 * tj + fr; const bool keep = dir ? (j > i) : (j <= i);
            ATT[(size_t)cidx * 4096 + i * 64 + j] = f2bf(keep ? acc[r] : 0.f); } } }
#pragma unroll
    for (int qq = 0; qq < 4; ++qq) { const int c0 = 8 * (ch * 4 + qq); unsigned short v[8];
#pragma unroll
        for (int jj = 0; jj < 8; ++jj) v[jj] = *(const LASF bf16*)(lds + GP_KS + (c0 + jj) * GP_ROW + k * 2);
        uint4 o; o.x = v[0] | ((unsigned)v[1] << 16); o.y = v[2] | ((unsigned)v[3] << 16); o.z = v[4] | ((unsigned)v[5] << 16); o.w = v[6] | ((unsigned)v[7] << 16);
        *(uint4*)(KST + ((size_t)cidx * 256 + k) * 64 + c0) = o; }
    __syncthreads();
}
typedef unsigned u32x4_ __attribute__((ext_vector_type(4)));
typedef unsigned u32x2_ __attribute__((ext_vector_type(2)));
constexpr int S2_QT = 0, S2_KT = 64 * 528, S2_VT = S2_KT + 256 * 144, S2_AT = S2_VT + 64 * 144, S2_DC = S2_AT + 64 * 144, S2_P = S2_DC + 1024, S2_PW = 32 * 144;
#define S2_BAR() do { asm volatile("s_waitcnt lgkmcnt(0)" ::: "memory"); __builtin_amdgcn_s_barrier(); asm volatile("" ::: "memory"); } while (0)
DEV void gla_scan_item(LASF unsigned char* lds, const bf16* __restrict__ QD, const bf16* __restrict__ KST, const bf16* __restrict__ ATT, const float* __restrict__ DEC, const bf16* __restrict__ VT,
                       bf16* __restrict__ O, int b, int h, int dir, int sl, int tid) {
    const int lane = tid & 63, wave = __builtin_amdgcn_readfirstlane(tid >> 6), fr = lane & 15, g = lane >> 4, kq = wave >> 1, dh = wave & 1;
    f32x4_ st[4][2];
#pragma unroll
    for (int i = 0; i < 4; ++i)
#pragma unroll
        for (int t = 0; t < 2; ++t) st[i][t] = (f32x4_){0.f, 0.f, 0.f, 0.f};
    u32x4_ sq[4], sk[4], sv, sa, sd = {0u, 0u, 0u, 0u};
#define S2_ISSUE(nn) do { const size_t ci_ = (size_t)((b * 4 + h) * 32 + (nn)); const size_t t0_ = (size_t)b * 2048 + (nn) * 64; \
        _Pragma("unroll") for (int j = 0; j < 4; ++j) { const int ix_ = tid + 512 * j; sq[j] = *(const u32x4_*)(QD + (t0_ + (ix_ >> 5)) * 1024 + h * 256 + (ix_ & 31) * 8); } \
        _Pragma("unroll") for (int j = 0; j < 4; ++j) { const int ix_ = tid + 512 * j; sk[j] = *(const u32x4_*)(KST + (ci_ * 256 + (ix_ >> 3)) * 64 + (ix_ & 7) * 8); } \
        sv = *(const u32x4_*)(VT + (size_t)(1024 + h * 512 + sl * 64 + (tid >> 3)) * T + t0_ + (tid & 7) * 8); sa = *(const u32x4_*)(ATT + ci_ * 4096 + (tid >> 3) * 64 + (tid & 7) * 8); \
        sd = *(const u32x4_*)(DEC + ci_ * 256 + (tid & 63) * 4); } while (0)
#define S2_COMMIT() do { \
        _Pragma("unroll") for (int j = 0; j < 4; ++j) { const int ix_ = tid + 512 * j; *(LASF u32x4_*)(lds + S2_QT + (ix_ >> 5) * 528 + (ix_ & 31) * 16) = sq[j]; *(LASF u32x4_*)(lds + S2_KT + (ix_ >> 3) * 144 + (ix_ & 7) * 16) = sk[j]; } \
        *(LASF u32x4_*)(lds + S2_VT + (tid >> 3) * 144 + (tid & 7) * 16) = sv; *(LASF u32x4_*)(lds + S2_AT + (tid >> 3) * 144 + (tid & 7) * 16) = sa; \
        if (tid < 64) *(LASF u32x4_*)(lds + S2_DC + tid * 16) = sd; } while (0)
    { const int n0 = dir ? 31 : 0; S2_ISSUE(n0); S2_COMMIT(); S2_BAR(); }
    for (int step = 0; step < 32; ++step) {
        const int n = dir ? 31 - step : step, nn = dir ? (n > 0 ? n - 1 : 0) : (n < 31 ? n + 1 : 31);
        S2_ISSUE(nn);
        f32x4_ po[4][2];
        { bf16x8_ bs_[2][2];
#pragma unroll
          for (int t = 0; t < 2; ++t)
#pragma unroll
            for (int s_ = 0; s_ < 2; ++s_) { uint4 w; w.x = cvtpk(st[2 * s_][t][0], st[2 * s_][t][1]); w.y = cvtpk(st[2 * s_][t][2], st[2 * s_][t][3]); w.z = cvtpk(st[2 * s_ + 1][t][0], st[2 * s_ + 1][t][1]); w.w = cvtpk(st[2 * s_ + 1][t][2], st[2 * s_ + 1][t][3]); bs_[t][s_] = __builtin_bit_cast(bf16x8_, w); }
#pragma unroll
          for (int m = 0; m < 4; ++m) { bf16x8_ qa_[2];
#pragma unroll
            for (int s_ = 0; s_ < 2; ++s_) { const LASF unsigned char* qp_ = lds + S2_QT + (16 * m + fr) * 528 + (kq * 64 + 32 * s_ + 4 * g) * 2; const u32x2_ lo = *(const LASF u32x2_*)qp_, hi = *(const LASF u32x2_*)(qp_ + 32);
                uint4 w; w.x = lo.x; w.y = lo.y; w.z = hi.x; w.w = hi.y; qa_[s_] = __builtin_bit_cast(bf16x8_, w); }
#pragma unroll
            for (int t = 0; t < 2; ++t) { f32x4_ a = {0.f, 0.f, 0.f, 0.f}; a = __builtin_amdgcn_mfma_f32_16x16x32_bf16(qa_[0], bs_[t][0], a, 0, 0, 0); a = __builtin_amdgcn_mfma_f32_16x16x32_bf16(qa_[1], bs_[t][1], a, 0, 0, 0); po[m][t] = a; } } }
#pragma unroll
        for (int m = 0; m < 4; ++m)
#pragma unroll
            for (int t = 0; t < 2; ++t) { u32x2_ w; w.x = cvtpk(po[m][t][0], po[m][t][1]); w.y = cvtpk(po[m][t][2], po[m][t][3]); *(LASF u32x2_*)(lds + S2_P + wave * S2_PW + (16 * t + fr) * 144 + (16 * m + 4 * g) * 2) = w; }
        S2_BAR();
        bf16x8_ vb[2][2];
#pragma unroll
        for (int t = 0; t < 2; ++t)
#pragma unroll
            for (int s2 = 0; s2 < 2; ++s2) vb[t][s2] = *(const LASF bf16x8_*)(lds + S2_VT + (dh * 32 + 16 * t + fr) * 144 + (32 * s2 + 8 * g) * 2);
        { const bf16x8_ aa0 = *(const LASF bf16x8_*)(lds + S2_AT + (16 * kq + fr) * 144 + (8 * g) * 2), aa1 = *(const LASF bf16x8_*)(lds + S2_AT + (16 * kq + fr) * 144 + (32 + 8 * g) * 2);
#pragma unroll
          for (int t = 0; t < 2; ++t) { f32x4_ a = {0.f, 0.f, 0.f, 0.f};
#pragma unroll
            for (int w4 = 0; w4 < 4; ++w4) { const u32x2_ pw = *(const LASF u32x2_*)(lds + S2_P + (2 * w4 + dh) * S2_PW + (16 * t + fr) * 144 + (16 * kq + 4 * g) * 2);
                a[0] += __uint_as_float(pw.x << 16); a[1] += __uint_as_float(pw.x & 0xffff0000u); a[2] += __uint_as_float(pw.y << 16); a[3] += __uint_as_float(pw.y & 0xffff0000u); }
            a = __builtin_amdgcn_mfma_f32_16x16x32_bf16(aa0, vb[t][0], a, 0, 0, 0); a = __builtin_amdgcn_mfma_f32_16x16x32_bf16(aa1, vb[t][1], a, 0, 0, 0);
#pragma unroll
            for (int r = 0; r < 4; ++r) O[(size_t)(b * 2048 + n * 64 + 16 * kq + 4 * g + r) * 2048 + h * 512 + sl * 64 + dh * 32 + 16 * t + fr] = f2bf(a[r]); } }
#pragma unroll
        for (int i = 0; i < 4; ++i) { const f32x4_ dc = *(const LASF f32x4_*)(lds + S2_DC + (kq * 64 + 16 * i + 4 * g) * 4);
            const bf16x8_ ka0 = *(const LASF bf16x8_*)(lds + S2_KT + (kq * 64 + 16 * i + fr) * 144 + (8 * g) * 2), ka1 = *(const LASF bf16x8_*)(lds + S2_KT + (kq * 64 + 16 * i + fr) * 144 + (32 + 8 * g) * 2);
#pragma unroll
            for (int t = 0; t < 2; ++t) { f32x4_ a = st[i][t] * dc; a = __builtin_amdgcn_mfma_f32_16x16x32_bf16(ka0, vb[t][0], a, 0, 0, 0); a = __builtin_amdgcn_mfma_f32_16x16x32_bf16(ka1, vb[t][1], a, 0, 0, 0); st[i][t] = a; } }
        S2_BAR();
        asm volatile("s_waitcnt vmcnt(0)" ::: "memory");
        S2_COMMIT();
        S2_BAR();
    }
#undef S2_ISSUE
#undef S2_COMMIT
}

DEV void na_task(const bf16* __restrict__ NAQK, const bf16* __restrict__ VT, const float* __restrict__ rpb, bf16* __restrict__ YNA, int task, int lane) {
    const int w = task & 3, r = (task >> 2) & 31, h = (task >> 7) & 15, b = task >> 11, fr = lane & 15, g = lane >> 4;
    const int r0 = min(max(r - WIN_R / 2, 0), ROWS - WIN_R), cs = min(max(16 * w - 8, 0), GRID_W - 32), qc = 16 * w + fr, c0 = min(max(qc - WIN_C / 2, 0), GRID_W - WIN_C);
    const size_t tokq = (size_t)b * 2048 + r * 64 + qc;
    const bf16x8_ q0 = *(const bf16x8_*)(NAQK + tokq * 2048 + h * 64 + 8 * g), q1 = *(const bf16x8_*)(NAQK + tokq * 2048 + h * 64 + 32 + 8 * g);
    bf16x8_ kf[8][2][2];
#pragma unroll
    for (int i = 0; i < 8; ++i)
#pragma unroll
        for (int ct = 0; ct < 2; ++ct) { const bf16* kp = NAQK + ((size_t)b * 2048 + (r0 + i) * 64 + cs + 16 * ct + fr) * 2048 + 1024 + h * 64 + 8 * g; kf[i][ct][0] = *(const bf16x8_*)kp; kf[i][ct][1] = *(const bf16x8_*)(kp + 32); }
    __builtin_amdgcn_sched_barrier(0);
    f32x4_ sc[8][2];
#pragma unroll
    for (int i = 0; i < 8; ++i)
#pragma unroll
        for (int ct = 0; ct < 2; ++ct) { f32x4_ a = {0.f, 0.f, 0.f, 0.f}; a = __builtin_amdgcn_mfma_f32_16x16x32_bf16(kf[i][ct][0], q0, a, 0, 0, 0); a = __builtin_amdgcn_mfma_f32_16x16x32_bf16(kf[i][ct][1], q1, a, 0, 0, 0); sc[i][ct] = a; }
    __builtin_amdgcn_sched_barrier(0);
    float bs[8][2][4]; uint2 va[4][4][2], vc[4][4][2];
#pragma unroll
    for (int i = 0; i < 8; ++i)
#pragma unroll
        for (int ct = 0; ct < 2; ++ct)
#pragma unroll
            for (int rg = 0; rg < 4; ++rg) bs[i][ct][rg] = rpb[(h * 15 + (r0 + i - r + WIN_R - 1)) * 31 + min(max(cs + 16 * ct + 4 * g + rg - qc + WIN_C - 1, 0), 30)];
#define NA_LDV(dst, ibase) do { _Pragma("unroll") for (int i_ = 0; i_ < 4; ++i_) _Pragma("unroll") for (int mt = 0; mt < 4; ++mt) { \
        const bf16* vp_ = VT + (size_t)(h * 64 + 16 * mt + fr) * T + (size_t)b * 2048 + (r0 + (ibase) + i_) * 64 + cs + 4 * g; dst[i_][mt][0] = *(const uint2*)vp_; dst[i_][mt][1] = *(const uint2*)(vp_ + 16); } } while (0)
    NA_LDV(va, 0);
    __builtin_amdgcn_sched_barrier(0);
    float mx = -3.0e38f;
#pragma unroll
    for (int i = 0; i < 8; ++i)
#pragma unroll
        for (int ct = 0; ct < 2; ++ct)
#pragma unroll
            for (int rg = 0; rg < 4; ++rg) { const int kc = cs + 16 * ct + 4 * g + rg; const bool valid = (kc >= c0) && (kc < c0 + WIN_C);
                const float v = valid ? sc[i][ct][rg] + bs[i][ct][rg] : -3.0e38f; sc[i][ct][rg] = v; mx = fmaxf(mx, v); }
    mx = fmaxf(mx, __shfl_xor(mx, 16)); mx = fmaxf(mx, __shfl_xor(mx, 32));
    NA_LDV(vc, 4);
    __builtin_amdgcn_sched_barrier(0);
    float sum = 0.f;
#pragma unroll
    for (int i = 0; i < 8; ++i)
#pragma unroll
        for (int ct = 0; ct < 2; ++ct)
#pragma unroll
            for (int rg = 0; rg < 4; ++rg) { const float p = sc[i][ct][rg] > -1.0e38f ? __expf(sc[i][ct][rg] - mx) : 0.f; sc[i][ct][rg] = p; sum += p; }
    sum += __shfl_xor(sum, 16); sum += __shfl_xor(sum, 32);
    f32x4_ o[4];
#pragma unroll
    for (int mt = 0; mt < 4; ++mt) o[mt] = (f32x4_){0.f, 0.f, 0.f, 0.f};
#define NA_PV(src, ibase) do { _Pragma("unroll") for (int i_ = 0; i_ < 4; ++i_) { const int i = (ibase) + i_; uint4 pw; pw.x = cvtpk(sc[i][0][0], sc[i][0][1]); pw.y = cvtpk(sc[i][0][2], sc[i][0][3]); pw.z = cvtpk(sc[i][1][0], sc[i][1][1]); pw.w = cvtpk(sc[i][1][2], sc[i][1][3]); \
        const bf16x8_ pb = __builtin_bit_cast(bf16x8_, pw); \
        _Pragma("unroll") for (int mt = 0; mt < 4; ++mt) { uint4 aw; aw.x = src[i_][mt][0].x; aw.y = src[i_][mt][0].y; aw.z = src[i_][mt][1].x; aw.w = src[i_][mt][1].y; \
            o[mt] = __builtin_amdgcn_mfma_f32_16x16x32_bf16(__builtin_bit_cast(bf16x8_, aw), pb, o[mt], 0, 0, 0); } } } while (0)
    NA_PV(va, 0); NA_PV(vc, 4);
#undef NA_LDV
#undef NA_PV
    const float inv = 1.f / sum;
#pragma unroll
    for (int mt = 0; mt < 4; ++mt) { uint2 ow; ow.x = cvtpk(o[mt][0] * inv, o[mt][1] * inv); ow.y = cvtpk(o[mt][2] * inv, o[mt][3] * inv);
        *(uint2*)(YNA + tokq * 1024 + h * 64 + 16 * mt + 4 * g) = ow; }
}

constexpr int NA_KROW = 64 * 144, NA_K = 0, NA_V = 8 * NA_KROW, NA_VP = 1040, NA_BT = NA_V + 64 * NA_VP, NA_EX = NA_BT + 1872;
DEV void na_item(LASF unsigned char* lds, const bf16* __restrict__ NAQK, const bf16* __restrict__ VT, const float* __restrict__ rpb, bf16* __restrict__ YNA, int b, int h, int rb, int tid) {
    const int lane = tid & 63, wave = __builtin_amdgcn_readfirstlane(tid >> 6), fr = lane & 15, g = lane >> 4, w = wave >> 1, dhalf = wave & 1;
    const int cs = min(max(16 * w - 8, 0), GRID_W - 32), qc = 16 * w + fr, c0 = min(max(qc - WIN_C / 2, 0), GRID_W - WIN_C);
    LASF float* BT = (LASF float*)(lds + NA_BT);
    for (int i = tid; i < 15 * 31; i += 512) BT[i] = rpb[h * 465 + i];
    const int kkey = tid >> 3, kch = tid & 7;
#define NA_LDROW(kx, vx, row) do { kx = *(const u32x4_*)(NAQK + ((size_t)b * 2048 + (row) * 64 + kkey) * 2048 + 1024 + h * 64 + kch * 8); vx = *(const u32x4_*)(VT + (size_t)(h * 64 + kkey) * T + (size_t)b * 2048 + (row) * 64 + kch * 8); } while (0)
#define NA_STROW(kx, vx, row) do { const int sl_ = (row) & 7; *(LASF u32x4_*)(lds + NA_K + sl_ * NA_KROW + kkey * 144 + kch * 16) = kx; *(LASF u32x4_*)(lds + NA_V + kkey * NA_VP + (sl_ * 64 + kch * 8) * 2) = vx; } while (0)
    { const int r0i = min(max(8 * rb - WIN_R / 2, 0), ROWS - WIN_R); u32x4_ k8[8], v8[8];
#pragma unroll
      for (int i = 0; i < 8; ++i) NA_LDROW(k8[i], v8[i], r0i + i);
#pragma unroll
      for (int i = 0; i < 8; ++i) NA_STROW(k8[i], v8[i], r0i + i); }
    size_t tokq = (size_t)b * 2048 + (8 * rb) * 64 + qc;
    bf16x8_ q0 = *(const bf16x8_*)(NAQK + tokq * 2048 + h * 64 + 8 * g), q1 = *(const bf16x8_*)(NAQK + tokq * 2048 + h * 64 + 32 + 8 * g);
    int bofs[2][4]; float mneg[2][4];
#pragma unroll
    for (int ct = 0; ct < 2; ++ct)
#pragma unroll
        for (int rg = 0; rg < 4; ++rg) { const int kc = cs + 16 * ct + 4 * g + rg; const bool valid = (kc >= c0) && (kc < c0 + WIN_C);
            bofs[ct][rg] = min(max(kc - qc + WIN_C - 1, 0), 30); mneg[ct][rg] = valid ? 0.f : -3.0e38f; }
    S2_BAR();
    for (int ri = 0; ri < 8; ++ri) {
        const int r = 8 * rb + ri, r0 = min(max(r - WIN_R / 2, 0), ROWS - WIN_R), r0n = min(max(r + 1 - WIN_R / 2, 0), ROWS - WIN_R);
        const bool more = ri < 7, newrow = more && (r0n != r0);
        u32x4_ kx = {0u, 0u, 0u, 0u}, vx = {0u, 0u, 0u, 0u}; bf16x8_ q0n = q0, q1n = q1;
        if (newrow) NA_LDROW(kx, vx, r0n + 7);
        if (more) { const size_t tn = tokq + 64; q0n = *(const bf16x8_*)(NAQK + tn * 2048 + h * 64 + 8 * g); q1n = *(const bf16x8_*)(NAQK + tn * 2048 + h * 64 + 32 + 8 * g); }
        const int i0 = 4 * dhalf;
        f32x4_ sc[4][2];
#pragma unroll
        for (int i = 0; i < 4; ++i)
#pragma unroll
            for (int ct = 0; ct < 2; ++ct) { const LASF unsigned char* kp = lds + NA_K + ((r0 + i0 + i) & 7) * NA_KROW + (cs + 16 * ct + fr) * 144 + 16 * g;
                f32x4_ a = {0.f, 0.f, 0.f, 0.f}; a = __builtin_amdgcn_mfma_f32_16x16x32_bf16(*(const LASF bf16x8_*)kp, q0, a, 0, 0, 0); a = __builtin_amdgcn_mfma_f32_16x16x32_bf16(*(const LASF bf16x8_*)(kp + 64), q1, a, 0, 0, 0); sc[i][ct] = a; }
        float mx = -3.0e38f;
#pragma unroll
        for (int i = 0; i < 4; ++i)
#pragma unroll
            for (int ct = 0; ct < 2; ++ct)
#pragma unroll
                for (int rg = 0; rg < 4; ++rg) { const float v = sc[i][ct][rg] + BT[(r0 + i0 + i - r + WIN_R - 1) * 31 + bofs[ct][rg]] + mneg[ct][rg]; sc[i][ct][rg] = v; mx = fmaxf(mx, v); }
        mx = fmaxf(mx, __shfl_xor(mx, 16)); mx = fmaxf(mx, __shfl_xor(mx, 32));
        float sum = 0.f;
#pragma unroll
        for (int i = 0; i < 4; ++i)
#pragma unroll
            for (int ct = 0; ct < 2; ++ct)
#pragma unroll
                for (int rg = 0; rg < 4; ++rg) { const float p = __builtin_amdgcn_exp2f((sc[i][ct][rg] - mx) * 1.44269504f); sc[i][ct][rg] = p; sum += p; }
        sum += __shfl_xor(sum, 16); sum += __shfl_xor(sum, 32);
        f32x4_ o[4] = {{0.f, 0.f, 0.f, 0.f}, {0.f, 0.f, 0.f, 0.f}, {0.f, 0.f, 0.f, 0.f}, {0.f, 0.f, 0.f, 0.f}};
#pragma unroll
        for (int i = 0; i < 4; ++i) { uint4 pw; pw.x = cvtpk(sc[i][0][0], sc[i][0][1]); pw.y = cvtpk(sc[i][0][2], sc[i][0][3]); pw.z = cvtpk(sc[i][1][0], sc[i][1][1]); pw.w = cvtpk(sc[i][1][2], sc[i][1][3]);
            const bf16x8_ pb = __builtin_bit_cast(bf16x8_, pw);
#pragma unroll
            for (int mm = 0; mm < 4; ++mm) { const LASF unsigned char* vp = lds + NA_V + (16 * ((2 * dhalf + mm) & 3) + fr) * NA_VP + ((((r0 + i0 + i) & 7) * 64) + cs + 4 * g) * 2;
                const u32x2_ lo = *(const LASF u32x2_*)vp, hi = *(const LASF u32x2_*)(vp + 32); uint4 vw; vw.x = lo.x; vw.y = lo.y; vw.z = hi.x; vw.w = hi.y;
                o[mm] = __builtin_amdgcn_mfma_f32_16x16x32_bf16(__builtin_bit_cast(bf16x8_, vw), pb, o[mm], 0, 0, 0); } }
        { LASF unsigned char* ex = lds + NA_EX + wave * 1152; const f32x4_ pa = o[2], pb2 = o[3];
          *(LASF u32x4_*)(ex + 16 * lane) = (u32x4_){cvtpk(pa[0], pa[1]), cvtpk(pa[2], pa[3]), cvtpk(pb2[0], pb2[1]), cvtpk(pb2[2], pb2[3])};
          if (g == 0) *(LASF f32x2_*)(ex + 1024 + 8 * fr) = (f32x2_){mx, sum}; }
        S2_BAR();
        if (newrow) NA_STROW(kx, vx, r0n + 7);
        { const LASF unsigned char* ex = lds + NA_EX + (wave ^ 1) * 1152; const u32x4_ pp = *(const LASF u32x4_*)(ex + 16 * lane); const f32x2_ ps = *(const LASF f32x2_*)(ex + 1024 + 8 * fr);
          const float M = fmaxf(mx, ps[0]), sw = __builtin_amdgcn_exp2f((mx - M) * 1.44269504f), sp = __builtin_amdgcn_exp2f((ps[0] - M) * 1.44269504f), inv = 1.f / (sum * sw + ps[1] * sp);
          const float cw = sw * inv, cp = sp * inv;
#pragma unroll
          for (int mm = 0; mm < 2; ++mm) { const f32x4_ ow_ = o[mm]; const unsigned p0 = pp[2 * mm], p1 = pp[2 * mm + 1];
              const float y0 = ow_[0] * cw + __uint_as_float(p0 << 16) * cp, y1 = ow_[1] * cw + __uint_as_float(p0 & 0xffff0000u) * cp, y2 = ow_[2] * cw + __uint_as_float(p1 << 16) * cp, y3 = ow_[3] * cw + __uint_as_float(p1 & 0xffff0000u) * cp;
              int ow = 0; ow = __builtin_amdgcn_cvt_pk_fp8_f32(y0, y1, ow, false); ow = __builtin_amdgcn_cvt_pk_fp8_f32(y2, y3, ow, true);
              *(int*)((unsigned char*)YNA + tokq * 1024 + h * 64 + 16 * (2 * dhalf + mm) + 4 * g) = ow; } }
        S2_BAR();
        q0 = q0n; q1 = q1n; tokq += 64;
    }
#undef NA_LDROW
#undef NA_STROW
}

DEV void gla_pre_block(LASF unsigned char* lds, const bf16* __restrict__ GQK, const bf16* __restrict__ LR, const float* __restrict__ upf, const float* __restrict__ bif, const float* __restrict__ upb, const float* __restrict__ bib,
                       bf16* __restrict__ QD0, bf16* __restrict__ KST0, bf16* __restrict__ ATT0, float* __restrict__ DEC0, int bx, int G, int tid) {
    const int k = tid & 255, ch = tid >> 8, lane = tid & 63, wave = tid >> 6, fr = lane & 15, g = lane >> 4;
    LASF float* LRs = (LASF float*)(lds + GP_LR); LASF float* Sx = (LASF float*)(lds + GP_SX);
    u32x4_ rq[4], rk[4], rl = {0u, 0u, 0u, 0u};
#define GPB_ISSUE(it_) do { const int dir_ = (it_) & 1, n_ = ((it_) >> 1) & 31, h_ = ((it_) >> 6) & 3, b_ = (it_) >> 8; const size_t t0_ = (size_t)b_ * 2048 + n_ * 64; \
        _Pragma("unroll") for (int j = 0; j < 4; ++j) { const int ix_ = tid + 512 * j; const bf16* p_ = GQK + (t0_ + (ix_ >> 5)) * 2048 + h_ * 256 + (ix_ & 31) * 8; rq[j] = *(const u32x4_*)p_; rk[j] = *(const u32x4_*)(p_ + 1024); } \
        if (tid < 128) rl = *(const u32x4_*)(LR + (t0_ + (tid >> 1)) * 256 + dir_ * 16 + (tid & 1) * 8); } while (0)
#define GPB_COMMIT() do { \
        _Pragma("unroll") for (int j = 0; j < 4; ++j) { const int ix_ = tid + 512 * j; *(LASF u32x4_*)(lds + GP_QD + (ix_ >> 5) * GP_ROW + (ix_ & 31) * 16) = rq[j]; *(LASF u32x4_*)(lds + GP_KI + (ix_ >> 5) * GP_ROW + (ix_ & 31) * 16) = rk[j]; } \
        if (tid < 128) { f32x4_ a_, b_; a_[0] = __uint_as_float(rl[0] << 16); a_[1] = __uint_as_float(rl[0] & 0xffff0000u); a_[2] = __uint_as_float(rl[1] << 16); a_[3] = __uint_as_float(rl[1] & 0xffff0000u); \
            b_[0] = __uint_as_float(rl[2] << 16); b_[1] = __uint_as_float(rl[2] & 0xffff0000u); b_[2] = __uint_as_float(rl[3] << 16); b_[3] = __uint_as_float(rl[3] & 0xffff0000u); \
            *(LASF f32x4_*)(LRs + (tid >> 1) * 16 + (tid & 1) * 8) = a_; *(LASF f32x4_*)(LRs + (tid >> 1) * 16 + (tid & 1) * 8 + 4) = b_; } } while (0)
    if (bx < 1024) GPB_ISSUE(bx);
    const int kp = tid & 127, qd = tid >> 7;
    int hd_cached = -1; float bs0 = 0.f, bs1 = 0.f; bf16x8_ upb_[2] = {{0, 0, 0, 0, 0, 0, 0, 0}, {0, 0, 0, 0, 0, 0, 0, 0}};
    for (int it = bx; it < 1024; it += G) {
        const int dir = it & 1, n = (it >> 1) & 31, h = (it >> 6) & 3, b = it >> 8, tok0 = b * 2048 + n * 64, cidx = (b * 4 + h) * 32 + n;
        bf16* QD = QD0 + (size_t)dir * T * 1024; bf16* KST = KST0 + (size_t)dir * 512 * 256 * 64; bf16* ATT = ATT0 + (size_t)dir * 512 * 4096; float* DEC = DEC0 + (size_t)dir * 512 * 256;
        if (hd_cached != h * 2 + dir) { const float* up = dir ? upb : upf; const float* bias = dir ? bib : bif; hd_cached = h * 2 + dir;
#pragma unroll
            for (int ct = 0; ct < 2; ++ct) { uint4 w = {0u, 0u, 0u, 0u};
                if (g < 2) { const float* up_ = up + (8 * g) * 1024 + h * 256 + 16 * (2 * wave + ct) + fr;
                    w.x = cvtpk(up_[0], up_[1024]); w.y = cvtpk(up_[2 * 1024], up_[3 * 1024]); w.z = cvtpk(up_[4 * 1024], up_[5 * 1024]); w.w = cvtpk(up_[6 * 1024], up_[7 * 1024]); }
                upb_[ct] = __builtin_bit_cast(bf16x8_, w); }
            { const f32x2_ b2 = *(const f32x2_*)(bias + h * 256 + 2 * kp); bs0 = b2[0]; bs1 = b2[1]; } }
        GPB_COMMIT();
        S2_BAR();
        if (it + G < 1024) GPB_ISSUE(it + G);
#pragma unroll
        for (int tm = 0; tm < 4; ++tm) { uint4 aw = {0u, 0u, 0u, 0u};
            if (g < 2) { const f32x4_ l0 = *(const LASF f32x4_*)(LRs + (16 * tm + fr) * 16 + 8 * g), l1 = *(const LASF f32x4_*)(LRs + (16 * tm + fr) * 16 + 8 * g + 4);
                aw.x = cvtpk(l0[0], l0[1]); aw.y = cvtpk(l0[2], l0[3]); aw.z = cvtpk(l1[0], l1[1]); aw.w = cvtpk(l1[2], l1[3]); }
            const bf16x8_ af = __builtin_bit_cast(bf16x8_, aw);
#pragma unroll
            for (int ct = 0; ct < 2; ++ct) { const f32x4_ z4 = {0.f, 0.f, 0.f, 0.f}; const f32x4_ cg = __builtin_amdgcn_mfma_f32_16x16x32_bf16(af, upb_[ct], z4, 0, 0, 0);
#pragma unroll
                for (int j = 0; j < 4; ++j) *(LASF bf16*)(lds + GP_GK + (16 * tm + 4 * g + j) * GP_ROW + (16 * (2 * wave + ct) + fr) * 2) = f2bf(cg[j]); } }
        S2_BAR();
        float S0 = 0.f, S1 = 0.f, la0[16], la1[16];
#pragma unroll
        for (int cc = 0; cc < 16; ++cc) { const int c = dir ? 16 * qd + 15 - cc : 16 * qd + cc; const unsigned gw_ = *(const LASF unsigned*)(lds + GP_GK + c * GP_ROW + kp * 4);
            const float g0 = bs0 + __uint_as_float(gw_ << 16), g1 = bs1 + __uint_as_float(gw_ & 0xffff0000u);
            la0[cc] = (fminf(g0, 0.f) - __logf(1.f + __expf(-fabsf(g0)))) * (1.f / 16.f); la1[cc] = (fminf(g1, 0.f) - __logf(1.f + __expf(-fabsf(g1)))) * (1.f / 16.f); S0 += la0[cc]; S1 += la1[cc]; }
        *(LASF f32x2_*)(Sx + qd * 256 + 2 * kp) = (f32x2_){S0, S1};
        S2_BAR();
        float cum0 = 0.f, cum1 = 0.f, bt0 = 0.f, bt1 = 0.f;
#pragma unroll
        for (int q4 = 0; q4 < 4; ++q4) { const f32x2_ sq_ = *(const LASF f32x2_*)(Sx + q4 * 256 + 2 * kp); bt0 += sq_[0]; bt1 += sq_[1];
            const bool before = dir ? (q4 > qd) : (q4 < qd); cum0 += before ? sq_[0] : 0.f; cum1 += before ? sq_[1] : 0.f; }
        const float ebt0 = __expf(bt0), ebt1 = __expf(bt1);
#pragma unroll
        for (int cc = 0; cc < 16; ++cc) { const int c = dir ? 16 * qd + 15 - cc : 16 * qd + cc;
            cum0 += la0[cc]; cum1 += la1[cc];
            LASF unsigned* qp = (LASF unsigned*)(lds + GP_QD + c * GP_ROW + kp * 4); LASF unsigned* kq_ = (LASF unsigned*)(lds + GP_KI + c * GP_ROW + kp * 4);
            const unsigned qw = *qp, kw = *kq_; const float q0 = __uint_as_float(qw << 16), q1 = __uint_as_float(qw & 0xffff0000u), k0 = __uint_as_float(kw << 16), k1 = __uint_as_float(kw & 0xffff0000u);
            const float e0 = __expf(cum0), e1 = __expf(cum1), i0 = __builtin_amdgcn_rcpf(e0), i1 = __builtin_amdgcn_rcpf(e1);
            *qp = cvtpk(q0 * e0, q1 * e1); *kq_ = cvtpk(k0 * i0, k1 * i1); *(LASF unsigned*)(lds + GP_KS + c * GP_ROW + kp * 4) = cvtpk(k0 * i0 * ebt0, k1 * i1 * ebt1); }
        if (qd == 0) *(f32x2_*)(DEC + (size_t)cidx * 256 + 2 * kp) = (f32x2_){ebt0, ebt1};
        S2_BAR();
        { const int ti = wave >> 1, tj0 = 2 * (wave & 1);
#pragma unroll
          for (int u = 0; u < 2; ++u) { const int tj = tj0 + u; f32x4_ acc = {0.f, 0.f, 0.f, 0.f};
            if (dir ? (tj >= ti) : (tj <= ti)) {
#pragma unroll
                for (int s8 = 0; s8 < 8; ++s8) { const bf16x8_ a = *(const LASF bf16x8_*)(lds + GP_QD + (16 * ti + fr) * GP_ROW + 64 * s8 + 16 * g), bq = *(const LASF bf16x8_*)(lds + GP_KI + (16 * tj + fr) * GP_ROW + 64 * s8 + 16 * g);
                    acc = __builtin_amdgcn_mfma_f32_16x16x32_bf16(a, bq, acc, 0, 0, 0); } }
#pragma unroll
            for (int r = 0; r < 4; ++r) { const int i = 16 * ti + 4 * g + r, j = 16 * tj + fr; const bool keep = dir ? (j > i) : (j <= i);
                ATT[(size_t)cidx * 4096 + i * 64 + j] = f2bf(keep ? acc[r] : 0.f); } } }
#pragma unroll
        for (int qq = 0; qq < 4; ++qq) { const int c0 = 8 * (ch * 4 + qq); unsigned short v[8];
#pragma unroll
            for (int jj = 0; jj < 8; ++jj) v[jj] = *(const LASF bf16*)(lds + GP_KS + (c0 + jj) * GP_ROW + k * 2);
            uint4 o; o.x = v[0] | ((unsigned)v[1] << 16); o.y = v[2] | ((unsigned)v[3] << 16); o.z = v[4] | ((unsigned)v[5] << 16); o.w = v[6] | ((unsigned)v[7] << 16);
            *(uint4*)(KST + ((size_t)cidx * 256 + k) * 64 + c0) = o; }
#pragma unroll
        for (int j = 0; j < 4; ++j) { const int ix_ = tid + 512 * j; const u32x4_ o = *(const LASF u32x4_*)(lds + GP_QD + (ix_ >> 5) * GP_ROW + (ix_ & 31) * 16); *(u32x4_*)(QD + (size_t)(tok0 + (ix_ >> 5)) * 1024 + h * 256 + (ix_ & 31) * 8) = o; }
        S2_BAR();
    }
#undef GPB_ISSUE
#undef GPB_COMMIT
}

struct __attribute__((aligned(4))) U3_ { unsigned a, b, c; };
DEV void q6_row(const float* __restrict__ src, unsigned char* __restrict__ dst, float* __restrict__ rs, int row, int lane) {
    const float4* sp = (const float4*)(src + (size_t)row * 2048 + 32 * lane); float4 v[8]; float m = 0.f;
#pragma unroll
    for (int j = 0; j < 8; ++j) { v[j] = sp[j]; m = fmaxf(fmaxf(m, fmaxf(fabsf(v[j].x), fabsf(v[j].y))), fmaxf(fabsf(v[j].z), fabsf(v[j].w))); }
    m = wave_max(m); const float inv = m > 0.f ? 31.f / m : 0.f;
    unsigned q[32];
#pragma unroll
    for (int j = 0; j < 8; ++j) { q[4 * j] = (unsigned)(__float2int_rn(v[j].x * inv) + 32); q[4 * j + 1] = (unsigned)(__float2int_rn(v[j].y * inv) + 32); q[4 * j + 2] = (unsigned)(__float2int_rn(v[j].z * inv) + 32); q[4 * j + 3] = (unsigned)(__float2int_rn(v[j].w * inv) + 32); }
#pragma unroll
    for (int t = 0; t < 2; ++t) { const unsigned* p = q + 16 * t; U3_ w;
        w.a = p[0] | (p[1] << 6) | (p[2] << 12) | (p[3] << 18) | (p[4] << 24) | (p[5] << 30);
        w.b = (p[5] >> 2) | (p[6] << 4) | (p[7] << 10) | (p[8] << 16) | (p[9] << 22) | (p[10] << 28);
        w.c = (p[10] >> 4) | (p[11] << 2) | (p[12] << 8) | (p[13] << 14) | (p[14] << 20) | (p[15] << 26);
        *(U3_*)(dst + (size_t)row * 1536 + 24 * lane + 12 * t) = w; }
    if (lane == 0) rs[row] = m * (1.f / 31.f);
}
#define Q6_DEC(T, f) do { const unsigned t0_ = (T).a, t1_ = (T).b, t2_ = (T).c; \
        f[0] = (f32x2_){(float)(t0_ & 63u), (float)((t0_ >> 6) & 63u)}; f[1] = (f32x2_){(float)((t0_ >> 12) & 63u), (float)((t0_ >> 18) & 63u)}; \
        f[2] = (f32x2_){(float)((t0_ >> 24) & 63u), (float)(__builtin_amdgcn_alignbit(t1_, t0_, 30) & 63u)}; f[3] = (f32x2_){(float)((t1_ >> 4) & 63u), (float)((t1_ >> 10) & 63u)}; \
        f[4] = (f32x2_){(float)((t1_ >> 16) & 63u), (float)((t1_ >> 22) & 63u)}; f[5] = (f32x2_){(float)(__builtin_amdgcn_alignbit(t2_, t1_, 28) & 63u), (float)((t2_ >> 2) & 63u)}; \
        f[6] = (f32x2_){(float)((t2_ >> 8) & 63u), (float)((t2_ >> 14) & 63u)}; f[7] = (f32x2_){(float)((t2_ >> 20) & 63u), (float)(t2_ >> 26)}; } while (0)
#define P6_ISSUE_U(grp) do { _Pragma("unroll") for (int e_ = 0; e_ < 8; ++e_) { const int ee_ = 8 * (grp) + e_; const int id_ = __builtin_amdgcn_readlane(ee_ < 64 ? id0 : id1, ee_ & 63); \
        const unsigned char* up_ = U6 + (size_t)id_ * 1536 + 24 * lane; ub[e_][0] = *(const U3_*)up_; ub[e_][1] = *(const U3_*)(up_ + 12); } } while (0)
#define P6_ISSUE_V(grp) do { _Pragma("unroll") for (int e_ = 0; e_ < 8; ++e_) { const int ee_ = 8 * (grp) + e_; const int id_ = __builtin_amdgcn_readlane(ee_ < 64 ? id0 : id1, ee_ & 63); \
        const unsigned char* vp_ = V6 + (size_t)id_ * 1536 + 24 * lane; vb[e_][0] = *(const U3_*)vp_; vb[e_][1] = *(const U3_*)(vp_ + 12); } } while (0)
#define P6_LANE_OF(e) (8 * (e))
#define P6_DPP(x, ctl) __builtin_bit_cast(float, __builtin_amdgcn_mov_dpp(__builtin_bit_cast(int, x), ctl, 0xf, 0xf, true))
#define P6_SW32(a, b) ({ const auto p_ = __builtin_amdgcn_permlane32_swap(__float_as_uint(a), __float_as_uint(b), false, false); __uint_as_float(p_[0]) + __uint_as_float(p_[1]); })
#define P6_SW16(a, b) ({ const auto p_ = __builtin_amdgcn_permlane16_swap(__float_as_uint(a), __float_as_uint(b), false, false); __uint_as_float(p_[0]) + __uint_as_float(p_[1]); })
#define P6_GROUP(grp, more) do { float a_[8]; \
        _Pragma("unroll") for (int e_ = 0; e_ < 8; ++e_) { f32x2_ acc_ = {0.f, 0.f}; \
            _Pragma("unroll") for (int t_ = 0; t_ < 2; ++t_) { f32x2_ f_[8]; Q6_DEC(ub[e_][t_], f_); _Pragma("unroll") for (int p_ = 0; p_ < 8; ++p_) acc_ += f_[p_] * x2[8 * t_ + p_]; } \
            a_[e_] = acc_.x + acc_.y - xs32; } \
        if (more) P6_ISSUE_U((grp) + 1); \
        const int ow_ = (8 * (grp) + (lane >> 3)) & 63; const float su_ = __shfl((grp) < 8 ? su0 : su1, ow_), sv_ = __shfl((grp) < 8 ? sv0 : sv1, ow_); \
          \
        const float h0_ = P6_SW32(a_[0], a_[4]), h1_ = P6_SW32(a_[1], a_[5]), h2_ = P6_SW32(a_[2], a_[6]), h3_ = P6_SW32(a_[3], a_[7]); \
          \
        const float r0_ = P6_SW16(h0_, h2_), r1_ = P6_SW16(h1_, h3_); \
          \
        const bool hi8_ = (lane & 8) != 0; const float keep_ = hi8_ ? r1_ : r0_, send_ = hi8_ ? r0_ : r1_; \
        float kk_ = keep_ + P6_DPP(send_, 0x128); \
        kk_ += P6_DPP(kk_, 0xB1); kk_ += P6_DPP(kk_, 0x4E); kk_ += P6_DPP(kk_, 0x141); \
        const float hid_ = su_ * kk_; const float wv_ = sv_ * (0.5f * hid_ * (1.f + erff(hid_ * 0.70710678f))); \
        _Pragma("unroll") for (int e_ = 0; e_ < 8; ++e_) { const float we_ = __uint_as_float((unsigned)__builtin_amdgcn_readlane((int)__float_as_uint(wv_), P6_LANE_OF(e_))); wsum += we_; \
            _Pragma("unroll") for (int t_ = 0; t_ < 2; ++t_) { f32x2_ f_[8]; Q6_DEC(vb[e_][t_], f_); _Pragma("unroll") for (int p_ = 0; p_ < 8; ++p_) y2[8 * t_ + p_] += f_[p_] * we_; } } \
        if (more) P6_ISSUE_V((grp) + 1); } while (0)
DEV void peer_gather_tok6(const bf16* __restrict__ H1, int id0, int id1, float gp0, float gp1, const unsigned char* __restrict__ U6, const unsigned char* __restrict__ V6,
                          const float* __restrict__ RSU, const float* __restrict__ RSV, const bf16* __restrict__ PLEB, const float* lg, const float* lb, float* __restrict__ out, int tok, int lane) {
    const bool hi32 = (lane & 32) != 0, hi16 = (lane & 16) != 0;
    f32x2_ x2[16], y2[16];
#pragma unroll
    for (int u = 0; u < 4; ++u) { const uint4 w = *(const uint4*)(H1 + (size_t)tok * 2048 + 32 * lane + 8 * u); const unsigned q[4] = {w.x, w.y, w.z, w.w};
#pragma unroll
        for (int k = 0; k < 4; ++k) x2[4 * u + k] = (f32x2_){__uint_as_float(q[k] << 16), __uint_as_float(q[k] & 0xffff0000u)}; }
#pragma unroll
    for (int k = 0; k < 16; ++k) y2[k] = (f32x2_){0.f, 0.f};
    const float su0 = RSU[id0], su1 = RSU[id1], sv0 = RSV[id0] * gp0, sv1 = RSV[id1] * gp1;
    float xs32 = 0.f, wsum = 0.f;
#pragma unroll
    for (int k = 0; k < 16; ++k) xs32 += x2[k].x + x2[k].y;
    xs32 *= 32.f;
    U3_ ub[8][2], vb[8][2];
    P6_ISSUE_U(0); P6_ISSUE_V(0);
    for (int g = 0; g < 15; ++g) P6_GROUP(g, true);
    P6_GROUP(15, false);
    wsum *= 32.f;
#pragma unroll
    for (int k = 0; k < 16; ++k) y2[k] -= wsum;
    asm volatile("" : "+s"(lg), "+s"(lb));
    float s = 0.f;
#pragma unroll
    for (int u = 0; u < 4; ++u) { const uint4 w = *(const uint4*)(PLEB + (size_t)tok * 2048 + 32 * lane + 8 * u); const unsigned q[4] = {w.x, w.y, w.z, w.w};
#pragma unroll
        for (int k = 0; k < 4; ++k) { const int ix = 4 * u + k; y2[ix] += x2[ix] * ALPHA + (f32x2_){__uint_as_float(q[k] << 16), __uint_as_float(q[k] & 0xffff0000u)}; s += y2[ix].x + y2[ix].y; } }
    const float mean = wave_sum(s) * (1.f / D); float q = 0.f;
#pragma unroll
    for (int k = 0; k < 16; ++k) { y2[k] -= mean; q += y2[k].x * y2[k].x + y2[k].y * y2[k].y; }
    const float rstd = rsqrtf(wave_sum(q) * (1.f / D) + LN_EPS);
#pragma unroll
    for (int k = 0; k < 8; ++k) { const int c = 32 * lane + 4 * k; const float4 gg = *(const float4*)(lg + c), bb = *(const float4*)(lb + c); const f32x2_ a = y2[2 * k], b = y2[2 * k + 1];
        float4 o; o.x = a.x * rstd * gg.x + bb.x; o.y = a.y * rstd * gg.y + bb.y; o.z = b.x * rstd * gg.z + bb.z; o.w = b.y * rstd * gg.w + bb.w; *(float4*)(out + (size_t)tok * 2048 + c) = o; }
}

#define FP4_LOW 3
template <bool VLAY> DEV void f6_row(const float* __restrict__ src, unsigned char* __restrict__ dst, unsigned char* __restrict__ dst4, float* __restrict__ rs, int row, int lane) {
    const float4* sp = (const float4*)(src + (size_t)row * 2048 + 32 * lane); float4 v[8]; float m = 0.f;
#pragma unroll
    for (int j = 0; j < 8; ++j) { v[j] = sp[j]; m = fmaxf(fmaxf(m, fmaxf(fabsf(v[j].x), fabsf(v[j].y))), fmaxf(fabsf(v[j].z), fabsf(v[j].w))); }
    m = wave_max(m); const float inv = m > 0.f ? 7.5f / m : 0.f;
    unsigned q[32];
#define F6_CODE(xv) ({ const float x_ = (xv); const float a_ = fabsf(x_) * inv; const float t_ = fminf(fminf(8.f * a_, 4.f * a_ + 8.f), 2.f * a_ + 16.f); \
        (__float_as_uint(t_ + 8388608.f) & 31u) | ((__float_as_uint(x_) >> 26) & 32u); })
#pragma unroll
    for (int j = 0; j < 8; ++j) { q[4 * j] = F6_CODE(v[j].x); q[4 * j + 1] = F6_CODE(v[j].y); q[4 * j + 2] = F6_CODE(v[j].z); q[4 * j + 3] = F6_CODE(v[j].w); }
#undef F6_CODE
    unsigned w6[6];
#pragma unroll
    for (int t = 0; t < 2; ++t) { const unsigned* p = q + 16 * t;
        w6[3 * t] = p[0] | (p[1] << 6) | (p[2] << 12) | (p[3] << 18) | (p[4] << 24) | (p[5] << 30);
        w6[3 * t + 1] = (p[5] >> 2) | (p[6] << 4) | (p[7] << 10) | (p[8] << 16) | (p[9] << 22) | (p[10] << 28);
        w6[3 * t + 2] = (p[10] >> 4) | (p[11] << 2) | (p[12] << 8) | (p[13] << 14) | (p[14] << 20) | (p[15] << 26); }
    unsigned char* rp = dst + (size_t)row * 1536;
    if (VLAY) { rp += 384 * (lane >> 4); *(u32x4_*)(rp + 16 * (lane & 15)) = (u32x4_){w6[0], w6[1], w6[2], w6[3]}; *(u32x2_*)(rp + 256 + 8 * (lane & 15)) = (u32x2_){w6[4], w6[5]}; }
    else { *(u32x4_*)(rp + 16 * lane) = (u32x4_){w6[0], w6[1], w6[2], w6[3]}; *(u32x2_*)(rp + 1024 + 8 * lane) = (u32x2_){w6[4], w6[5]}; }
    if (lane == 0) rs[row] = m * (1.f / 7.5f);
#if FP4_LOW
    { const float inv4 = m > 0.f ? 6.f / m : 0.f; unsigned w4[4];
#pragma unroll
      for (int j = 0; j < 4; ++j) { unsigned w = 0u;
          w = __builtin_amdgcn_cvt_scalef32_pk_fp4_f32(w, v[2 * j].x * inv4, v[2 * j].y * inv4, 1.0f, 0); w = __builtin_amdgcn_cvt_scalef32_pk_fp4_f32(w, v[2 * j].z * inv4, v[2 * j].w * inv4, 1.0f, 1);
          w = __builtin_amdgcn_cvt_scalef32_pk_fp4_f32(w, v[2 * j + 1].x * inv4, v[2 * j + 1].y * inv4, 1.0f, 2); w = __builtin_amdgcn_cvt_scalef32_pk_fp4_f32(w, v[2 * j + 1].z * inv4, v[2 * j + 1].w * inv4, 1.0f, 3); w4[j] = w; }
      *(u32x4_*)(dst4 + (size_t)row * 1024 + 16 * lane) = (u32x4_){w4[0], w4[1], w4[2], w4[3]};
      if (lane == 0) rs[PNK * PNK + row] = m * (1.f / 6.f); }
#endif
}
DEV void f4_row(const float* __restrict__ src, unsigned char* __restrict__ dst4, float* __restrict__ rs, int row, int lane) {
    const float4* sp = (const float4*)(src + (size_t)row * 2048 + 32 * lane); float4 v[8]; float q = 0.f;
#pragma unroll
    for (int j = 0; j < 8; ++j) { v[j] = sp[j]; q += (v[j].x * v[j].x + v[j].y * v[j].y) + (v[j].z * v[j].z + v[j].w * v[j].w); }
    const float rms = sqrtf(wave_sum(q) * (1.f / 2048.f)); const float inv4 = rms > 0.f ? 2.f / rms : 0.f; unsigned w4[4];
#pragma unroll
    for (int j = 0; j < 4; ++j) { unsigned w = 0u;
        w = __builtin_amdgcn_cvt_scalef32_pk_fp4_f32(w, v[2 * j].x * inv4, v[2 * j].y * inv4, 1.0f, 0); w = __builtin_amdgcn_cvt_scalef32_pk_fp4_f32(w, v[2 * j].z * inv4, v[2 * j].w * inv4, 1.0f, 1);
        w = __builtin_amdgcn_cvt_scalef32_pk_fp4_f32(w, v[2 * j + 1].x * inv4, v[2 * j + 1].y * inv4, 1.0f, 2); w = __builtin_amdgcn_cvt_scalef32_pk_fp4_f32(w, v[2 * j + 1].z * inv4, v[2 * j + 1].w * inv4, 1.0f, 3); w4[j] = w; }
    *(u32x4_*)(dst4 + (size_t)row * 1024 + 16 * lane) = (u32x4_){w4[0], w4[1], w4[2], w4[3]};
    if (lane == 0) rs[PNK * PNK + row] = rms * 0.5f;
}
struct R6_ { u32x4_ a; u32x2_ b; };
typedef int i32x8g_ __attribute__((ext_vector_type(8)));
#define M6_MFMA(a, b, c, sa) __builtin_amdgcn_mfma_scale_f32_16x16x128_f8f6f4(a, b, c, 2, 2, 0, sa, 0, 127)
#define M4_MFMA(a, b, c, sa) __builtin_amdgcn_mfma_scale_f32_16x16x128_f8f6f4(a, b, c, 2, 4, 0, sa, 0, 127)
#define M6_B(r) ((i32x8g_){(int)(r).a[0], (int)(r).a[1], (int)(r).a[2], (int)(r).a[3], (int)(r).b[0], (int)(r).b[1], 0, 0})
#define M4_B(r) ((i32x8g_){(int)(r).a[0], (int)(r).a[1], (int)(r).a[2], (int)(r).a[3], 0, 0, 0, 0})
#define M6_ISSUE_U(grp) do { _Pragma("unroll") for (int e_ = 0; e_ < 8; ++e_) { const int ee_ = 8 * (grp) + e_; const int id_ = __builtin_amdgcn_readlane(ee_ < 64 ? id0 : id1, ee_ & 63); \
        const unsigned char* up_ = U6 + (size_t)id_ * 1536; ub[e_].a = *(const u32x4_*)(up_ + 16 * lane); ub[e_].b = *(const u32x2_*)(up_ + 1024 + 8 * lane); } } while (0)
#define M6_ISSUE_V(grp) do { _Pragma("unroll") for (int q_ = 0; q_ < 2; ++q_) { const int idv_ = __shfl((grp) < 8 ? id0 : id1, (8 * (grp) + 4 * q_ + kg) & 63); \
        const unsigned char* vp_ = V6 + (unsigned)(idv_ * 1536 + n16); const unsigned char* vq_ = V6 + (unsigned)(idv_ * 1536 + 256 + n8); \
        _Pragma("unroll") for (int t_ = 0; t_ < 4; ++t_) { vb[q_][t_].a = *(const u32x4_*)(vp_ + 384 * t_); vb[q_][t_].b = *(const u32x2_*)(vq_ + 384 * t_); } } } while (0)
#define M4_ISSUE_U(grp) do { _Pragma("unroll") for (int e_ = 0; e_ < 8; ++e_) { const int ee_ = 8 * (grp) + e_; const int id_ = __builtin_amdgcn_readlane(ee_ < 64 ? id0 : id1, ee_ & 63); \
        ub[e_].a = *(const u32x4_*)(U4 + (size_t)id_ * 1024 + 16 * lane); } } while (0)
#define M4_ISSUE_V(grp) do { _Pragma("unroll") for (int q_ = 0; q_ < 2; ++q_) { const int idv_ = __shfl((grp) < 8 ? id0 : id1, (8 * (grp) + 4 * q_ + kg) & 63); \
        const unsigned char* vp_ = V4 + (unsigned)(idv_ * 1024 + n16); \
        _Pragma("unroll") for (int t_ = 0; t_ < 4; ++t_) vb[q_][t_].a = *(const u32x4_*)(vp_ + 256 * t_); } } while (0)
#define MQ_ISSUE_U(grp) do { _Pragma("unroll") for (int e_ = 0; e_ < 8; ++e_) { const int ee_ = 8 * (grp) + e_; const int id_ = __builtin_amdgcn_readlane(ee_ < 64 ? id0 : id1, ee_ & 63); \
        if (e_ < 4) { const unsigned char* up_ = U6 + (size_t)id_ * 1536; ub[e_].a = *(const u32x4_*)(up_ + 16 * lane); ub[e_].b = *(const u32x2_*)(up_ + 1024 + 8 * lane); } \
        else ub[e_].a = *(const u32x4_*)(U4 + (size_t)id_ * 1024 + 16 * lane); } } while (0)
#define MQ_ISSUE_V(grp) do { { const int idv_ = __shfl((grp) < 8 ? id0 : id1, (8 * (grp) + kg) & 63); \
        const unsigned char* vp_ = V6 + (unsigned)(idv_ * 1536 + n16); const unsigned char* vq_ = V6 + (unsigned)(idv_ * 1536 + 256 + n8); \
        _Pragma("unroll") for (int t_ = 0; t_ < 4; ++t_) { vb[0][t_].a = *(const u32x4_*)(vp_ + 384 * t_); vb[0][t_].b = *(const u32x2_*)(vq_ + 384 * t_); } } \
      { const int idv_ = __shfl((grp) < 8 ? id0 : id1, (8 * (grp) + 4 + kg) & 63); const unsigned char* vp_ = V4 + (unsigned)(idv_ * 1024 + n16); \
        _Pragma("unroll") for (int t_ = 0; t_ < 4; ++t_) vb[1][t_].a = *(const u32x4_*)(vp_ + 256 * t_); } } while (0)
#define MQ_U(e_) ((e_) < 4 ? M6_MFMA(xa, M6_B(ub[e_]), zero4, xsb) : M4_MFMA(xa, M4_B(ub[e_]), zero4, xsb))
#define MQ_V(q_, A_, t_, c_, s_) ((q_) == 0 ? M6_MFMA(A_, M6_B(vb[q_][t_]), c_, s_) : M4_MFMA(A_, M4_B(vb[q_][t_]), c_, s_))
#define M6_U(e_) M6_MFMA(xa, M6_B(ub[e_]), zero4, xsb)
#define M4_U(e_) M4_MFMA(xa, M4_B(ub[e_]), zero4, xsb)
#define M6_V(q_, A_, t_, c_, s_) M6_MFMA(A_, M6_B(vb[q_][t_]), c_, s_)
#define M4_V(q_, A_, t_, c_, s_) M4_MFMA(A_, M4_B(vb[q_][t_]), c_, s_)
#define MX_GROUP(grp, UOP, VOP, NEXT_U, NEXT_V) do { float a_[8]; \
        _Pragma("unroll") for (int e_ = 0; e_ < 8; ++e_) { const f32x4_ c_ = UOP(e_); \
            const float t0_ = lb0 ? c_[1] : c_[0], t1_ = lb0 ? c_[3] : c_[2]; const float s_ = lb1 ? t1_ : t0_; a_[e_] = dg ? s_ : 0.f; } \
        NEXT_U; \
        const int ow_ = (8 * (grp) + (lane >> 3)) & 63; const float su_ = __shfl((grp) < 8 ? su0 : su1, ow_), sv_ = __shfl((grp) < 8 ? sv0 : sv1, ow_); \
        const float h0_ = P6_SW32(a_[0], a_[4]), h1_ = P6_SW32(a_[1], a_[5]), h2_ = P6_SW32(a_[2], a_[6]), h3_ = P6_SW32(a_[3], a_[7]); \
        const float r0_ = P6_SW16(h0_, h2_), r1_ = P6_SW16(h1_, h3_); \
        const bool hi8_ = (lane & 8) != 0; const float keep_ = hi8_ ? r1_ : r0_, send_ = hi8_ ? r0_ : r1_; \
        float kk_ = keep_ + P6_DPP(send_, 0x128); \
        kk_ += P6_DPP(kk_, 0xB1); kk_ += P6_DPP(kk_, 0x4E); kk_ += P6_DPP(kk_, 0x141); \
        const float hid_ = su_ * kk_; const float wv_ = sv_ * (0.5f * hid_ * (1.f + erff(hid_ * 0.70710678f))); \
        _Pragma("unroll") for (int q_ = 0; q_ < 2; ++q_) { const float wq_ = __shfl(wv_, 32 * q_ + 8 * kg); \
            const unsigned wb_ = __float_as_uint(wq_), wr_ = wb_ + 0x00080000u; const int wsb_ = (int)((wr_ >> 23) & 255u); \
            const unsigned cd_ = 8u | ((wr_ >> 20) & 7u) | ((wb_ >> 26) & 32u); const unsigned lo_ = cd_ << wsh, hi_ = (cd_ >> 1) >> (31 - wsh); \
            const int a0_ = (int)(wrl == 0 ? lo_ : 0u), a1_ = (int)(wrl == 1 ? lo_ : (wrl == 0 ? hi_ : 0u)), a2_ = (int)(wrl == 2 ? lo_ : (wrl == 1 ? hi_ : 0u)); \
            const i32x8g_ A0_ = {a0_, a1_, a2_, 0, 0, 0, 0, 0}, A1_ = {0, 0, 0, a0_, a1_, a2_, 0, 0}; \
            _Pragma("unroll") for (int t_ = 0; t_ < 4; ++t_) { acc[t_][0] = VOP(q_, A0_, t_, acc[t_][0], wsb_); acc[t_][1] = VOP(q_, A1_, t_, acc[t_][1], wsb_); } } \
        NEXT_V; } while (0)
DEV void peer_gather_tokm(const bf16* __restrict__ H1, int id0, int id1, float gp0, float gp1, const unsigned char* __restrict__ U6, const unsigned char* __restrict__ V6,
                          const unsigned char* __restrict__ U4, const unsigned char* __restrict__ V4, const float* __restrict__ RSU, const float* __restrict__ RSV,
                          const bf16* __restrict__ PLEB, const float* lg, const float* lb, float* __restrict__ out, int tok, int lane) {
    const int kg = lane >> 4, n16 = (lane & 15) * 16, n8 = (lane & 15) * 8, r4 = (lane & 15) >> 2, wsh = (6 * (lane & 15)) & 31, wrl = (6 * (lane & 15)) >> 5;
    const bool lb0 = (lane & 1) != 0, lb1 = (lane & 2) != 0, dg = kg == r4;
    i32x8g_ xa; int xsb;
    { float xf[32]; float m = 0.f;
#pragma unroll
      for (int u = 0; u < 4; ++u) { const uint4 w = *(const uint4*)(H1 + (size_t)tok * 2048 + 32 * lane + 8 * u); const unsigned q[4] = {w.x, w.y, w.z, w.w};
#pragma unroll
          for (int k = 0; k < 4; ++k) { xf[8 * u + 2 * k] = __uint_as_float(q[k] << 16); xf[8 * u + 2 * k + 1] = __uint_as_float(q[k] & 0xffff0000u); m = fmaxf(m, fmaxf(fabsf(xf[8 * u + 2 * k]), fabsf(xf[8 * u + 2 * k + 1]))); } }
      const unsigned eb = (__float_as_uint(m * 1.0666667f) >> 23) & 255u; const bool ok = eb >= 3u;
      xsb = ok ? (int)eb - 2 : 0; const float inv = ok ? __uint_as_float((256u - eb) << 23) : 0.f;
      unsigned p[32];
#pragma unroll
      for (int i = 0; i < 32; ++i) { const float a = fabsf(xf[i]) * inv; const float t = fminf(fminf(8.f * a, 4.f * a + 8.f), 2.f * a + 16.f); p[i] = (__float_as_uint(t + 8388608.f) & 31u) | ((__float_as_uint(xf[i]) >> 26) & 32u); }
      unsigned w6[6];
#pragma unroll
      for (int t = 0; t < 2; ++t) { const unsigned* c = p + 16 * t;
          w6[3 * t] = c[0] | (c[1] << 6) | (c[2] << 12) | (c[3] << 18) | (c[4] << 24) | (c[5] << 30);
          w6[3 * t + 1] = (c[5] >> 2) | (c[6] << 4) | (c[7] << 10) | (c[8] << 16) | (c[9] << 22) | (c[10] << 28);
          w6[3 * t + 2] = (c[10] >> 4) | (c[11] << 2) | (c[12] << 8) | (c[13] << 14) | (c[14] << 20) | (c[15] << 26); }
      xa = (i32x8g_){(int)w6[0], (int)w6[1], (int)w6[2], (int)w6[3], (int)w6[4], (int)w6[5], 0, 0}; }
    const f32x4_ zero4 = {0.f, 0.f, 0.f, 0.f};
    f32x4_ acc[4][2];
#pragma unroll
    for (int t = 0; t < 4; ++t) { acc[t][0] = zero4; acc[t][1] = zero4; }
    const int so = (FP4_LOW == 1 && (lane & 8)) || (FP4_LOW == 2 && (lane & 12)) || FP4_LOW == 3 ? PNK * PNK : 0;
    const float su0 = RSU[id0 + so], su1 = RSU[id1 + so], sv0 = RSV[id0 + so] * gp0, sv1 = RSV[id1 + so] * gp1;
    R6_ ub[8], vb[2][4];
#if FP4_LOW == 1
    M6_ISSUE_U(0); M6_ISSUE_V(0);
    for (int g = 0; g < 14; g += 2) { MX_GROUP(g, M6_U, M6_V, M4_ISSUE_U(g + 1), M4_ISSUE_V(g + 1)); MX_GROUP(g + 1, M4_U, M4_V, M6_ISSUE_U(g + 2), M6_ISSUE_V(g + 2)); }
    MX_GROUP(14, M6_U, M6_V, M4_ISSUE_U(15), M4_ISSUE_V(15)); MX_GROUP(15, M4_U, M4_V, (void)0, (void)0);
#elif FP4_LOW == 2
    MQ_ISSUE_U(0); MQ_ISSUE_V(0);
    for (int g = 0; g < 14; g += 2) { MX_GROUP(g, MQ_U, MQ_V, M4_ISSUE_U(g + 1), M4_ISSUE_V(g + 1)); MX_GROUP(g + 1, M4_U, M4_V, MQ_ISSUE_U(g + 2), MQ_ISSUE_V(g + 2)); }
    MX_GROUP(14, MQ_U, MQ_V, M4_ISSUE_U(15), M4_ISSUE_V(15)); MX_GROUP(15, M4_U, M4_V, (void)0, (void)0);
#elif FP4_LOW == 3
    M4_ISSUE_U(0); M4_ISSUE_V(0);
    for (int g = 0; g < 14; ++g) MX_GROUP(g, M4_U, M4_V, M4_ISSUE_U(g + 1), M4_ISSUE_V(g + 1));
    MX_GROUP(14, M4_U, M4_V, M4_ISSUE_U(15), M4_ISSUE_V(15)); MX_GROUP(15, M4_U, M4_V, (void)0, (void)0);
#else
    M6_ISSUE_U(0); M6_ISSUE_V(0);
    for (int g = 0; g < 15; ++g) MX_GROUP(g, M6_U, M6_V, M6_ISSUE_U(g + 1), M6_ISSUE_V(g + 1));
    MX_GROUP(15, M6_U, M6_V, (void)0, (void)0);
#endif
    asm volatile("" : "+s"(lg), "+s"(lb));
    const int dl = 32 * (lane & 15) + 4 * kg; float s = 0.f;
#pragma unroll
    for (int t = 0; t < 4; ++t)
#pragma unroll
        for (int h = 0; h < 2; ++h) { const size_t o = (size_t)tok * 2048 + 512 * t + 16 * h + dl; const u32x2_ hw = *(const u32x2_*)(H1 + o), pw = *(const u32x2_*)(PLEB + o);
            f32x4_ y = acc[t][h];
            y[0] += __uint_as_float(hw.x << 16) * ALPHA + __uint_as_float(pw.x << 16); y[1] += __uint_as_float(hw.x & 0xffff0000u) * ALPHA + __uint_as_float(pw.x & 0xffff0000u);
            y[2] += __uint_as_float(hw.y << 16) * ALPHA + __uint_as_float(pw.y << 16); y[3] += __uint_as_float(hw.y & 0xffff0000u) * ALPHA + __uint_as_float(pw.y & 0xffff0000u);
            acc[t][h] = y; s += (y[0] + y[1]) + (y[2] + y[3]); }
    const float mean = wave_sum(s) * (1.f / D); float q = 0.f;
#pragma unroll
    for (int t = 0; t < 4; ++t)
#pragma unroll
        for (int h = 0; h < 2; ++h) { acc[t][h] -= mean; const f32x4_ y = acc[t][h]; q += (y[0] * y[0] + y[1] * y[1]) + (y[2] * y[2] + y[3] * y[3]); }
    const float rstd = rsqrtf(wave_sum(q) * (1.f / D) + LN_EPS);
#pragma unroll
    for (int t = 0; t < 4; ++t)
#pragma unroll
        for (int h = 0; h < 2; ++h) { const int c = 512 * t + 16 * h + dl; const f32x4_ gg = *(const f32x4_*)(lg + c), bb = *(const f32x4_*)(lb + c);
            *(f32x4_*)(out + (size_t)tok * 2048 + c) = acc[t][h] * rstd * gg + bb; }
}

constexpr int PS_ROW = 528, PS_IDS = 256 * PS_ROW, PS_GT = PS_IDS + 8192;
#define TOPK_INSERT(tv, ti, xv, xi) do { if ((xv) > tv[15]) { tv[15] = (xv); ti[15] = (xi); \
        _Pragma("unroll") for (int k_ = 15; k_ > 0; --k_) { const bool sw_ = tv[k_] > tv[k_ - 1]; const float fa_ = tv[k_ - 1], fb_ = tv[k_]; const int ia_ = ti[k_ - 1], ib_ = ti[k_]; \
            tv[k_ - 1] = sw_ ? fb_ : fa_; tv[k_] = sw_ ? fa_ : fb_; ti[k_ - 1] = sw_ ? ib_ : ia_; ti[k_] = sw_ ? ia_ : ib_; } } } while (0)
template <bool DESC> DEV void sort16(unsigned (&a)[16]) {
#pragma unroll
    for (int k = 2; k <= 16; k <<= 1)
#pragma unroll
        for (int j = k >> 1; j > 0; j >>= 1)
#pragma unroll
            for (int i = 0; i < 16; ++i) { const int l = i ^ j; if (l > i) { const bool up = ((i & k) == 0) != DESC; const unsigned lo = a[i] < a[l] ? a[i] : a[l], hi = a[i] < a[l] ? a[l] : a[i]; a[i] = up ? lo : hi; a[l] = up ? hi : lo; } }
}
DEV void merge16(unsigned (&top)[16], const unsigned (&asc)[16]) {
#pragma unroll
    for (int i = 0; i < 16; ++i) top[i] = top[i] > asc[i] ? top[i] : asc[i];
#pragma unroll
    for (int j = 8; j > 0; j >>= 1)
#pragma unroll
        for (int i = 0; i < 16; ++i) if ((i & j) == 0) { const unsigned hi = top[i] > top[i + j] ? top[i] : top[i + j], lo = top[i] > top[i + j] ? top[i + j] : top[i]; top[i] = hi; top[i + j] = lo; }
}
DEV void peer_tile(LASF unsigned char* lds, const bf16* __restrict__ QP, const bf16* __restrict__ KEYS, const bf16* __restrict__ H1, const unsigned char* __restrict__ U8, const unsigned char* __restrict__ V8, const unsigned char* __restrict__ U4, const unsigned char* __restrict__ V4,
                   const float* __restrict__ RSU, const float* __restrict__ RSV, const bf16* __restrict__ PLEB, const float* __restrict__ lg, const float* __restrict__ lb, float* __restrict__ out, int tile, int tid) {
    const int lane = tid & 63, wave = __builtin_amdgcn_readfirstlane(tid >> 6), fr = lane & 15, g = lane >> 4, tok0 = tile * 16;
    LASF float* SC = (LASF float*)lds; LASF int* LID = (LASF int*)(lds + PS_IDS); LASF float* LGT = (LASF float*)(lds + PS_GT);
#pragma unroll
    for (int half = 0; half < 2; ++half) {
        bf16x8_ qa[4];
#pragma unroll
        for (int ks = 0; ks < 4; ++ks) qa[ks] = *(const bf16x8_*)(QP + (size_t)(tok0 + fr) * 2048 + wave * 256 + half * 128 + 32 * ks + 8 * g);
        const bf16* kb = KEYS + ((size_t)(wave * 2 + half) * 128 + fr) * 128 + 8 * g;
#pragma unroll
        for (int nt = 0; nt < 8; ++nt) { f32x4_ acc = {0.f, 0.f, 0.f, 0.f};
#pragma unroll
            for (int ks = 0; ks < 4; ++ks) acc = __builtin_amdgcn_mfma_f32_16x16x32_bf16(qa[ks], *(const bf16x8_*)(kb + (size_t)nt * 16 * 128 + 32 * ks), acc, 0, 0, 0);
#pragma unroll
            for (int r = 0; r < 4; ++r) SC[((wave * 2 + half) * 16 + 4 * g + r) * (PS_ROW / 4) + 16 * nt + fr] = acc[r]; } }
    __syncthreads();
#define KEY_OF(f, low, mask) ({ const unsigned u_ = __float_as_uint(f); ((u_ ^ ((unsigned)((int)u_ >> 31) | 0x80000000u)) & ~(mask)) | (low); })
#define VAL_OF(kk, mask) ({ const unsigned k_ = (kk) & ~(mask); __uint_as_float(k_ ^ ((k_ >> 31) ? 0x80000000u : 0xffffffffu)); })
#define KEY_INSERT(tk, key) do { if ((key) > tk[15]) { const unsigned ky_ = (key); \
        _Pragma("unroll") for (int k_ = 15; k_ > 0; --k_) { const unsigned m_ = tk[k_] > ky_ ? tk[k_] : ky_; tk[k_] = tk[k_ - 1] < m_ ? tk[k_ - 1] : m_; } \
        tk[0] = tk[0] > ky_ ? tk[0] : ky_; } } while (0)
    { LASF float* row = SC + (tid & 255) * (PS_ROW / 4); const int hf = tid >> 8; unsigned tk[16];
#pragma unroll 1
        for (int b4 = 0; b4 < 4; ++b4) { const int bt = 4 * hf + b4; unsigned nk[16];
#pragma unroll
            for (int c4 = 0; c4 < 4; ++c4) { const f32x4_ v = *(const LASF f32x4_*)(row + 16 * bt + 4 * c4);
#pragma unroll
                for (int j = 0; j < 4; ++j) nk[4 * c4 + j] = KEY_OF(v[j], (unsigned)(127 - (16 * bt + 4 * c4 + j)), 127u); }
            if (b4 == 0) { sort16<true>(nk);
#pragma unroll
                for (int k = 0; k < 16; ++k) tk[k] = nk[k]; }
            else { sort16<false>(nk); merge16(tk, nk); } }
        if (hf == 1) {
#pragma unroll
            for (int k = 0; k < 16; ++k) ((LASF unsigned*)row)[64 + k] = tk[15 - k]; }
        __syncthreads();
        if (hf == 0) { unsigned asc[16];
#pragma unroll
            for (int k4 = 0; k4 < 4; ++k4) { const u32x4_ a4 = *(const LASF u32x4_*)((LASF unsigned*)row + 64 + 4 * k4); asc[4 * k4] = a4[0]; asc[4 * k4 + 1] = a4[1]; asc[4 * k4 + 2] = a4[2]; asc[4 * k4 + 3] = a4[3]; }
            merge16(tk, asc);
#pragma unroll
            for (int k = 0; k < 16; ++k) { row[k] = VAL_OF(tk[k], 127u); ((LASF int*)row)[16 + k] = 127 - (int)(tk[k] & 127u); } } }
    __syncthreads();
    if (tid < 128) { int tc_ = tid; asm volatile("" : "+v"(tc_));
        const int tk_ = tc_ & 15, hh = tc_ >> 4; const LASF float* ra = SC + ((hh * 2) * 16 + tk_) * (PS_ROW / 4); const LASF float* rb = SC + ((hh * 2 + 1) * 16 + tk_) * (PS_ROW / 4);
        unsigned tk[16], cd[64]; float fa[16], fb[16];
#pragma unroll
        for (int k4 = 0; k4 < 4; ++k4) { const f32x4_ va = *(const LASF f32x4_*)(ra + 4 * k4), vb_ = *(const LASF f32x4_*)(rb + 4 * k4);
#pragma unroll
            for (int r = 0; r < 4; ++r) { fa[4 * k4 + r] = va[r]; fb[4 * k4 + r] = vb_[r]; } }
        { int c = 0;
#pragma unroll
          for (int i = 0; i < 16; ++i)
#pragma unroll
              for (int j = 0; j < 16; ++j) if ((i + 1) * (j + 1) <= 16) { cd[c] = KEY_OF(fa[i] + fb[j], (unsigned)(255 - (16 * i + j)), 255u); ++c; }
#pragma unroll
          for (int k = 50; k < 64; ++k) cd[k] = 0u; }
#pragma unroll
        for (int bt = 0; bt < 4; ++bt) { unsigned nk[16];
#pragma unroll
            for (int k = 0; k < 16; ++k) nk[k] = cd[16 * bt + k];
            if (bt == 0) { sort16<true>(nk);
#pragma unroll
                for (int k = 0; k < 16; ++k) tk[k] = nk[k]; }
            else { sort16<false>(nk); merge16(tk, nk); } }
        float tv[16]; const float mx = VAL_OF(tk[0], 255u); float sum = 0.f;
#pragma unroll
        for (int k = 0; k < 16; ++k) { tv[k] = __expf(VAL_OF(tk[k], 255u) - mx); sum += tv[k]; }
        const float inv = 1.f / sum;
#pragma unroll
        for (int k = 0; k < 16; ++k) { const int slot = 255 - (int)(tk[k] & 255u); LID[tk_ * 128 + hh * 16 + k] = ((const LASF int*)ra)[16 + (slot >> 4)] * 128 + ((const LASF int*)rb)[16 + (slot & 15)]; LGT[tk_ * 128 + hh * 16 + k] = tv[k] * inv; } }
    __syncthreads();
#undef KEY_OF
#undef VAL_OF
#undef KEY_INSERT
#pragma unroll 1
    for (int u = 0; u < 2; ++u) { const int tl = 2 * wave + u;
        peer_gather_tokm(H1, LID[tl * 128 + lane], LID[tl * 128 + 64 + lane], LGT[tl * 128 + lane], LGT[tl * 128 + 64 + lane], U8, V8, U4, V4, RSU, RSV, PLEB, lg, lb, out, tok0 + tl, lane); }
    __syncthreads();
}

namespace pg8 {
#define PG8_LAS __attribute__((address_space(3)))
typedef unsigned short bf16_t;
typedef short bf16x8 __attribute__((ext_vector_type(8)));
typedef float f32x4 __attribute__((ext_vector_type(4)));
typedef unsigned u32x4 __attribute__((ext_vector_type(4)));
constexpr int BM = 256, BK = 64, HALF = 128, HTB = HALF * BK * 2  , STAGE_BYTES = 8 * HTB, NXCD = 8, WGM = 8;
__host__ __device__ __forceinline__ int lds_byte(int r, int c) { const int st = (r >> 4) * 2 + (c >> 5), rr = r & 15, cc = c & 31, ob = rr * 64 + cc * 2; return st * 1024 + (ob ^ (((ob >> 9) & 1) << 5)); }
__host__ __device__ __forceinline__ void stage_rc(int b, int& R, int& C) { const int st = b / 1024, sb = b % 1024, swz = sb ^ (((sb >> 9) & 1) << 5); R = (st >> 1) * 16 + swz / 64; C = (st & 1) * 32 + (swz % 64) / 2; }
__host__ __device__ __forceinline__ int perm32(int rho) { const int n = rho >> 4, i = rho & 15; return 8 * (i >> 2) + 4 * n + (i & 3); }
struct Unit { int pm, pn, which; };
struct Gemm { const bf16_t* A; const bf16_t* Bt; const bf16_t* A2; const bf16_t* Bt2; int K; };

struct StaticOrder {
    int nM, nN, nwg, G, c;
    __host__ __device__ void init(int M, int N, int G_, int c_) { nM = M / BM; nN = N / BM; nwg = nM * nN; G = G_; c = c_; }
    __host__ __device__ bool next(int i, Unit& u) const {
        const long L = (long)i * G + c; if (L >= nwg) return false;
        int wgid = (int)L; { const int q = nwg / NXCD, r = nwg % NXCD, xcd = wgid % NXCD, off = wgid / NXCD; wgid = (xcd < r ? xcd * (q + 1) : r * (q + 1) + (xcd - r) * q) + off; }
        const int nig = WGM * nN, gid = wgid / nig, fm = gid * WGM, gsz = (nM - fm) < WGM ? (nM - fm) : WGM;
        u.pm = fm + ((wgid % nig) % gsz); u.pn = (wgid % nig) / gsz; return true;
    }
    __device__ __forceinline__ void a_ready(const Unit&) const {}
    __device__ __forceinline__ void done(const Unit&) const {}
};
typedef __bf16 bf16x2_t __attribute__((ext_vector_type(2)));
typedef float f32x2_t __attribute__((ext_vector_type(2)));
__device__ __forceinline__ unsigned cvt_pk_bf16(float lo, float hi) { const f32x2_t v = {lo, hi}; return __builtin_bit_cast(unsigned, __builtin_convertvector(v, bf16x2_t)); }
typedef float f32x2 __attribute__((ext_vector_type(2)));
__device__ __forceinline__ f32x2 gelu_pk(f32x2 v) {
    const f32x2 av = __builtin_elementwise_abs(v), d = av * 0.2316418882f + 1.0f;
    f32x2 t; t.x = __builtin_amdgcn_rcpf(d.x); t.y = __builtin_amdgcn_rcpf(d.y);
    f32x2 q = t * 0.5307027145f + (-0.7265760135f); q = q * t + 0.7107068705f; q = q * t + (-0.142248368f); q = q * t + 0.127414796f; q = q * t;
    const f32x2 s = (v * v) * (-0.72134752044f);
    f32x2 e; e.x = __builtin_amdgcn_exp2f(s.x); e.y = __builtin_amdgcn_exp2f(s.y);
    const f32x2 m = v * (q * e), r = v - m;
    f32x2 o; o.x = v.x < 0.f ? m.x : r.x; o.y = v.y < 0.f ? m.y : r.y; return o;
}


struct Order2 {
    int nM0, nN0, n0, nM1, nN1, n1, G, c;
    __device__ __forceinline__ void init(int M0, int N0, int M1, int N1_, int G_, int c_) { nM0 = M0 / BM; nN0 = N0 / BM; n0 = nM0 * nN0; nM1 = M1 / BM; nN1 = N1_ / BM; n1 = nM1 * nN1; G = G_; c = c_; }
    static __device__ __forceinline__ void map(int wgid, int nwg, int nM, int nN, Unit& u) {
        { const int q = nwg / NXCD, r = nwg % NXCD, xcd = wgid % NXCD, off = wgid / NXCD; wgid = (xcd < r ? xcd * (q + 1) : r * (q + 1) + (xcd - r) * q) + off; }
        const int nig = WGM * nN, gid = wgid / nig, fm = gid * WGM, gsz = (nM - fm) < WGM ? (nM - fm) : WGM;
        u.pm = fm + ((wgid % nig) % gsz); u.pn = (wgid % nig) / gsz; }
    __device__ __forceinline__ bool next(int i, Unit& u) const {
        int L = i * G + c;
        if (L < n0) { map(L, n0, nM0, nN0, u); u.which = 0; return true; }
        L -= n0; if (L < n1) { map(L, n1, nM1, nN1, u); u.which = 1; return true; }
        return false; }
    __device__ __forceinline__ void a_ready(const Unit&) const {}
    __device__ __forceinline__ void done(const Unit&) const {}
};
__device__ __forceinline__ void st8bf(bf16_t* p, f32x4 v0, f32x4 v1) { u32x4 w; w.x = cvt_pk_bf16(v0[0], v0[1]); w.y = cvt_pk_bf16(v0[2], v0[3]); w.z = cvt_pk_bf16(v1[0], v1[1]); w.w = cvt_pk_bf16(v1[2], v1[3]); *(u32x4*)p = w; }
__device__ __forceinline__ void st8f8(unsigned char* p, f32x4 v0, f32x4 v1) { int a = 0, b = 0; a = __builtin_amdgcn_cvt_pk_fp8_f32(v0[0], v0[1], a, false); a = __builtin_amdgcn_cvt_pk_fp8_f32(v0[2], v0[3], a, true);
    b = __builtin_amdgcn_cvt_pk_fp8_f32(v1[0], v1[1], b, false); b = __builtin_amdgcn_cvt_pk_fp8_f32(v1[2], v1[3], b, true); typedef int i32x2_ __attribute__((ext_vector_type(2))); *(i32x2_*)p = (i32x2_){a, b}; }
__device__ __forceinline__ void ld8bf(const bf16_t* p, f32x4& v0, f32x4& v1) { const u32x4 w = *(const u32x4*)p;
    v0[0] = __uint_as_float(w.x << 16); v0[1] = __uint_as_float(w.x & 0xffff0000u); v0[2] = __uint_as_float(w.y << 16); v0[3] = __uint_as_float(w.y & 0xffff0000u);
    v1[0] = __uint_as_float(w.z << 16); v1[1] = __uint_as_float(w.z & 0xffff0000u); v1[2] = __uint_as_float(w.w << 16); v1[3] = __uint_as_float(w.w & 0xffff0000u); }
__device__ __forceinline__ f32x4 sig4(f32x4 v) { f32x4 r; r[0] = sigmoidf_(v[0]); r[1] = sigmoidf_(v[1]); r[2] = sigmoidf_(v[2]); r[3] = sigmoidf_(v[3]); return r; }
template <int KIND> struct Epi {
    static constexpr bool PERM = true, AFTER_DRAIN = false;
    EpiArgs e;
    __device__ __forceinline__ void operator()(const f32x4 (&acc)[2][2][4][2], const Unit& u, int wr, int wc, int fr, int fq) const {
        const int row0 = u.pm * BM + wr * 64 + fr, colu = u.pn * BM + wc * 32 + 8 * fq;
        if (KIND == EK_MAIN && u.which == 1) {
#pragma unroll
            for (int ai = 0; ai < 2; ++ai)
#pragma unroll
                for (int m = 0; m < 4; ++m) { const int row = row0 + ai * HALF + m * 16; const float bv = e.bias2[row];
#pragma unroll
                    for (int bj = 0; bj < 2; ++bj) st8bf(e.o5 + (size_t)row * T + colu + bj * HALF, acc[ai][bj][m][0] + bv, acc[ai][bj][m][1] + bv); }
            return; }
        bf16_t* ob = e.o0; int ldc = 2048, c0 = colu, mode = 0; float sc = 1.f;
        if (KIND == EK_MAIN) { const int pn = u.pn, cw = wc * 32 + 8 * fq;
            if (pn < 8) { ob = e.o0; c0 = pn * 256 + cw; sc = pn < 4 ? 0.125f : 1.f; }
            else if (pn < 16) { ob = e.o1; c0 = (pn - 8) * 256 + cw; sc = pn < 12 ? 0.0625f : 1.f; }
            else if (pn < 24) { ob = e.o2; c0 = (pn - 16) * 256 + cw; mode = 1; }
            else if (pn < 40) { ob = e.o3; c0 = (pn - 24) * 256 + cw; ldc = 4096; mode = 2; }
            else { ob = e.o4; c0 = cw; ldc = 256; } }
        if (KIND == EK_2) { if (e.qonly) { ob = e.o1; mode = 1; } else if (u.pn >= 8) { ob = e.o1; c0 = colu - 2048; mode = 1; } }
        if (KIND == EK_MAIN) {
#pragma unroll
            for (int bj = 0; bj < 2; ++bj) { const float* bp_ = e.bias + colu + bj * HALF; asm volatile("" : "+v"(bp_)); const f32x4 bs0 = *(const f32x4*)bp_, bs1 = *(const f32x4*)(bp_ + 4); const int cc = c0 + bj * HALF;
#pragma unroll
                for (int ai = 0; ai < 2; ++ai)
#pragma unroll
                    for (int m = 0; m < 4; ++m) { const int row = row0 + ai * HALF + m * 16; f32x4 v0 = acc[ai][bj][m][0] + bs0, v1 = acc[ai][bj][m][1] + bs1;
                        if (mode == 0) { v0 *= sc; v1 *= sc; } else if (mode == 1) { v0 *= sig4(v0); v1 *= sig4(v1); } else { v0 = sig4(v0); v1 = sig4(v1); }
                        st8bf(ob + (size_t)row * ldc + cc, v0, v1); } }
            return; }
#pragma unroll
        for (int ai = 0; ai < 2; ++ai)
#pragma unroll
            for (int m = 0; m < 4; ++m) { const int row = row0 + ai * HALF + m * 16;
#pragma unroll
                for (int bj = 0; bj < 2; ++bj) { f32x4 v0 = acc[ai][bj][m][0], v1 = acc[ai][bj][m][1]; const int cc = c0 + bj * HALF;
                    if (KIND == EK_MAIN) { const float* bp_ = e.bias + colu + bj * HALF; asm volatile("" : "+v"(bp_));
                        v0 += *(const f32x4*)bp_; v1 += *(const f32x4*)(bp_ + 4);
                        if (mode == 0) { v0 *= sc; v1 *= sc; } else if (mode == 1) { v0 *= sig4(v0); v1 *= sig4(v1); } else { v0 = sig4(v0); v1 = sig4(v1); }
                        st8bf(ob + (size_t)row * ldc + cc, v0, v1); }
                    else if (KIND == EK_A) { f32x4 g0, g1; ld8bf(e.a0 + (size_t)row * 4096 + cc, g0, g1); st8bf(ob + (size_t)row * 2048 + cc, g0 * v0, g1 * v1); }
                    else if (KIND == EK_B) { f32x4 g0, g1, t0, t1; ld8bf(e.a0 + (size_t)row * 4096 + 2048 + cc, g0, g1); ld8bf(e.a1 + (size_t)row * 2048 + cc, t0, t1); st8f8((unsigned char*)ob + (size_t)row * 2048 + cc, t0 + g0 * v0, t1 + g1 * v1); }
                    else if (KIND == EK_OUT) { f32x4 h0, h1; ld8bf(e.a0 + (size_t)row * 2048 + cc, h0, h1); float* op = e.of + (size_t)row * 2048 + cc; *(f32x4*)op = h0 * ALPHA + v0; *(f32x4*)(op + 4) = h1 * ALPHA + v1; }
                    else if (KIND == EK_PLE) { st8bf(ob + (size_t)row * 2048 + cc, v0, v1); }
                    else if (KIND == EK_2) { if (mode == 0) { f32x4 p0, p1; ld8bf(e.a0 + (size_t)row * 2048 + cc, p0, p1); st8bf(ob + (size_t)row * 2048 + cc, p0 * sig4(v0), p1 * sig4(v1)); } else st8bf(ob + (size_t)row * 2048 + cc, v0, v1); }
                } }
    }
};

struct EpiLnOut {
    static constexpr bool PERM = true, AFTER_DRAIN = true;
    const bf16_t* h0; const float* lng; const float* lnb; bf16_t* h1; unsigned char* h1f8; unsigned long long* xbuf; unsigned* cnt; unsigned* tmo;
    __device__ __forceinline__ void operator()(const f32x4 (&)[2][2][4][2], const Unit&, int, int, int, int) const {}
    __device__ __forceinline__ void fused(f32x4 (&acc)[2][2][4][2], const Unit& u, int wr, int wc, int fr, int fq, PG8_LAS unsigned char* lds, int wid, int lane) const {
        typedef float f32x2v __attribute__((ext_vector_type(2)));
        PG8_LAS f32x2v* P = (PG8_LAS f32x2v*)lds; PG8_LAS f32x2v* S = (PG8_LAS f32x2v*)(lds + 8192);
        const int row0 = u.pm * BM + wr * 64 + fr, colu = u.pn * BM + wc * 32 + 8 * fq, tid = wid * 64 + lane;
#define LNO_BAR() do { asm volatile("s_waitcnt lgkmcnt(0)" ::: "memory"); __builtin_amdgcn_s_barrier(); asm volatile("" ::: "memory"); } while (0)
#pragma unroll
        for (int ai = 0; ai < 2; ++ai)
#pragma unroll
            for (int m = 0; m < 4; ++m) { const int row = row0 + ai * HALF + m * 16; float s1 = 0.f, s2 = 0.f;
#pragma unroll
                for (int bj = 0; bj < 2; ++bj) { f32x4 ha, hb; ld8bf(h0 + (size_t)row * 2048 + colu + bj * HALF, ha, hb);
                    const f32x4 v0 = acc[ai][bj][m][0] + ha * ALPHA, v1 = acc[ai][bj][m][1] + hb * ALPHA; acc[ai][bj][m][0] = v0; acc[ai][bj][m][1] = v1;
                    s1 += (v0[0] + v0[1]) + (v0[2] + v0[3]) + (v1[0] + v1[1]) + (v1[2] + v1[3]); s2 += (v0[0] * v0[0] + v0[1] * v0[1]) + (v0[2] * v0[2] + v0[3] * v0[3]) + (v1[0] * v1[0] + v1[1] * v1[1]) + (v1[2] * v1[2] + v1[3] * v1[3]); }
                s1 += __shfl_xor(s1, 16); s1 += __shfl_xor(s1, 32); s2 += __shfl_xor(s2, 16); s2 += __shfl_xor(s2, 32);
                if (fq == 0) P[(ai * HALF + wr * 64 + m * 16 + fr) * 4 + wc] = (f32x2v){s1, s2}; }
        LNO_BAR();
        if (tid < 256) { const f32x2v a = P[tid * 4], b = P[tid * 4 + 1], c = P[tid * 4 + 2], d = P[tid * 4 + 3]; const float t1 = (a.x + b.x) + (c.x + d.x), t2 = (a.y + b.y) + (c.y + d.y);
            __hip_atomic_store(xbuf + ((size_t)(u.pm * BM + tid) * 8 + u.pn), ((unsigned long long)__float_as_uint(t2) << 32) | __float_as_uint(t1), __ATOMIC_RELAXED, __HIP_MEMORY_SCOPE_AGENT); }
        asm volatile("s_waitcnt vmcnt(0)" ::: "memory");
        LNO_BAR();
        if (tid == 0) { __hip_atomic_fetch_add(cnt + 64 * u.pm, 1u, __ATOMIC_RELAXED, __HIP_MEMORY_SCOPE_AGENT);
            unsigned sp = 0; while (__hip_atomic_load(cnt + 64 * u.pm, __ATOMIC_RELAXED, __HIP_MEMORY_SCOPE_AGENT) < 8u) { __builtin_amdgcn_s_sleep(1);
                if ((++sp & 255u) == 0u) { if (__hip_atomic_load(tmo, __ATOMIC_RELAXED, __HIP_MEMORY_SCOPE_AGENT)) break; if (sp > (1u << 18)) { atomicAdd(tmo, 1u); break; } } }
            __builtin_amdgcn_fence(__ATOMIC_ACQUIRE, "agent"); asm volatile("s_waitcnt vmcnt(0)" ::: "memory"); }
        LNO_BAR();
        if (tid < 256) { float t1 = 0.f, t2 = 0.f;
#pragma unroll
            for (int t = 0; t < 8; ++t) { const unsigned long long w = __hip_atomic_load(xbuf + ((size_t)(u.pm * BM + tid) * 8 + t), __ATOMIC_RELAXED, __HIP_MEMORY_SCOPE_AGENT); t1 += __uint_as_float((unsigned)w); t2 += __uint_as_float((unsigned)(w >> 32)); }
            const float mean = t1 * (1.f / 2048.f), var = fmaxf(t2 * (1.f / 2048.f) - mean * mean, 0.f); S[tid] = (f32x2v){mean, rsqrtf(var + LN_EPS)}; }
        LNO_BAR();
#pragma unroll
        for (int ai = 0; ai < 2; ++ai)
#pragma unroll
            for (int m = 0; m < 4; ++m) { const int rl = ai * HALF + wr * 64 + m * 16 + fr, row = u.pm * BM + rl; const f32x2v ms = S[rl];
#pragma unroll
                for (int bj = 0; bj < 2; ++bj) { const int cc = colu + bj * HALF; const f32x4 g0 = *(const f32x4*)(lng + cc), g1 = *(const f32x4*)(lng + cc + 4), b0 = *(const f32x4*)(lnb + cc), b1 = *(const f32x4*)(lnb + cc + 4);
                    const f32x4 y0 = (acc[ai][bj][m][0] - ms.x) * ms.y * g0 + b0, y1 = (acc[ai][bj][m][1] - ms.x) * ms.y * g1 + b1;
                    st8bf(h1 + (size_t)row * 2048 + cc, y0, y1); st8f8(h1f8 + (size_t)row * 2048 + cc, y0, y1); } }
#undef LNO_BAR
    }
};
typedef int i32x8_ __attribute__((ext_vector_type(8)));
template <class Epi, class Sched, bool ALIGN_EPI = false, bool SP2 = false, bool F8 = false>
__device__ __forceinline__ void gemm_phase(PG8_LAS unsigned char* lds, const Gemm g, const Sched& S, const Epi& E) {
    const int tid = threadIdx.x, wid = __builtin_amdgcn_readfirstlane(tid >> 6), lane = tid & 63, wr = wid >> 2, wc = wid & 3, fr = lane & 15, fq = lane >> 4;
    const int K = g.K, nt = K / BK;
    unsigned voffA[2], voffB[2];
#pragma unroll
    for (int i = 0; i < 2; ++i) { int R, C; stage_rc(tid * 16 + i * 8192, R, C); const int Rb = Epi::PERM ? ((R & ~31) + perm32(R & 31)) : R;
        voffA[i] = (unsigned)(R * K + C) * 2u; voffB[i] = (unsigned)(Rb * K + C) * 2u; }
    const size_t kstep = (size_t)(BK * 2);
    const size_t hstep = (size_t)HALF * K * 2;
    const size_t tstep = 2 * hstep;
    const unsigned ldsw = (unsigned)wid * 1024u;
    const int aoff = lds_byte(wr * 64 + fr, fq * 8), boff = lds_byte(wc * 32 + fr, fq * 8);
#define PG8_SA(b, h) (((b) * 2 + (h)) * HTB)
#define PG8_SB(b, h) ((4 + (b) * 2 + (h)) * HTB)
#define PG8_STAGE(bufoff, gbase, voff) do { _Pragma("unroll") for (int _i = 0; _i < 2; ++_i) \
        __builtin_amdgcn_global_load_lds((const unsigned*)((const char*)(gbase) + (voff)[_i]), (PG8_LAS unsigned*)(lds + (bufoff) + ldsw + _i * 8192), 16, 0, 0); } while (0)
#define PG8_LDA(dst, b, h) do { _Pragma("unroll") for (int m = 0; m < 4; ++m) { if constexpr (F8) { const u32x4 l_ = *(const PG8_LAS u32x4*)(lds + PG8_SA(b, h) + aoff + m * 2048), h_ = *(const PG8_LAS u32x4*)(lds + PG8_SA(b, h) + aoff + m * 2048 + 1024); dst##8[m] = __builtin_shufflevector(l_, h_, 0, 1, 2, 3, 4, 5, 6, 7); } \
        else { _Pragma("unroll") for (int k = 0; k < 2; ++k) dst[m][k] = *(const PG8_LAS bf16x8*)(lds + PG8_SA(b, h) + aoff + m * 2048 + k * 1024); } } } while (0)
#define PG8_LDB(dst, b, h) do { _Pragma("unroll") for (int n = 0; n < 2; ++n) { if constexpr (F8) { const u32x4 l_ = *(const PG8_LAS u32x4*)(lds + PG8_SB(b, h) + boff + n * 2048), h_ = *(const PG8_LAS u32x4*)(lds + PG8_SB(b, h) + boff + n * 2048 + 1024); dst##8[n] = __builtin_shufflevector(l_, h_, 0, 1, 2, 3, 4, 5, 6, 7); } \
        else { _Pragma("unroll") for (int k = 0; k < 2; ++k) dst[n][k] = *(const PG8_LAS bf16x8*)(lds + PG8_SB(b, h) + boff + n * 2048 + k * 1024); } } } while (0)
#define PG8_MMA(ai, bj, At, Bt) do { __builtin_amdgcn_s_setprio(1); _Pragma("unroll") for (int m = 0; m < 4; ++m) _Pragma("unroll") for (int n = 0; n < 2; ++n) { \
        if constexpr (F8) asm volatile("v_mfma_scale_f32_16x16x128_f8f6f4 %0, %1, %2, %0, %3, %4 op_sel_hi:[0,0,0]" : "+v"(acc[ai][bj][m][n]) : "v"(Bt##8[n]), "v"(At##8[m]), "v"(sclB), "v"(sclA)); \
        else { _Pragma("unroll") for (int k = 0; k < 2; ++k) acc[ai][bj][m][n] = __builtin_amdgcn_mfma_f32_16x16x32_bf16(Bt[n][k], At[m][k], acc[ai][bj][m][n], 0, 0, 0); } } __builtin_amdgcn_s_setprio(0); } while (0)
#define PG8_WAIT_V(n) asm volatile("s_waitcnt vmcnt(" #n ")" ::: "memory")
#define PG8_WAIT_L(n) asm volatile("s_waitcnt lgkmcnt(" #n ")" ::: "memory")
#define PG8_BAR __builtin_amdgcn_s_barrier()
#define PG8_SCHED __builtin_amdgcn_sched_barrier(0)
    Unit cur, nxt; int ui = 0;
    if (!S.next(0, cur)) return;
    f32x4 acc[2][2][4][2];
#pragma unroll
    for (int a = 0; a < 2; ++a)
#pragma unroll
        for (int b = 0; b < 2; ++b)
#pragma unroll
            for (int m = 0; m < 4; ++m)
#pragma unroll
                for (int n = 0; n < 2; ++n) acc[a][b][m][n] = (f32x4){0.f, 0.f, 0.f, 0.f};
    int sclB = 0x79797979, sclA = 0x7f7f7f7f; asm volatile("" : "+v"(sclB), "+v"(sclA));
    bf16x8 At[4][2], B0[2][2], B1[2][2]; typedef unsigned u32x8 __attribute__((ext_vector_type(8))); u32x8 At8[4], B08[2], B18[2]; (void)At; (void)B0; (void)B1; (void)At8; (void)B08; (void)B18;
    const char* cA = (const char*)(cur.which ? g.A2 : g.A) + (size_t)cur.pm * tstep; const char* cB = (const char*)(cur.which ? g.Bt2 : g.Bt) + (size_t)cur.pn * tstep;
    S.a_ready(cur);
    if constexpr (SP2) {
        PG8_STAGE(PG8_SB(0, 0), cB, voffB); PG8_STAGE(PG8_SB(0, 1), cB + hstep, voffB); PG8_STAGE(PG8_SA(0, 0), cA, voffA); PG8_STAGE(PG8_SA(0, 1), cA + hstep, voffA);
        if (wr == 1) PG8_BAR;
        PG8_WAIT_V(2); PG8_BAR;
        PG8_STAGE(PG8_SB(1, 0), cB + kstep, voffB); PG8_STAGE(PG8_SA(1, 0), cA + kstep, voffA); PG8_STAGE(PG8_SB(1, 1), cB + hstep + kstep, voffB);
        PG8_WAIT_V(6); PG8_BAR;
    } else {
        PG8_STAGE(PG8_SB(0, 0), cB, voffB); PG8_STAGE(PG8_SA(0, 0), cA, voffA); PG8_STAGE(PG8_SB(0, 1), cB + hstep, voffB); PG8_STAGE(PG8_SA(0, 1), cA + hstep, voffA);
        if (wr == 1) PG8_BAR;
        PG8_WAIT_V(4); PG8_BAR;
        PG8_STAGE(PG8_SB(1, 0), cB + kstep, voffB); PG8_STAGE(PG8_SA(1, 0), cA + kstep, voffA); PG8_STAGE(PG8_SB(1, 1), cB + hstep + kstep, voffB);
        PG8_WAIT_V(6); PG8_BAR;
    }
    for (;;) {
        const bool has_next = S.next(ui + 1, nxt);
        const char* nA = has_next ? (const char*)(nxt.which ? g.A2 : g.A) + (size_t)nxt.pm * tstep : cA; const char* nB = has_next ? (const char*)(nxt.which ? g.Bt2 : g.Bt) + (size_t)nxt.pn * tstep : cB;
        for (int t = 0; t < nt; t += 2) {
            const bool last = (t == nt - 2);
            const char* a1 = cA + (size_t)(t + 1) * kstep;
            const char* a2 = last ? nA : cA + (size_t)(t + 2) * kstep; const char* b2 = last ? nB : cB + (size_t)(t + 2) * kstep;
            const char* a3 = a2 + kstep; const char* b3 = b2 + kstep;
            if (last && has_next) S.a_ready(nxt);
            if constexpr (SP2) {
            PG8_LDB(B0, 0, 0); PG8_LDB(B1, 0, 1); PG8_SCHED; PG8_LDA(At, 0, 0); PG8_STAGE(PG8_SA(1, 1), a1 + hstep, voffA);
            PG8_WAIT_V(8); PG8_WAIT_L(0); PG8_BAR; PG8_MMA(0, 0, At, B0); PG8_MMA(0, 1, At, B1); PG8_BAR; PG8_SCHED;
            PG8_LDA(At, 0, 1); PG8_STAGE(PG8_SB(0, 0), b2, voffB); PG8_STAGE(PG8_SB(0, 1), b2 + hstep, voffB); PG8_STAGE(PG8_SA(0, 0), a2, voffA);
            PG8_WAIT_V(8); PG8_WAIT_L(0); PG8_BAR; PG8_MMA(1, 0, At, B0); PG8_MMA(1, 1, At, B1); PG8_BAR; PG8_SCHED;
            PG8_LDB(B0, 1, 0); PG8_LDB(B1, 1, 1); PG8_SCHED; PG8_LDA(At, 1, 0); PG8_STAGE(PG8_SA(0, 1), a2 + hstep, voffA);
            PG8_WAIT_V(8); PG8_WAIT_L(0); PG8_BAR; PG8_MMA(0, 0, At, B0); PG8_MMA(0, 1, At, B1); PG8_BAR; PG8_SCHED;
            PG8_LDA(At, 1, 1); PG8_STAGE(PG8_SB(1, 0), b3, voffB); PG8_STAGE(PG8_SB(1, 1), b3 + hstep, voffB); PG8_STAGE(PG8_SA(1, 0), a3, voffA);
            PG8_WAIT_V(8); PG8_WAIT_L(0); PG8_BAR; PG8_MMA(1, 0, At, B0); PG8_MMA(1, 1, At, B1); PG8_BAR; PG8_SCHED;
            } else {
            PG8_LDB(B0, 0, 0); PG8_SCHED; PG8_LDA(At, 0, 0); PG8_STAGE(PG8_SA(1, 1), a1 + hstep, voffA);
            PG8_WAIT_L(8); PG8_BAR; PG8_WAIT_L(0); PG8_MMA(0, 0, At, B0); PG8_BAR; PG8_SCHED;
            PG8_LDB(B1, 0, 1); PG8_STAGE(PG8_SB(0, 0), b2, voffB);
            PG8_BAR; PG8_WAIT_L(0); PG8_MMA(0, 1, At, B1); PG8_BAR;
            PG8_LDA(At, 0, 1); PG8_STAGE(PG8_SA(0, 0), a2, voffA);
            PG8_BAR; PG8_WAIT_L(0); PG8_MMA(1, 0, At, B0); PG8_BAR; PG8_SCHED;
            PG8_STAGE(PG8_SB(0, 1), b2 + hstep, voffB);
            PG8_WAIT_V(6); PG8_BAR; PG8_MMA(1, 1, At, B1); PG8_BAR;
            PG8_LDB(B0, 1, 0); PG8_SCHED; PG8_LDA(At, 1, 0); PG8_STAGE(PG8_SA(0, 1), a2 + hstep, voffA);
            PG8_WAIT_L(8); PG8_BAR; PG8_WAIT_L(0); PG8_MMA(0, 0, At, B0); PG8_BAR; PG8_SCHED;
            PG8_LDB(B1, 1, 1); PG8_STAGE(PG8_SB(1, 0), b3, voffB);
            PG8_BAR; PG8_WAIT_L(0); PG8_MMA(0, 1, At, B1); PG8_BAR;
            PG8_LDA(At, 1, 1); PG8_STAGE(PG8_SA(1, 0), a3, voffA);
            PG8_BAR; PG8_WAIT_L(0); PG8_MMA(1, 0, At, B0); PG8_BAR; PG8_SCHED;
            PG8_STAGE(PG8_SB(1, 1), b3 + hstep, voffB);
            PG8_WAIT_V(6); PG8_BAR; PG8_MMA(1, 1, At, B1); PG8_BAR;
            }
        }
        if constexpr (F8) asm volatile("s_nop 15\n\ts_nop 15" ::: "memory");
        if constexpr (ALIGN_EPI) { if (wr == 0) PG8_BAR; }
        if constexpr (!Epi::AFTER_DRAIN) { E(acc, cur, wr, wc, fr, fq); S.done(cur); }
        if (!has_next) break;
#pragma unroll
        for (int a = 0; a < 2; ++a)
#pragma unroll
            for (int b = 0; b < 2; ++b)
#pragma unroll
                for (int m = 0; m < 4; ++m)
#pragma unroll
                    for (int n = 0; n < 2; ++n) acc[a][b][m][n] = (f32x4){0.f, 0.f, 0.f, 0.f};
        cur = nxt; cA = nA; cB = nB; ++ui;
        if constexpr (ALIGN_EPI) { if (wr == 1) PG8_BAR; }
    }
    PG8_WAIT_V(0);
    if constexpr (!ALIGN_EPI) { if (wr == 0) PG8_BAR; }
    PG8_BAR;
    if constexpr (Epi::AFTER_DRAIN) { E.fused(acc, cur, wr, wc, fr, fq, lds, wid, lane); S.done(cur); }
#undef PG8_SA
#undef PG8_SB
#undef PG8_STAGE
#undef PG8_LDA
#undef PG8_LDB
#undef PG8_MMA
#undef PG8_WAIT_V
#undef PG8_WAIT_L
#undef PG8_BAR
#undef PG8_SCHED
}
}

constexpr int NWAVES = 8;
constexpr int RING_BYTES = 131072, LDSCTL_OFF = 256 * 528 + 16384, MISC_OFF = LDSCTL_OFF + 320, LDS_BYTES = LDSCTL_OFF + 1024;
#define GAS __attribute__((address_space(1)))
#define LAS __attribute__((address_space(3)))
typedef GAS unsigned gu32;
constexpr int CW_TMO = 0, CW_CODE = 1, CW_BAR = 4096;
#define XB_TMO      128
#define XB_XCNT(j)  (256  + 64 * (j))
#define XB_XSUB(j)  (1280 + 64 * (j))
#define XB_XGEN(j)  (2304 + 64 * (j))
#define XB_TOP      3328
#define XB_TOPGEN   3392
#define XCD_BAR_WORDS 3456
#define XB_SPIN_CAP (1u << 18)

__device__ __forceinline__ unsigned xb_ld(unsigned* p)              { return __hip_atomic_load(p, __ATOMIC_RELAXED, __HIP_MEMORY_SCOPE_AGENT); }
__device__ __forceinline__ unsigned xb_add(unsigned* p, unsigned v) { return __hip_atomic_fetch_add(p, v, __ATOMIC_RELAXED, __HIP_MEMORY_SCOPE_AGENT); }
__device__ __forceinline__ unsigned xb_xcc_id() { return (unsigned)__builtin_amdgcn_s_getreg((3 << 11) | 20) & 0xFu; }
#define XB_SPIN(cond, bar) do { unsigned _sp = 0; while (cond) { __builtin_amdgcn_s_sleep(1); \
    if ((++_sp & 255u) == 0u) { if (xb_ld(&(bar)[XB_TMO])) break; if (_sp > XB_SPIN_CAP) { atomicAdd(&(bar)[XB_TMO], 1u); break; } } } } while (0)

struct XcdBarrier {
    unsigned* bar; unsigned x;
    volatile LAS unsigned* st;
};

__device__ __forceinline__ XcdBarrier xcd_barrier_post(unsigned* bar, volatile LAS unsigned* st) {
    XcdBarrier b; b.bar = bar; b.x = xb_xcc_id(); b.st = st;
    if (threadIdx.x == 0) (void)xb_add(&bar[XB_XCNT(b.x)], 1u);
    return b;
}
__device__ __forceinline__ void xcd_barrier_complete(unsigned* bar, unsigned x, unsigned& nloc, unsigned& nx) {
    const unsigned G = gridDim.x * gridDim.y * gridDim.z;
    unsigned sum, cnt, mine, sp = 0u;
    for (;;) {
        sum = 0u; cnt = 0u; mine = 0u;
#pragma unroll
        for (unsigned j = 0; j < 16; ++j) { const unsigned c = xb_ld(&bar[XB_XCNT(j)]); sum += c; cnt += (c > 0u) ? 1u : 0u; mine = (j == x) ? c : mine; }
        if (sum == G) break;
        __builtin_amdgcn_s_sleep(1);
        if ((++sp & 255u) == 0u) { if (xb_ld(&bar[XB_TMO])) break; if (sp > XB_SPIN_CAP) { atomicAdd(&bar[XB_TMO], 1u); break; } }
    }
    nloc = mine > 0u ? mine : 1u; nx = cnt > 0u ? cnt : 1u;
}

__device__ __forceinline__ void xcd_barrier(const XcdBarrier& b) {
    asm volatile("s_waitcnt vmcnt(0)" ::: "memory");
    __syncthreads();
    if (threadIdx.x == 0) {
        unsigned* bar = b.bar;
        __builtin_amdgcn_s_waitcnt(0);
        unsigned nloc = b.st[0], nx = b.st[1];
        if (nloc == 0u) { xcd_barrier_complete(bar, b.x, nloc, nx); b.st[0] = nloc; b.st[1] = nx; }
        const unsigned old = xb_add(&bar[XB_XSUB(b.x)], 1u);
        const unsigned gen = old / nloc;
        if (old + 1u == (gen + 1u) * nloc) {
            __builtin_amdgcn_fence(__ATOMIC_RELEASE, "agent");
            asm volatile("s_waitcnt vmcnt(0)" ::: "memory");
            const unsigned og = xb_add(&bar[XB_TOP], 1u);
            const unsigned tg = og / nx;
            if (og + 1u == (tg + 1u) * nx) xb_add(&bar[XB_TOPGEN], 1u);
            else XB_SPIN(xb_ld(&bar[XB_TOPGEN]) == tg, bar);
            __builtin_amdgcn_fence(__ATOMIC_ACQUIRE, "agent");
            xb_add(&bar[XB_XGEN(b.x)], 1u);
            asm volatile("s_waitcnt vmcnt(0)" ::: "memory");
        } else {
            XB_SPIN(xb_ld(&bar[XB_XGEN(b.x)]) == gen, bar);
            __builtin_amdgcn_fence(__ATOMIC_ACQUIRE, "agent");
            asm volatile("s_waitcnt vmcnt(0)" ::: "memory");
        }
    }
    __syncthreads();
}

struct Args { const float* in[25]; float* out; unsigned char* ws; int ph_lo, ph_hi, li, flags; };
#ifndef PROBE_PHASE
#define PROBE_PHASE -1
#endif

__device__ __forceinline__ void p0_transpose_item(const float* W, int ldw, int K, bf16* WT, LAS float* scr, int k0, int n0, int lane) {
#pragma unroll 8
    for (int i = 0; i < 32; ++i) { const int kk = 2 * i + (lane >> 5); scr[kk * 33 + (lane & 31)] = W[(size_t)(k0 + kk) * ldw + n0 + (lane & 31)]; }
    asm volatile("s_waitcnt lgkmcnt(0)" ::: "memory");
    const int c = lane & 7;
#pragma unroll
    for (int j = 0; j < 4; ++j) { const int n = (lane >> 3) + 8 * j; const LAS float* s = scr + (8 * c) * 33 + n;
        uint4 o; o.x = f2bf(s[0 * 33]) | ((unsigned)f2bf(s[1 * 33]) << 16); o.y = f2bf(s[2 * 33]) | ((unsigned)f2bf(s[3 * 33]) << 16); o.z = f2bf(s[4 * 33]) | ((unsigned)f2bf(s[5 * 33]) << 16); o.w = f2bf(s[6 * 33]) | ((unsigned)f2bf(s[7 * 33]) << 16);
        *(uint4*)(WT + (size_t)(n0 + n) * K + k0 + 8 * c) = o; }
    asm volatile("s_waitcnt lgkmcnt(0)" ::: "memory");
}
__device__ __forceinline__ void p0_transpose_item64(const float* W, int ldw, int K, bf16* WT, LAS unsigned char* scr, int k0, int n0, int lane) {
    const int q = lane >> 4, n4 = (lane & 15) * 4;
    float4 v[16];
#pragma unroll
    for (int i = 0; i < 16; ++i) v[i] = *(const float4*)(W + (size_t)(k0 + 8 * (i >> 1) + 2 * q + (i & 1)) * ldw + n0 + n4);
#pragma unroll
    for (int p = 0; p < 8; ++p) { const int kb = (8 * p + 2 * q) * 2;
        *(LAS unsigned*)(scr + (n4 + 0) * 144 + kb) = f2bf(v[2 * p].x) | ((unsigned)f2bf(v[2 * p + 1].x) << 16); *(LAS unsigned*)(scr + (n4 + 1) * 144 + kb) = f2bf(v[2 * p].y) | ((unsigned)f2bf(v[2 * p + 1].y) << 16);
        *(LAS unsigned*)(scr + (n4 + 2) * 144 + kb) = f2bf(v[2 * p].z) | ((unsigned)f2bf(v[2 * p + 1].z) << 16); *(LAS unsigned*)(scr + (n4 + 3) * 144 + kb) = f2bf(v[2 * p].w) | ((unsigned)f2bf(v[2 * p + 1].w) << 16); }
    asm volatile("s_waitcnt lgkmcnt(0)" ::: "memory");
    const int c = lane & 7;
#pragma unroll
    for (int jj = 0; jj < 8; ++jj) { const int n = (lane >> 3) + 8 * jj; const pg8::u32x4 o = *(const LAS pg8::u32x4*)(scr + n * 144 + c * 16); *(pg8::u32x4*)(WT + (size_t)(n0 + n) * K + k0 + 8 * c) = o; }
    asm volatile("s_waitcnt lgkmcnt(0)" ::: "memory");
}
__device__ __forceinline__ void p0_transpose_item64_f8(const float* W, int ldw, int K, unsigned char* WT8, LAS unsigned char* scr, int k0, int n0, int lane, float sc) {
    const int q = lane >> 4, n4 = (lane & 15) * 4;
    float4 v[16];
#pragma unroll
    for (int i = 0; i < 16; ++i) v[i] = *(const float4*)(W + (size_t)(k0 + 16 * (i >> 2) + 4 * q + (i & 3)) * ldw + n0 + n4);
#pragma unroll
    for (int p = 0; p < 4; ++p) { const int kb = 16 * p + 4 * q;
#define P0_PK4(comp) ({ int w_ = 0; w_ = __builtin_amdgcn_cvt_pk_fp8_f32(v[4 * p].comp * sc, v[4 * p + 1].comp * sc, w_, false); w_ = __builtin_amdgcn_cvt_pk_fp8_f32(v[4 * p + 2].comp * sc, v[4 * p + 3].comp * sc, w_, true); w_; })
        *(LAS int*)(scr + (n4 + 0) * 80 + kb) = P0_PK4(x); *(LAS int*)(scr + (n4 + 1) * 80 + kb) = P0_PK4(y); *(LAS int*)(scr + (n4 + 2) * 80 + kb) = P0_PK4(z); *(LAS int*)(scr + (n4 + 3) * 80 + kb) = P0_PK4(w);
#undef P0_PK4
    }
    asm volatile("s_waitcnt lgkmcnt(0)" ::: "memory");
    const int c = lane & 3;
#pragma unroll
    for (int jj = 0; jj < 4; ++jj) { const int n = (lane >> 2) + 16 * jj; const pg8::u32x4 o = *(const LAS pg8::u32x4*)(scr + n * 80 + c * 16); *(pg8::u32x4*)(WT8 + (size_t)(n0 + n) * K + k0 + 16 * c) = o; }
    asm volatile("s_waitcnt lgkmcnt(0)" ::: "memory");
}
__device__ __forceinline__ void ln_row_dev(const float* __restrict__ xrow, const float* __restrict__ g, const float* __restrict__ b, bf16* __restrict__ orow, int lane, unsigned char* __restrict__ o8 = nullptr) {
    const float4* xr = (const float4*)xrow + lane;
    float4 v[8]; float s = 0.f;
#pragma unroll
    for (int j = 0; j < 8; ++j) { v[j] = xr[64 * j]; s += (v[j].x + v[j].y) + (v[j].z + v[j].w); }
    const float mean = wave_sum(s) * (1.f / D); float q = 0.f;
#pragma unroll
    for (int j = 0; j < 8; ++j) { v[j].x -= mean; v[j].y -= mean; v[j].z -= mean; v[j].w -= mean; q += (v[j].x * v[j].x + v[j].y * v[j].y) + (v[j].z * v[j].z + v[j].w * v[j].w); }
    const float rstd = rsqrtf(wave_sum(q) * (1.f / D) + LN_EPS);
#pragma unroll
    for (int j = 0; j < 8; ++j) {
        const int c = 4 * lane + 256 * j; const float4 gg = *(const float4*)(g + c), bb = *(const float4*)(b + c);
        ushort4 o; o.x = f2bf(v[j].x * rstd * gg.x + bb.x); o.y = f2bf(v[j].y * rstd * gg.y + bb.y); o.z = f2bf(v[j].z * rstd * gg.z + bb.z); o.w = f2bf(v[j].w * rstd * gg.w + bb.w);
        *(ushort4*)(orow + c) = o;
        if (o8) { int w = 0; w = __builtin_amdgcn_cvt_pk_fp8_f32(v[j].x * rstd * gg.x + bb.x, v[j].y * rstd * gg.y + bb.y, w, false); w = __builtin_amdgcn_cvt_pk_fp8_f32(v[j].z * rstd * gg.z + bb.z, v[j].w * rstd * gg.w + bb.w, w, true); *(int*)(o8 + c) = w; } }
}

__global__ void __launch_bounds__(NWAVES * 64, 2) mk_fwd(Args args) {
    extern __shared__ __attribute__((aligned(16))) unsigned char lds_raw[];
    LAS unsigned char* lds = (LAS unsigned char*)lds_raw;
    volatile LAS unsigned* MISC = (volatile LAS unsigned*)(lds + MISC_OFF);
    const int tid = threadIdx.x, lane = tid & 63, wave = __builtin_amdgcn_readfirstlane(tid >> 6);
    const int G = gridDim.x, bx = blockIdx.x, vcu = (G % 8 == 0) ? (bx % 8) * (G / 8) + bx / 8 : bx;
    unsigned char* ws = args.ws; gu32* ctl = (gu32*)(ws + WS_CTL);
    for (int u = tid; u < (LDS_BYTES - LDSCTL_OFF) / 4; u += NWAVES * 64) ((LAS unsigned*)(lds + LDSCTL_OFF))[u] = 0u;
    __syncthreads();
    XcdBarrier bar = xcd_barrier_post((unsigned*)(ctl + CW_BAR) + args.li * XCD_BAR_WORDS, MISC + 8);
    const int lo = args.ph_lo, hi = args.ph_hi;
#define IN(k) (lo <= (k) && (k) < hi)
#define BOTH(k) (IN(k) && IN((k) + 1))
#define WSP(T_, off) ((T_*)(ws + (off)))
    bf16 *H0 = WSP(bf16, WS_H0), *W1T = WSP(bf16, WS_W1T), *WVT = WSP(bf16, WS_WVT), *WAT = WSP(bf16, WS_WAT), *WBT = WSP(bf16, WS_WBT), *WOT = WSP(bf16, WS_WOT), *W2T = WSP(bf16, WS_W2T),
         *WPT = WSP(bf16, WS_WPT), *PB = WSP(bf16, WS_PB), *KEYS = WSP(bf16, WS_KEYS), *NAQK = WSP(bf16, WS_NAQK), *GQK = WSP(bf16, WS_GQK),
         *GOUT = WSP(bf16, WS_GOUT), *GATES = WSP(bf16, WS_GATES), *LR = WSP(bf16, WS_LR), *VT = WSP(bf16, WS_VT);
    float *B1 = WSP(float, WS_B1), *BV = WSP(float, WS_BV);
    const int gw = vcu * NWAVES + wave, NGW = G * NWAVES;

    if (IN(0)) { for (int rep_ = 0; rep_ < (PROBE_PHASE == 0 ? 2 : 1); ++rep_) {
        const float* w_in = args.in[4];
        LAS float* scr = (LAS float*)(lds + wave * 16384);
        for (int m = gw; m < T; m += NGW) ln_row_dev(args.in[0] + (size_t)m * D, args.in[2], args.in[3], H0 + (size_t)m * D, lane, WSP(unsigned char, WS_H0F8) + (size_t)m * D);
        struct Seg { const float* W; bf16* WT; int ldw, col0, ncols, K, row0, pad; };
        LAS unsigned long long* segp = (LAS unsigned long long*)(lds + 8 * 16384); LAS int* segi = (LAS int*)(lds + 8 * 16384 + 512);
        if (tid < 16) { Seg sg{};
            switch (tid) {
                case 0: sg = Seg{w_in, W1T, IN_W, C_NAQ, 1024, D, 0, 0}; break; case 1: sg = Seg{w_in, W1T, IN_W, C_NAK, 1024, D, 1024, 0}; break;
                case 2: sg = Seg{w_in, W1T, IN_W, C_GQ, 1024, D, 2048, 0}; break; case 3: sg = Seg{w_in, W1T, IN_W, C_GK, 1024, D, 3072, 0}; break;
                case 4: sg = Seg{w_in, W1T, IN_W, C_GOUT, 2048, D, 4096, 0}; break; case 5: sg = Seg{w_in, W1T, IN_W, C_GA, 2048, D, 6144, 0}; break;
                case 6: sg = Seg{w_in, W1T, IN_W, C_GB, 2048, D, 8192, 0}; break; case 7: sg = Seg{w_in, W1T, IN_W, C_LRF, 32, D, 10240, 0}; break;
                case 8: sg = Seg{w_in, WVT, IN_W, C_NAV, 1024, D, 0, 0}; break; case 9: sg = Seg{w_in, WVT, IN_W, C_GV, 2048, D, 1024, 0}; break;
                case 10: sg = Seg{args.in[12], WAT, D, 0, D, NA_W, 0, 0}; break; case 11: sg = Seg{args.in[13], WBT, D, 0, D, GV, 0, 0}; break;
                case 12: sg = Seg{args.in[14], WOT, D, 0, D, D, 0, 0}; break; case 13: sg = Seg{args.in[22], W2T, D, 0, D, D, 0, 0}; break;
                case 14: sg = Seg{args.in[17], W2T, D, 0, D, D, 2048, 0}; break; default: sg = Seg{args.in[21], WPT, D, 0, D, PLE, 0, 0}; break; }
            segp[2 * tid] = (unsigned long long)sg.W; segp[2 * tid + 1] = (unsigned long long)sg.WT; segi[8 * tid] = sg.ldw; segi[8 * tid + 1] = sg.col0; segi[8 * tid + 2] = sg.ncols; segi[8 * tid + 3] = sg.K; segi[8 * tid + 4] = sg.row0; }
        __syncthreads();
        int base = 0;
        for (int sgi = 0; sgi < 16; ++sgi) { Seg sg; sg.W = (const float*)segp[2 * sgi]; sg.WT = (bf16*)segp[2 * sgi + 1]; sg.ldw = segi[8 * sgi]; sg.col0 = segi[8 * sgi + 1]; sg.ncols = segi[8 * sgi + 2]; sg.K = segi[8 * sgi + 3]; sg.row0 = segi[8 * sgi + 4]; const bool wide = (sg.ncols % 64) == 0; const int nblk = sg.ncols / (wide ? 64 : 32), nit = nblk * (sg.K / 64);
            int first = gw - (base % NGW); if (first < 0) first += NGW;
            for (int it = first; it < nit; it += NGW) { if (wide && sgi <= 13) p0_transpose_item64_f8(sg.W + sg.col0, sg.ldw, sg.K, (sgi < 8 ? WSP(unsigned char, WS_W1F8) : sgi < 10 ? WSP(unsigned char, WS_WVF8) : sgi == 10 ? WSP(unsigned char, WS_WAT) : sgi == 11 ? WSP(unsigned char, WS_WBT) : sgi == 12 ? WSP(unsigned char, WS_WOT) : WSP(unsigned char, WS_W2F8)) + (size_t)sg.row0 * sg.K, (LAS unsigned char*)scr, 64 * (it / nblk), 64 * (it % nblk), lane, 64.f);
                else if (wide) p0_transpose_item64(sg.W + sg.col0, sg.ldw, sg.K, sg.WT + (size_t)sg.row0 * sg.K, (LAS unsigned char*)scr, 64 * (it / nblk), 64 * (it % nblk), lane);
                else if (sgi != 7) p0_transpose_item(sg.W + sg.col0, sg.ldw, sg.K, sg.WT + (size_t)sg.row0 * sg.K, scr, 64 * (it / nblk), 32 * (it % nblk), lane); }
            base += nit; }
        const int gt = vcu * NWAVES * 64 + tid, NGT = G * NWAVES * 64;
        for (int i = gt; i < (N1 - 10272) * D / 16; i += NGT) ((uint4*)(WSP(unsigned char, WS_W1F8) + (size_t)10272 * D))[i] = make_uint4(0u, 0u, 0u, 0u);
        for (int i = gt; i < 32 * D / 4; i += NGT) { const int n = i / (D / 4), k4 = (i % (D / 4)) * 4; const float* wp = w_in + (size_t)k4 * IN_W + C_LRF + n;
            int w = 0; w = __builtin_amdgcn_cvt_pk_fp8_f32(wp[0] * 64.f, wp[IN_W] * 64.f, w, false); w = __builtin_amdgcn_cvt_pk_fp8_f32(wp[2 * (size_t)IN_W] * 64.f, wp[3 * (size_t)IN_W] * 64.f, w, true);
            *(int*)(WSP(unsigned char, WS_W1F8) + (size_t)(10240 + n) * D + k4) = w; }
        for (int i = gt; i < T * PLE / 4; i += NGT) { const float4 v = ((const float4*)args.in[1])[i]; ushort4 o; o.x = f2bf(v.x); o.y = f2bf(v.y); o.z = f2bf(v.z); o.w = f2bf(v.w); ((ushort4*)PB)[i] = o; }
        for (int i = gt; i < PH * 2 * PNK * 128 / 4; i += NGT) { const float4 v = ((const float4*)args.in[18])[i]; ushort4 o; o.x = f2bf(v.x); o.y = f2bf(v.y); o.z = f2bf(v.z); o.w = f2bf(v.w); ((ushort4*)KEYS)[i] = o; }
        for (int i = gt; i < N1; i += NGT) { const int c = orig_col_main(i); B1[i] = c >= 0 ? args.in[5][c] : 0.f; }
        for (int i = gt; i < 3072; i += NGT) BV[i] = args.in[5][i < 1024 ? C_NAV + i : C_GV + (i - 1024)];
        if (PROBE_PHASE == 0) __syncthreads(); }
        if (BOTH(0)) xcd_barrier(bar);
    }
    if (IN(1)) { for (int rep_ = 0; rep_ < (PROBE_PHASE == 1 ? 2 : 1); ++rep_) {
        pg8::Gemm g{(const bf16*)WSP(unsigned char, WS_H0F8), (const bf16*)WSP(unsigned char, WS_W1F8), (const bf16*)WSP(unsigned char, WS_WVF8), (const bf16*)WSP(unsigned char, WS_H0F8), D / 2}; pg8::Order2 S; S.init(T, N1, 3072, T, G, bx);
        pg8::Epi<EK_MAIN> E; E.e = EpiArgs{}; E.e.bias = B1; E.e.bias2 = BV; E.e.o0 = NAQK; E.e.o1 = GQK; E.e.o2 = GOUT; E.e.o3 = GATES; E.e.o4 = LR; E.e.o5 = VT;
        pg8::gemm_phase<pg8::Epi<EK_MAIN>, pg8::Order2, true, true, true>(lds, g, S, E);
        { const int n1u = (T / 256) * (N1 / 256) + (3072 / 256) * (T / 256), rem = n1u % G;
          if (rem != 0 && bx >= rem) { int kple = PLE; asm volatile("" : "+s"(kple));
            pg8::Gemm g2{PB, WPT, PB, WPT, kple}; pg8::Order2 S2; S2.init(T, D, 0, 0, G - rem, bx - rem);
            pg8::Epi<EK_PLE> E2; E2.e = EpiArgs{}; E2.e.o0 = WSP(bf16, WS_PLELIN);
            pg8::gemm_phase<pg8::Epi<EK_PLE>, pg8::Order2, true, true>(lds, g2, S2, E2); } }
        if (PROBE_PHASE == 1) __syncthreads(); }
        if (BOTH(1)) xcd_barrier(bar);
    }
    bf16 *YNA = WSP(bf16, WS_YNA), *TMP = WSP(bf16, WS_TMP), *OG = WSP(bf16, WS_OG), *MERGED = WSP(bf16, WS_MERGED), *H1 = WSP(bf16, WS_H1), *PLELIN = WSP(bf16, WS_PLELIN), *PLEB = WSP(bf16, WS_PLEB), *QP = WSP(bf16, WS_QP);
    float* R1 = WSP(float, WS_R1);
    const bf16* OF = (args.flags & 1) ? WSP(bf16, WS_OF) : WSP(bf16, WS_NAQK); const bf16* OB = (args.flags & 1) ? WSP(bf16, WS_OB) : WSP(bf16, WS_GQK);
    float *AF = WSP(float, WS_AF), *AB = WSP(float, WS_AB), *GP = WSP(float, WS_GATEP); int* IDS = WSP(int, WS_IDS);
    const int gt_ = vcu * NWAVES * 64 + tid, NGT_ = G * NWAVES * 64;
    if (IN(2)) { for (int rep_ = 0; rep_ < (PROBE_PHASE == 2 ? 2 : 1); ++rep_) {
        for (int rr_ = 0; rr_ < (PROBE_PHASE == 20 ? 2 : 1); ++rr_)
        for (int it = bx; it < BATCH * NA_H * (ROWS / 8); it += G) na_item(lds, NAQK, VT, args.in[6], YNA, it >> 6, (it >> 2) & 15, it & 3, tid);
        __syncthreads();
        for (int rr_ = 0; rr_ < (PROBE_PHASE == 21 ? 2 : 1); ++rr_)
        gla_pre_block(lds, GQK, LR, args.in[7], args.in[8], args.in[9], args.in[10], WSP(bf16, WS_QD), WSP(bf16, WS_KST), WSP(bf16, WS_ATT), WSP(float, WS_DEC), bx, G, tid);
        __syncthreads();
        if (PROBE_PHASE == 2) __syncthreads(); }
        if (BOTH(2)) xcd_barrier(bar);
    }
    if (IN(3)) { for (int rep_ = 0; rep_ < (PROBE_PHASE == 3 ? 2 : 1); ++rep_) {
        for (int rr_ = 0; rr_ < (PROBE_PHASE == 30 ? 2 : 1); ++rr_)
        for (int it = bx; it < 256; it += G) { const int grp_ = (it & 7) * 4 + (it >> 6), sl = (it >> 3) & 7, dir = grp_ & 1, h = (grp_ >> 1) & 3, b = grp_ >> 3;
            gla_scan_item(lds, WSP(bf16, WS_QD) + (size_t)dir * T * 1024, WSP(bf16, WS_KST) + (size_t)dir * 512 * 256 * 64, WSP(bf16, WS_ATT) + (size_t)dir * 512 * 4096, WSP(float, WS_DEC) + (size_t)dir * 512 * 256,
                          VT, dir ? WSP(bf16, WS_GQK) : WSP(bf16, WS_NAQK), b, h, dir, sl, tid); }
        __syncthreads();
        pg8::Gemm g{YNA, WAT, YNA, WAT, NA_W / 2}; pg8::Order2 S; S.init(T, D, 0, 0, G, bx);
        pg8::Epi<EK_A> E; E.e = EpiArgs{}; E.e.o0 = TMP; E.e.a0 = GATES;
        pg8::gemm_phase<pg8::Epi<EK_A>, pg8::Order2, true, true, true>(lds, g, S, E);
        if (PROBE_PHASE == 3) __syncthreads(); }
        if (BOTH(3)) xcd_barrier(bar);
    }
    if (IN(4)) { for (int rep_ = 0; rep_ < (PROBE_PHASE == 4 ? 2 : 1); ++rep_) {
        const float* ng = args.in[11];
        const pg8::f32x4 n0 = *(const pg8::f32x4*)(ng + lane * 8), n1 = *(const pg8::f32x4*)(ng + lane * 8 + 4);
        for (int task = gw; task < T * GH; task += 2 * NGW) {
            const int task2 = task + NGW; const bool two = task2 < T * GH; const int tk2 = two ? task2 : task;
            const size_t base = (size_t)(task >> 2) * 2048 + (task & 3) * 512 + lane * 8, base2 = (size_t)(tk2 >> 2) * 2048 + (tk2 & 3) * 512 + lane * 8;
            pg8::f32x4 a0, a1, b0, b1, g0, g1, c0, c1, d0, d1, e0, e1;
            pg8::ld8bf(OF + base, a0, a1); pg8::ld8bf(OB + base, b0, b1); pg8::ld8bf(GOUT + base, g0, g1); pg8::ld8bf(OF + base2, c0, c1); pg8::ld8bf(OB + base2, d0, d1); pg8::ld8bf(GOUT + base2, e0, e1);
            a0 += b0; a1 += b1; c0 += d0; c1 += d1; const pg8::f32x4 q4 = a0 * a0 + a1 * a1, q5 = c0 * c0 + c1 * c1;
            const float r = rsqrtf(wave_sum((q4[0] + q4[1]) + (q4[2] + q4[3])) * (1.f / 512.f) + LN_EPS), r2 = rsqrtf(wave_sum((q5[0] + q5[1]) + (q5[2] + q5[3])) * (1.f / 512.f) + LN_EPS);
            pg8::st8f8((unsigned char*)OG + base, a0 * r * n0 * g0, a1 * r * n1 * g1);
            if (two) pg8::st8f8((unsigned char*)OG + base2, c0 * r2 * n0 * e0, c1 * r2 * n1 * e1); }
        if (PROBE_PHASE == 4) __syncthreads(); }
        if (BOTH(4)) xcd_barrier(bar);
    }
    if (IN(5)) { for (int rep_ = 0; rep_ < (PROBE_PHASE == 5 ? 2 : 1); ++rep_) {
        pg8::Gemm g{OG, WBT, OG, WBT, GV / 2}; pg8::Order2 S; S.init(T, D, 0, 0, G, bx);
        pg8::Epi<EK_B> E; E.e = EpiArgs{}; E.e.o0 = MERGED; E.e.a0 = GATES; E.e.a1 = TMP;
        pg8::gemm_phase<pg8::Epi<EK_B>, pg8::Order2, true, true, true>(lds, g, S, E);
        if (PROBE_PHASE == 5) __syncthreads(); }
        if (BOTH(5)) xcd_barrier(bar);
    }
    if (IN(6)) { for (int rep_ = 0; rep_ < (PROBE_PHASE == 6 ? 2 : 1); ++rep_) {
        pg8::Gemm g{MERGED, WOT, MERGED, WOT, D / 2}; pg8::Order2 S; S.init(T, D, 0, 0, G, bx);
        if (G == 256) { pg8::EpiLnOut E{H0, args.in[15], args.in[16], H1, WSP(unsigned char, WS_H1F8), WSP(unsigned long long, WS_LNX), (unsigned*)(ctl + 16384), (unsigned*)(ctl + CW_TMO)};
            pg8::gemm_phase<pg8::EpiLnOut, pg8::Order2, false, true, true>(lds, g, S, E); }
        else { pg8::Epi<EK_OUT> E; E.e = EpiArgs{}; E.e.of = R1; E.e.a0 = H0;
            pg8::gemm_phase<pg8::Epi<EK_OUT>, pg8::Order2, true, true, true>(lds, g, S, E); }
#if FP4_LOW == 3
        for (int r = gw; r < 2 * PNK * PNK; r += NGW) { if (r < PNK * PNK) f4_row(args.in[19], WSP(unsigned char, WS_U4), WSP(float, WS_RSU), r, lane); else f4_row(args.in[20], WSP(unsigned char, WS_V4), WSP(float, WS_RSV), r - PNK * PNK, lane); }
#else
        for (int r = gw; r < 2 * PNK * PNK; r += NGW) { if (r < PNK * PNK) f6_row<false>(args.in[19], WSP(unsigned char, WS_U8), WSP(unsigned char, WS_U4), WSP(float, WS_RSU), r, lane); else f6_row<true>(args.in[20], WSP(unsigned char, WS_V8), WSP(unsigned char, WS_V4), WSP(float, WS_RSV), r - PNK * PNK, lane); }
#endif
        if (PROBE_PHASE == 6) __syncthreads(); }
        if (BOTH(6)) xcd_barrier(bar);
    }
    const bool p7_needed = (G != 256) || ((((T / 256) * (N1 / 256) + (3072 / 256) * (T / 256)) % G) == 0);
    if (IN(7) && p7_needed) { for (int rep_ = 0; rep_ < (PROBE_PHASE == 7 ? 2 : 1); ++rep_) {
        if (G != 256) for (int m = gw; m < T; m += NGW) ln_row_dev(R1 + (size_t)m * D, args.in[15], args.in[16], H1 + (size_t)m * D, lane, WSP(unsigned char, WS_H1F8) + (size_t)m * D);
        if ((((T / 256) * (N1 / 256) + (3072 / 256) * (T / 256)) % G) == 0) {
        int kple = PLE; asm volatile("" : "+s"(kple));
        pg8::Gemm g{PB, WPT, PB, WPT, kple}; pg8::Order2 S; S.init(T, D, 0, 0, G, bx);
        pg8::Epi<EK_PLE> E; E.e = EpiArgs{}; E.e.o0 = PLELIN;
        pg8::gemm_phase<pg8::Epi<EK_PLE>, pg8::Order2, true, true>(lds, g, S, E); }
        if (PROBE_PHASE == 7) __syncthreads(); }
        if (BOTH(7)) xcd_barrier(bar);
    }
    if (IN(8)) { for (int rep_ = 0; rep_ < (PROBE_PHASE == 8 ? 2 : 1); ++rep_) {
        { pg8::Gemm g{(const bf16*)WSP(unsigned char, WS_H1F8), (const bf16*)WSP(unsigned char, WS_W2F8), (const bf16*)WSP(unsigned char, WS_H1F8), (const bf16*)WSP(unsigned char, WS_W2F8), D / 2}; pg8::Order2 S; S.init(T, D, 0, 0, G, bx);
          pg8::Epi<EK_2> E; E.e = EpiArgs{}; E.e.o0 = PLEB; E.e.o1 = QP; E.e.a0 = PLELIN;
          pg8::gemm_phase<pg8::Epi<EK_2>, pg8::Order2, true, true, true>(lds, g, S, E); }
        { pg8::Gemm g{H1, W2T + (size_t)2048 * D, H1, W2T + (size_t)2048 * D, D}; pg8::Order2 S; S.init(T, D, 0, 0, G, bx);
          pg8::Epi<EK_2> E; E.e = EpiArgs{}; E.e.o0 = PLEB; E.e.o1 = QP; E.e.a0 = PLELIN; E.e.qonly = 1;
          pg8::gemm_phase<pg8::Epi<EK_2>, pg8::Order2, true, true, false>(lds, g, S, E); }
        if (PROBE_PHASE == 8) __syncthreads(); }
        if (BOTH(8)) xcd_barrier(bar);
    }
    if (IN(9)) { for (int rep_ = 0; rep_ < (PROBE_PHASE == 9 ? 2 : 1); ++rep_) {
        for (int tile = bx; tile < T / 16; tile += G)
            peer_tile(lds, QP, KEYS, H1, WSP(unsigned char, WS_U8), WSP(unsigned char, WS_V8), WSP(unsigned char, WS_U4), WSP(unsigned char, WS_V4), WSP(float, WS_RSU), WSP(float, WS_RSV), PLEB, args.in[23], args.in[24], args.out, tile, tid);
    } }
#undef IN
#undef BOTH
#undef WSP
}

extern "C" void kernel_launch(void* const* d_in, const int* in_sizes, int n_in, void* d_out, int out_size, void* d_ws, size_t ws_size, hipStream_t stream) {
    (void)in_sizes; (void)n_in; (void)out_size; (void)ws_size;
    const float* x = (const float*)d_in[0]; const float* p = (const float*)d_in[1]; const float* ln_e_g = (const float*)d_in[2]; const float* ln_e_b = (const float*)d_in[3];
    const float* w_in = (const float*)d_in[4]; const float* b_in = (const float*)d_in[5]; const float* rpb = (const float*)d_in[6];
    const float* up_f = (const float*)d_in[7]; const float* gb_f = (const float*)d_in[8]; const float* up_b = (const float*)d_in[9]; const float* gb_b = (const float*)d_in[10];
    const float* norm_g = (const float*)d_in[11]; const float* w_pa = (const float*)d_in[12]; const float* w_pb = (const float*)d_in[13]; const float* w_out = (const float*)d_in[14];
    const float* ln_a_g = (const float*)d_in[15]; const float* ln_a_b = (const float*)d_in[16]; const float* peer_wq = (const float*)d_in[17]; const float* sub_keys = (const float*)d_in[18];
    const float* peer_u = (const float*)d_in[19]; const float* peer_v = (const float*)d_in[20]; const float* w_ple = (const float*)d_in[21]; const float* w_pg = (const float*)d_in[22];
    const float* ln_b_g = (const float*)d_in[23]; const float* ln_b_b = (const float*)d_in[24];
    unsigned char* ws = (unsigned char*)d_ws; float* out = (float*)d_out;
#define WSP(T_, off) ((T_*)(ws + (off)))
    static int grid = 0;
    if (grid == 0) {
        int dev = 0, cus = 0; (void)hipGetDevice(&dev); (void)hipDeviceGetAttribute(&cus, hipDeviceAttributeMultiprocessorCount, dev);
        if (hipFuncSetAttribute((const void*)mk_fwd, hipFuncAttributeMaxDynamicSharedMemorySize, LDS_BYTES) != hipSuccess) { fprintf(stderr, "hipFuncSetAttribute failed\n"); grid = -1; return; }
        int per_cu = 0; (void)hipOccupancyMaxActiveBlocksPerMultiprocessor(&per_cu, (const void*)mk_fwd, NWAVES * 64, LDS_BYTES); (void)hipGetLastError();
        if (per_cu < 1) fprintf(stderr, "occupancy query reports %d blocks per CU\n", per_cu);
        grid = cus;
    }
    if (grid < 0) return;
    (void)hipMemsetAsync(ws + WS_CTL, 0, 1 * MiB, stream);
    { Args a{}; for (int i = 0; i < 25; ++i) a.in[i] = (const float*)d_in[i]; a.out = out; a.ws = ws; a.ph_lo = 0; a.ph_hi = 10; a.li = 0; a.flags = 0;
      hipLaunchKernelGGL(mk_fwd, dim3(grid), dim3(NWAVES * 64), LDS_BYTES, stream, a); }
}
```

```cpp
#include <hip/hip_runtime.h>
#include <cstdio>
#include <cstdint>

typedef unsigned short bf16;
#define DEV __device__ __forceinline__

constexpr int D = 2048, BATCH = 4, SEQ = 2048, T = BATCH * SEQ;
constexpr int GRID_W = 64, ROWS = SEQ / GRID_W;
constexpr int NA_H = 16, NA_DH = 64, NA_W = 1024, WIN_R = 8, WIN_C = 16;
constexpr int GH = 4, GDK = 256, GDV = 512, GK = 1024, GV = 2048, GRANK = 16;
constexpr int PH = 8, PNK = 128, PTOPK = 16, PLE = 256;
constexpr int IN_W = 13344;
constexpr float LN_EPS = 1e-5f;
constexpr float ALPHA = 1.189207115002721f;

constexpr int C_NAQ = 0, C_NAK = 1024, C_NAV = 2048, C_GQ = 3072, C_GK = 4096, C_GV = 5120, C_GOUT = 7168, C_LRF = 9216, C_LRB = 9232, C_GA = 9248, C_GB = 11296;
constexpr int N1 = 10496;

constexpr size_t MiB = 1u << 20;
constexpr size_t WS_CTL = 0, WS_H0 = 1 * MiB, WS_W1T = 33 * MiB, WS_WVT = 74 * MiB, WS_WAT = 86 * MiB, WS_WBT = 90 * MiB, WS_WOT = 98 * MiB, WS_W2T = 106 * MiB,
                 WS_WPT = 122 * MiB, WS_PB = 123 * MiB, WS_KEYS = 127 * MiB, WS_B1 = 127 * MiB + 512 * 1024, WS_BV = 127 * MiB + 640 * 1024,
                 WS_RSU = 127 * MiB + 768 * 1024, WS_RSV = 127 * MiB + 896 * 1024,
                 WS_U8 = 192 * MiB, WS_V8 = 160 * MiB,
                 WS_U4 = 160 * MiB, WS_V4 = 176 * MiB,
                 WS_AF = 128 * MiB, WS_AB = 160 * MiB,
                 WS_OF = 192 * MiB, WS_OB = 224 * MiB,
                 WS_NAQK = 256 * MiB, WS_GQK = 288 * MiB, WS_GOUT = 320 * MiB, WS_GATES = 352 * MiB, WS_LR = 416 * MiB,
                 WS_VT = 420 * MiB, WS_YNA = 468 * MiB, WS_IDS = 484 * MiB, WS_GATEP = 488 * MiB,
                 WS_W1F8 = 33 * MiB, WS_H0F8 = 54 * MiB, WS_WVF8 = 74 * MiB, WS_W2F8 = 106 * MiB, WS_H1F8 = 54 * MiB,
                 WS_LNX = 502 * MiB,
                 WS_QD = 192 * MiB, WS_KST = 224 * MiB,
                 WS_ATT = 493 * MiB, WS_DEC = 501 * MiB,
                 WS_TMP = 33 * MiB,
                 WS_OG = 192 * MiB,
                 WS_MERGED = 224 * MiB,
                 WS_R1 = 256 * MiB,
                 WS_H1 = 320 * MiB,
                 WS_PLELIN = 128 * MiB, WS_PLEB = 384 * MiB,
                 WS_QP = 420 * MiB;

DEV float bf2f(bf16 v) { return __uint_as_float((unsigned)v << 16); }
DEV bf16 f2bf(float f) { unsigned u = __float_as_uint(f); return (bf16)((u + 0x7fffu + ((u >> 16) & 1u)) >> 16); }
DEV float sigmoidf_(float x) { return __builtin_amdgcn_rcpf(1.f + __builtin_amdgcn_exp2f(x * -1.44269504f)); }
#define WR_DPP(x, ctl) __builtin_bit_cast(float, __builtin_amdgcn_mov_dpp(__builtin_bit_cast(int, x), ctl, 0xf, 0xf, true))
DEV float wave_sum(float v) {
    v += WR_DPP(v, 0xB1); v += WR_DPP(v, 0x4E); v += WR_DPP(v, 0x141); v += WR_DPP(v, 0x140);
    { const auto p = __builtin_amdgcn_permlane16_swap(__float_as_uint(v), __float_as_uint(v), false, false); v = __uint_as_float(p[0]) + __uint_as_float(p[1]); }
    { const auto p = __builtin_amdgcn_permlane32_swap(__float_as_uint(v), __float_as_uint(v), false, false); v = __uint_as_float(p[0]) + __uint_as_float(p[1]); }
    return v;
}
DEV float wave_max(float v) {
    v = fmaxf(v, WR_DPP(v, 0xB1)); v = fmaxf(v, WR_DPP(v, 0x4E)); v = fmaxf(v, WR_DPP(v, 0x141)); v = fmaxf(v, WR_DPP(v, 0x140));
    { const auto p = __builtin_amdgcn_permlane16_swap(__float_as_uint(v), __float_as_uint(v), false, false); v = fmaxf(__uint_as_float(p[0]), __uint_as_float(p[1])); }
    { const auto p = __builtin_amdgcn_permlane32_swap(__float_as_uint(v), __float_as_uint(v), false, false); v = fmaxf(__uint_as_float(p[0]), __uint_as_float(p[1])); }
    return v;
}

DEV int orig_col_main(int n) {
    if (n < 1024) return C_NAQ + n; if (n < 2048) return C_NAK + (n - 1024); if (n < 3072) return C_GQ + (n - 2048); if (n < 4096) return C_GK + (n - 3072);
    if (n < 6144) return C_GOUT + (n - 4096); if (n < 8192) return C_GA + (n - 6144); if (n < 10240) return C_GB + (n - 8192); if (n < 10272) return C_LRF + (n - 10240); return -1; }
struct EpiArgs { const float* bias; const float* bias2; bf16* o0; bf16* o1; bf16* o2; bf16* o3; bf16* o4; bf16* o5; float* of; const bf16* a0; const bf16* a1; int qonly; int pad; };
enum { EK_MAIN = 0, EK_VT = 1, EK_A = 2, EK_B = 3, EK_OUT = 4, EK_PLE = 5, EK_2 = 6 };
DEV void na_naive_task(const bf16* __restrict__ NAQK, const bf16* __restrict__ VT, const float* __restrict__ rpb, bf16* __restrict__ YNA, int task, int lane) {
    const int tok = task >> 4, h = task & 15, b = tok >> 11, s = tok & 2047, r = s >> 6, c = s & 63;
    const int r0 = min(max(r - WIN_R / 2, 0), ROWS - WIN_R), c0 = min(max(c - WIN_C / 2, 0), GRID_W - WIN_C);
    const bf16* q = NAQK + (size_t)tok * 2048 + h * 64;
    float sc[2];
#pragma unroll
    for (int u = 0; u < 2; ++u) {
        const int kidx = lane + 64 * u, i = kidx >> 4, j = kidx & 15, kt = b * 2048 + (r0 + i) * 64 + c0 + j;
        const bf16* kp = NAQK + (size_t)kt * 2048 + 1024 + h * 64; float a = 0.f;
        for (int d = 0; d < 64; ++d) a += bf2f(q[d]) * bf2f(kp[d]);
        sc[u] = a + rpb[(h * 15 + (r0 + i - r + WIN_R - 1)) * 31 + (c0 + j - c + WIN_C - 1)];
    }
    const float mx = wave_max(fmaxf(sc[0], sc[1]));
    const float p0 = __expf(sc[0] - mx), p1 = __expf(sc[1] - mx), inv = 1.f / wave_sum(p0 + p1);
    float o = 0.f;
    const bf16* vrow = VT + (size_t)(h * 64 + lane) * T;
    for (int kidx = 0; kidx < 128; ++kidx) {
        const float p = __shfl(kidx < 64 ? p0 : p1, kidx & 63);
        const int i = kidx >> 4, j = kidx & 15, kt = b * 2048 + (r0 + i) * 64 + c0 + j;
        o += p * bf2f(vrow[kt]);
    }
    YNA[(size_t)tok * 1024 + h * 64 + lane] = f2bf(o * inv);
}

DEV void gla_decay_elem(const bf16* __restrict__ LR, const float* __restrict__ upf, const float* __restrict__ bf_, const float* __restrict__ upb, const float* __restrict__ bb_, float* __restrict__ AF, float* __restrict__ AB, size_t i) {
    const int tok = (int)(i >> 10), ch = (int)(i & 1023);
    float gf = bf_[ch], gb = bb_[ch];
#pragma unroll
    for (int r = 0; r < 16; ++r) { gf += bf2f(LR[(size_t)tok * 256 + r]) * upf[r * 1024 + ch]; gb += bf2f(LR[(size_t)tok * 256 + 16 + r]) * upb[r * 1024 + ch]; }
    const float lf = fminf(gf, 0.f) - log1pf(__expf(-fabsf(gf))), lb = fminf(gb, 0.f) - log1pf(__expf(-fabsf(gb)));
    AF[i] = __expf(lf * (1.f / 16.f)); AB[i] = __expf(lb * (1.f / 16.f));
}
DEV void gla_naive_thread(const bf16* __restrict__ GQK, const bf16* __restrict__ VT, const float* __restrict__ AF, const float* __restrict__ AB, bf16* __restrict__ OF, bf16* __restrict__ OB, int gid) {
    const int kq = gid & 3, dv = (gid >> 2) & 511, bhd = gid >> 11, dir = bhd & 1, h = (bhd >> 1) & 3, b = bhd >> 3;
    const float* Adec = dir ? AB : AF; bf16* O = dir ? OB : OF;
    const bf16* vrow = VT + (size_t)(1024 + h * 512 + dv) * T + (size_t)b * 2048;
    float s[64];
#pragma unroll
    for (int k = 0; k < 64; ++k) s[k] = 0.f;
    for (int tt = 0; tt < SEQ; ++tt) {
        const int t = dir ? SEQ - 1 - tt : tt; const size_t tok = (size_t)b * 2048 + t;
        const bf16* qp = GQK + tok * 2048 + h * 256 + kq * 64; const bf16* kp = qp + 1024; const float* ap = Adec + tok * 1024 + h * 256 + kq * 64;
        const float v = bf2f(vrow[t]); float o = 0.f;
        if (dir == 0) {
#pragma unroll
            for (int k = 0; k < 64; ++k) { s[k] = ap[k] * s[k] + bf2f(kp[k]) * v; o += bf2f(qp[k]) * s[k]; }
        } else {
#pragma unroll
            for (int k = 0; k < 64; ++k) { const float sd = ap[k] * s[k]; o += bf2f(qp[k]) * sd; s[k] = sd + bf2f(kp[k]) * v; }
        }
        o += __shfl_xor(o, 1); o += __shfl_xor(o, 2);
        if (kq == 0) O[tok * 2048 + h * 512 + dv] = f2bf(o);
    }
}
DEV void peer_topk_task(const bf16* __restrict__ QP, const bf16* __restrict__ KEYS, int* __restrict__ IDS, float* __restrict__ GP, int task, int n, __attribute__((address_space(3))) float* sm) {
    __attribute__((address_space(3))) float (*sc)[128] = (__attribute__((address_space(3))) float (*)[128])sm;
    __attribute__((address_space(3))) float (*tv)[16] = (__attribute__((address_space(3))) float (*)[16])(sm + 256);
    __attribute__((address_space(3))) int (*ti)[16] = (__attribute__((address_space(3))) int (*)[16])(sm + 288);
    __attribute__((address_space(3))) float* cv = sm + 320; __attribute__((address_space(3))) float* fv = sm + 576; __attribute__((address_space(3))) int* fi = (__attribute__((address_space(3))) int*)(sm + 592);
    const int tok = task >> 3, h = task & 7;
#pragma unroll
    for (int half = 0; half < 2; ++half) {
        const bf16* q = QP + (size_t)tok * 2048 + h * 256 + half * 128; const bf16* kp = KEYS + ((size_t)(h * 2 + half) * 128 + n) * 128; float a = 0.f;
        for (int k = 0; k < 128; ++k) a += bf2f(q[k]) * bf2f(kp[k]);
        sc[half][n] = a;
    }
    __syncthreads();
#pragma unroll
    for (int half = 0; half < 2; ++half) { const float v = sc[half][n]; int rank = 0;
        for (int m = 0; m < 128; ++m) { const float w = sc[half][m]; rank += (w > v || (w == v && m < n)) ? 1 : 0; }
        if (rank < 16) { tv[half][rank] = v; ti[half][rank] = n; } }
    __syncthreads();
    for (int c = n; c < 256; c += 128) cv[c] = tv[0][c >> 4] + tv[1][c & 15];
    __syncthreads();
    for (int c = n; c < 256; c += 128) { const float v = cv[c]; int rank = 0;
        for (int m = 0; m < 256; ++m) { const float w = cv[m]; rank += (w > v || (w == v && m < c)) ? 1 : 0; }
        if (rank < 16) { fv[rank] = v; fi[rank] = ti[0][c >> 4] * 128 + ti[1][c & 15]; } }
    __syncthreads();
    if (n < 16) { float mx = fv[0], sum = 0.f;
        for (int m = 0; m < 16; ++m) sum += __expf(fv[m] - mx);
        IDS[(size_t)tok * 128 + h * 16 + n] = fi[n]; GP[(size_t)tok * 128 + h * 16 + n] = __expf(fv[n] - mx) / sum; }
}
DEV void peer_gather_naive_tok(const bf16* __restrict__ H1, const int* __restrict__ IDS, const float* __restrict__ GP, const float* __restrict__ U, const float* __restrict__ V,
                              const bf16* __restrict__ PLEB, const float* __restrict__ lg, const float* __restrict__ lb, float* __restrict__ out, int tok, int lane) {
    float x[32], y[32];
#pragma unroll
    for (int j = 0; j < 8; ++j)
#pragma unroll
        for (int i = 0; i < 4; ++i) { x[j * 4 + i] = bf2f(H1[(size_t)tok * 2048 + 256 * j + 4 * lane + i]); y[j * 4 + i] = 0.f; }
    for (int e = 0; e < 128; ++e) {
        const int id = IDS[(size_t)tok * 128 + e]; const float g = GP[(size_t)tok * 128 + e];
        const float4* ur = (const float4*)(U + (size_t)id * 2048) + lane; const float4* vr = (const float4*)(V + (size_t)id * 2048) + lane;
        float a = 0.f;
#pragma unroll
        for (int j = 0; j < 8; ++j) { const float4 u4 = ur[64 * j]; a += u4.x * x[j * 4] + u4.y * x[j * 4 + 1] + u4.z * x[j * 4 + 2] + u4.w * x[j * 4 + 3]; }
        a = wave_sum(a);
        const float w = g * (0.5f * a * (1.f + erff(a * 0.70710678f)));
#pragma unroll
        for (int j = 0; j < 8; ++j) { const float4 v4 = vr[64 * j]; y[j * 4] += w * v4.x; y[j * 4 + 1] += w * v4.y; y[j * 4 + 2] += w * v4.z; y[j * 4 + 3] += w * v4.w; }
    }
    float s = 0.f;
#pragma unroll
    for (int j = 0; j < 8; ++j)
#pragma unroll
        for (int i = 0; i < 4; ++i) { const int c = 256 * j + 4 * lane + i; y[j * 4 + i] += ALPHA * x[j * 4 + i] + bf2f(PLEB[(size_t)tok * 2048 + c]); s += y[j * 4 + i]; }
    const float mean = wave_sum(s) * (1.f / D); float q = 0.f;
#pragma unroll
    for (int i = 0; i < 32; ++i) { y[i] -= mean; q += y[i] * y[i]; }
    const float rstd = rsqrtf(wave_sum(q) * (1.f / D) + LN_EPS);
#pragma unroll
    for (int j = 0; j < 8; ++j) { const int c = 256 * j + 4 * lane; float4 o;
        o.x = y[j * 4] * rstd * lg[c] + lb[c]; o.y = y[j * 4 + 1] * rstd * lg[c + 1] + lb[c + 1]; o.z = y[j * 4 + 2] * rstd * lg[c + 2] + lb[c + 2]; o.w = y[j * 4 + 3] * rstd * lg[c + 3] + lb[c + 3];
        *(float4*)(out + (size_t)tok * 2048 + c) = o; }
}


typedef float f32x2_ __attribute__((ext_vector_type(2)));
DEV unsigned q8_1(float v) { return (unsigned)(__float2int_rn(v) + 128) & 0xffu; }
DEV void fp8_row(const float* __restrict__ src, unsigned char* __restrict__ dst, float* __restrict__ rs, int row, int lane) {
    const float4* sp = (const float4*)(src + (size_t)row * 2048) + lane; float4 v[8]; float m = 0.f;
#pragma unroll
    for (int j = 0; j < 8; ++j) { v[j] = sp[64 * j]; m = fmaxf(fmaxf(m, fmaxf(fabsf(v[j].x), fabsf(v[j].y))), fmaxf(fabsf(v[j].z), fabsf(v[j].w))); }
    m = wave_max(m); const float inv = m > 0.f ? 127.f / m : 0.f;
    unsigned* dp = (unsigned*)(dst + (size_t)row * 2048) + lane;
#pragma unroll
    for (int j = 0; j < 8; ++j) dp[64 * j] = q8_1(v[j].x * inv) | (q8_1(v[j].y * inv) << 8) | (q8_1(v[j].z * inv) << 16) | (q8_1(v[j].w * inv) << 24);
    if (lane == 0) rs[row] = m * (1.f / 127.f);
}
#define PG_ISSUE_U(grp) do { _Pragma("unroll") for (int e_ = 0; e_ < 4; ++e_) { const int ee_ = 4 * (grp) + e_; const int id_ = __builtin_amdgcn_readlane(ee_ < 64 ? id0 : id1, ee_ & 63); \
        const uint4* up_ = (const uint4*)(U8 + (size_t)id_ * 2048) + lane; ub[e_][0] = up_[0]; ub[e_][1] = up_[64]; } } while (0)
#define PG_ISSUE_V(grp) do { _Pragma("unroll") for (int e_ = 0; e_ < 4; ++e_) { const int ee_ = 4 * (grp) + e_; const int id_ = __builtin_amdgcn_readlane(ee_ < 64 ? id0 : id1, ee_ & 63); \
        const uint4* vp_ = (const uint4*)(V8 + (size_t)id_ * 2048) + lane; vb[e_][0] = vp_[0]; vb[e_][1] = vp_[64]; } } while (0)
#define PG_DOT(w4, xo, acc) do { const uint4 w_ = (w4); const unsigned q_[4] = {w_.x, w_.y, w_.z, w_.w}; _Pragma("unroll") for (int qq_ = 0; qq_ < 4; ++qq_) { \
        const f32x2_ lo_ = {(float)(q_[qq_] & 0xffu), (float)((q_[qq_] >> 8) & 0xffu)}, hi_ = {(float)((q_[qq_] >> 16) & 0xffu), (float)(q_[qq_] >> 24)}; \
        acc += lo_ * x2[(xo) + 2 * qq_]; acc += hi_ * x2[(xo) + 2 * qq_ + 1]; } } while (0)
#define PG_AXPY(w4, xo, wv) do { const uint4 w_ = (w4); const unsigned q_[4] = {w_.x, w_.y, w_.z, w_.w}; _Pragma("unroll") for (int qq_ = 0; qq_ < 4; ++qq_) { \
        const f32x2_ lo_ = {(float)(q_[qq_] & 0xffu), (float)((q_[qq_] >> 8) & 0xffu)}, hi_ = {(float)((q_[qq_] >> 16) & 0xffu), (float)(q_[qq_] >> 24)}; \
        y2[(xo) + 2 * qq_] += lo_ * (wv); y2[(xo) + 2 * qq_ + 1] += hi_ * (wv); } } while (0)
#define PG_GROUP(grp, more) do { float a_[4]; \
        _Pragma("unroll") for (int e_ = 0; e_ < 4; ++e_) { f32x2_ acc_ = {0.f, 0.f}; PG_DOT(ub[e_][0], 0, acc_); PG_DOT(ub[e_][1], 8, acc_); a_[e_] = acc_.x + acc_.y - xs128; } \
        if (more) PG_ISSUE_U((grp) + 1); \
        float s0_ = hi32 ? a_[0] : a_[2], s1_ = hi32 ? a_[1] : a_[3], k0_ = hi32 ? a_[2] : a_[0], k1_ = hi32 ? a_[3] : a_[1]; \
        k0_ += __shfl_xor(s0_, 32); k1_ += __shfl_xor(s1_, 32); \
        float sd_ = hi16 ? k0_ : k1_, kk_ = hi16 ? k1_ : k0_; kk_ += __shfl_xor(sd_, 16); \
        kk_ += __shfl_xor(kk_, 8); kk_ += __shfl_xor(kk_, 4); kk_ += __shfl_xor(kk_, 2); kk_ += __shfl_xor(kk_, 1); \
        const int ow_ = (4 * (grp) + (lane >> 4)) & 63; const float su_ = __shfl((grp) < 16 ? su0 : su1, ow_), sv_ = __shfl((grp) < 16 ? sv0 : sv1, ow_); \
        const float hid_ = su_ * kk_; const float wv_ = sv_ * (0.5f * hid_ * (1.f + erff(hid_ * 0.70710678f))); \
        _Pragma("unroll") for (int e_ = 0; e_ < 4; ++e_) { const float we_ = __uint_as_float((unsigned)__builtin_amdgcn_readlane((int)__float_as_uint(wv_), 16 * e_)); wsum += we_; PG_AXPY(vb[e_][0], 0, we_); PG_AXPY(vb[e_][1], 8, we_); } \
        if (more) PG_ISSUE_V((grp) + 1); } while (0)
DEV void peer_gather_tok(const bf16* __restrict__ H1, int id0, int id1, float gp0, float gp1, const unsigned char* __restrict__ U8, const unsigned char* __restrict__ V8,
                         const float* __restrict__ RSU, const float* __restrict__ RSV, const bf16* __restrict__ PLEB, const float* lg, const float* lb, float* __restrict__ out, int tok, int lane) {
    const bool hi32 = (lane & 32) != 0, hi16 = (lane & 16) != 0;
    f32x2_ x2[16], y2[16];
#pragma unroll
    for (int j = 0; j < 2; ++j)
#pragma unroll
        for (int hh = 0; hh < 2; ++hh) { const uint4 w = *(const uint4*)(H1 + (size_t)tok * 2048 + 1024 * j + 16 * lane + 8 * hh); const unsigned q[4] = {w.x, w.y, w.z, w.w};
#pragma unroll
            for (int k = 0; k < 4; ++k) { x2[8 * j + 4 * hh + k] = (f32x2_){__uint_as_float(q[k] << 16), __uint_as_float(q[k] & 0xffff0000u)}; } }
#pragma unroll
    for (int k = 0; k < 16; ++k) y2[k] = (f32x2_){0.f, 0.f};
    const float su0 = RSU[id0], su1 = RSU[id1], sv0 = RSV[id0] * gp0, sv1 = RSV[id1] * gp1;
    float xs128 = 0.f, wsum = 0.f;
#pragma unroll
    for (int k = 0; k < 16; ++k) xs128 += x2[k].x + x2[k].y;
    xs128 *= 128.f;
    uint4 ub[4][2], vb[4][2];
    PG_ISSUE_U(0); PG_ISSUE_V(0);
    for (int g = 0; g < 31; ++g) PG_GROUP(g, true);
    PG_GROUP(31, false);
    wsum *= 128.f;
#pragma unroll
    for (int k = 0; k < 16; ++k) y2[k] -= wsum;
    asm volatile("" : "+s"(lg), "+s"(lb));
    float s = 0.f;
#pragma unroll
    for (int j = 0; j < 2; ++j)
#pragma unroll
        for (int hh = 0; hh < 2; ++hh) { const uint4 w = *(const uint4*)(PLEB + (size_t)tok * 2048 + 1024 * j + 16 * lane + 8 * hh); const unsigned q[4] = {w.x, w.y, w.z, w.w};
#pragma unroll
            for (int k = 0; k < 4; ++k) { const int ix = 8 * j + 4 * hh + k; y2[ix] += x2[ix] * ALPHA + (f32x2_){__uint_as_float(q[k] << 16), __uint_as_float(q[k] & 0xffff0000u)}; s += y2[ix].x + y2[ix].y; } }
    const float mean = wave_sum(s) * (1.f / D); float q = 0.f;
#pragma unroll
    for (int k = 0; k < 16; ++k) { y2[k] -= mean; q += y2[k].x * y2[k].x + y2[k].y * y2[k].y; }
    const float rstd = rsqrtf(wave_sum(q) * (1.f / D) + LN_EPS);
#pragma unroll
    for (int j = 0; j < 2; ++j)
#pragma unroll
        for (int k = 0; k < 4; ++k) { const int c = 1024 * j + 16 * lane + 4 * k; const float4 gg = *(const float4*)(lg + c), bb = *(const float4*)(lb + c); const f32x2_ a = y2[8 * j + 2 * k], b = y2[8 * j + 2 * k + 1];
            float4 o; o.x = a.x * rstd * gg.x + bb.x; o.y = a.y * rstd * gg.y + bb.y; o.z = b.x * rstd * gg.z + bb.z; o.w = b.y * rstd * gg.w + bb.w; *(float4*)(out + (size_t)tok * 2048 + c) = o; }
}

typedef short bf16x8_ __attribute__((ext_vector_type(8)));
typedef float f32x4_ __attribute__((ext_vector_type(4)));
#define LASF __attribute__((address_space(3)))
constexpr int GP_ROW = 528;
constexpr int GP_QD = 0, GP_KI = 64 * GP_ROW, GP_KS = 2 * 64 * GP_ROW, GP_LR = 3 * 64 * GP_ROW, GP_SX = GP_LR + 4096, GP_GK = GP_SX + 4096;
typedef __bf16 bf16x2_t_ __attribute__((ext_vector_type(2)));
DEV unsigned cvtpk(float lo, float hi) { const f32x2_ v = {lo, hi}; return __builtin_bit_cast(unsigned, __builtin_convertvector(v, bf16x2_t_)); }
DEV void gla_pre_item(LASF unsigned char* lds, const bf16* __restrict__ GQK, const bf16* __restrict__ LR, const float* __restrict__ up, const float* __restrict__ bias,
                      bf16* __restrict__ QD, bf16* __restrict__ KST, bf16* __restrict__ ATT, float* __restrict__ DEC, int b, int h, int n, int dir, int tid) {
    const int k = tid & 255, ch = tid >> 8, tok0 = b * 2048 + n * 64, cidx = (b * 4 + h) * 32 + n, lane = tid & 63, wave = tid >> 6, fr = lane & 15, g = lane >> 4;
    LASF float* LRs = (LASF float*)(lds + GP_LR); LASF float* Sx = (LASF float*)(lds + GP_SX);
    for (int i = tid; i < 64 * 16; i += 512) LRs[i] = bf2f(LR[(size_t)(tok0 + (i >> 4)) * 256 + dir * 16 + (i & 15)]);
    float upr[16];
#pragma unroll
    for (int r = 0; r < 16; ++r) upr[r] = up[r * 1024 + h * 256 + k];
    const float bs = bias[h * 256 + k];
    __syncthreads();
    float S = 0.f, la[32];
#pragma unroll
    for (int cc = 0; cc < 32; ++cc) { const int c = dir ? 32 * ch + 31 - cc : 32 * ch + cc; float gk = bs;
#pragma unroll
        for (int r4 = 0; r4 < 4; ++r4) { const f32x4_ l4 = *(const LASF f32x4_*)(LRs + c * 16 + 4 * r4); gk += l4[0] * upr[4 * r4] + l4[1] * upr[4 * r4 + 1] + l4[2] * upr[4 * r4 + 2] + l4[3] * upr[4 * r4 + 3]; }
        la[cc] = (fminf(gk, 0.f) - __logf(1.f + __expf(-fabsf(gk)))) * (1.f / 16.f); S += la[cc]; }
    Sx[ch * 256 + k] = S;
    __syncthreads();
    const float Sother = Sx[(1 - ch) * 256 + k], btot = S + Sother, ebt = __expf(btot);
    float cum = (dir ? (ch == 0) : (ch == 1)) ? Sother : 0.f;
#pragma unroll
    for (int cc = 0; cc < 32; ++cc) { const int c = dir ? 32 * ch + 31 - cc : 32 * ch + cc;
        cum += la[cc];
        const size_t tr = (size_t)(tok0 + c) * 2048 + h * 256 + k; const float q = bf2f(GQK[tr]), kk = bf2f(GQK[tr + 1024]);
        const float e = __expf(cum), ie = __builtin_amdgcn_rcpf(e);
        const bf16 qd = f2bf(q * e), ki = f2bf(kk * ie), ks = f2bf(kk * ie * ebt);
        *(LASF bf16*)(lds + GP_QD + c * GP_ROW + k * 2) = qd; *(LASF bf16*)(lds + GP_KI + c * GP_ROW + k * 2) = ki; *(LASF bf16*)(lds + GP_KS + c * GP_ROW + k * 2) = ks;
        QD[(size_t)(tok0 + c) * 1024 + h * 256 + k] = qd; }
    if (ch == 0) DEC[(size_t)cidx * 256 + k] = ebt;
    __syncthreads();
    { const int ti = wave >> 1, tj0 = 2 * (wave & 1);
#pragma unroll
      for (int u = 0; u < 2; ++u) { const int tj = tj0 + u; f32x4_ acc = {0.f, 0.f, 0.f, 0.f};
        if (dir ? (tj >= ti) : (tj <= ti)) {
#pragma unroll
            for (int s8 = 0; s8 < 8; ++s8) { const bf16x8_ a = *(const LASF bf16x8_*)(lds + GP_QD + (16 * ti + fr) * GP_ROW + 64 * s8 + 16 * g), bq = *(const LASF bf16x8_*)(lds + GP_KI + (16 * tj + fr) * GP_ROW + 64 * s8 + 16 * g);
                acc = __builtin_amdgcn_mfma_f32_16x16x32_bf16(a, bq, acc, 0, 0, 0); } }
#pragma unroll
        for (int r = 0; r < 4; ++r) { const int i = 16 * ti + 4 * g + r, j = 16 * tj + fr; const bool keep = dir ? (j > i) : (j <= i);
            ATT[(size_t)cidx * 4096 + i * 64 + j] = f2bf(keep ? acc[r] : 0.f); } } }
#pragma unroll
    for (int qq = 0; qq < 4; ++qq) { const int c0 = 8 * (ch * 4 + qq); unsigned short v[8];
#pragma unroll
        for (int jj = 0; jj < 8; ++jj) v[jj] = *(const LASF bf16*)(lds + GP_KS + (c0 + jj) * GP_ROW + k * 2);
        uint4 o; o.x = v[0] | ((unsigned)v[1] << 16); o.y = v[2] | ((unsigned)v[3] << 16); o.z = v[4] | ((unsigned)v[5] << 16); o.w = v[6] | ((unsigned)v[7] << 16);
        *(uint4*)(KST + ((size_t)cidx * 256 + k) * 64 + c0) = o; }
    __syncthreads();
}
typedef unsigned u32x4_ __attribute__((ext_vector_type(4)));
typedef unsigned u32x2_ __attribute__((ext_vector_type(2)));
constexpr int S2_QT = 0, S2_KT = 64 * 528, S2_VT = S2_KT + 256 * 144, S2_AT = S2_VT + 64 * 144, S2_DC = S2_AT + 64 * 144, S2_P = S2_DC + 1024, S2_PW = 32 * 144;
#define S2_BAR() do { asm volatile("s_waitcnt lgkmcnt(0)" ::: "memory"); __builtin_amdgcn_s_barrier(); asm volatile("" ::: "memory"); } while (0)
struct QTab { const float* tu; const float* tv; unsigned char* u4; unsigned char* v4; float* rsu; float* rsv; int gw, ngw; };
DEV void f4_finish(const float4 (&v)[8], unsigned char* __restrict__ dst4, float* __restrict__ rs, int row, int lane) {
    float q = 0.f;
#pragma unroll
    for (int j = 0; j < 8; ++j) q += (v[j].x * v[j].x + v[j].y * v[j].y) + (v[j].z * v[j].z + v[j].w * v[j].w);
    const float rms = sqrtf(wave_sum(q) * (1.f / 2048.f)); const float inv4 = rms > 0.f ? 2.f / rms : 0.f;
#pragma unroll
    for (int j = 0; j < 8; ++j) { unsigned w = 0u;
        w = __builtin_amdgcn_cvt_scalef32_pk_fp4_f32(w, v[j].x * inv4, v[j].y * inv4, 1.0f, 0); w = __builtin_amdgcn_cvt_scalef32_pk_fp4_f32(w, v[j].z * inv4, v[j].w * inv4, 1.0f, 1);
        *(unsigned short*)(dst4 + (size_t)row * 1024 + 128 * j + 2 * lane) = (unsigned short)w; }
    if (lane == 0) rs[128 * 128 + row] = rms * 0.5f;
}
DEV void gla_scan_item(LASF unsigned char* lds, const bf16* __restrict__ QD, const bf16* __restrict__ KST, const bf16* __restrict__ ATT, const float* __restrict__ DEC, const bf16* __restrict__ VT,
                       bf16* __restrict__ O, int b, int h, int dir, int sl, int tid, const QTab& qt, int& qk) {
    const int lane = tid & 63, wave = __builtin_amdgcn_readfirstlane(tid >> 6), fr = lane & 15, g = lane >> 4, kq = wave >> 1, dh = wave & 1;
    f32x4_ st[4][2];
#pragma unroll
    for (int i = 0; i < 4; ++i)
#pragma unroll
        for (int t = 0; t < 2; ++t) st[i][t] = (f32x4_){0.f, 0.f, 0.f, 0.f};
    u32x4_ sq[4], sk[4], sv, sa, sd = {0u, 0u, 0u, 0u};
#define S2_ISSUE(nn) do { const size_t ci_ = (size_t)((b * 4 + h) * 32 + (nn)); const size_t t0_ = (size_t)b * 2048 + (nn) * 64; \
        _Pragma("unroll") for (int j = 0; j < 4; ++j) { const int ix_ = tid + 512 * j; sq[j] = *(const u32x4_*)(QD + (t0_ + (ix_ >> 5)) * 1024 + h * 256 + (ix_ & 31) * 8); } \
        _Pragma("unroll") for (int j = 0; j < 4; ++j) { const int ix_ = tid + 512 * j; sk[j] = *(const u32x4_*)(KST + (ci_ * 256 + (ix_ >> 3)) * 64 + (ix_ & 7) * 8); } \
        sv = *(const u32x4_*)(VT + (size_t)(1024 + h * 512 + sl * 64 + (tid >> 3)) * T + t0_ + (tid & 7) * 8); sa = *(const u32x4_*)(ATT + ci_ * 4096 + (tid >> 3) * 64 + (tid & 7) * 8); \
        sd = *(const u32x4_*)(DEC + ci_ * 256 + (tid & 63) * 4); } while (0)
#define S2_COMMIT() do { \
        _Pragma("unroll") for (int j = 0; j < 4; ++j) { const int ix_ = tid + 512 * j; *(LASF u32x4_*)(lds + S2_QT + (ix_ >> 5) * 528 + (ix_ & 31) * 16) = sq[j]; *(LASF u32x4_*)(lds + S2_KT + (ix_ >> 3) * 144 + (ix_ & 7) * 16) = sk[j]; } \
        *(LASF u32x4_*)(lds + S2_VT + (tid >> 3) * 144 + (tid & 7) * 16) = sv; *(LASF u32x4_*)(lds + S2_AT + (tid >> 3) * 144 + (tid & 7) * 16) = sa; \
        if (tid < 64) *(LASF u32x4_*)(lds + S2_DC + tid * 16) = sd; } while (0)
    { const int n0 = dir ? 31 : 0; S2_ISSUE(n0); S2_COMMIT(); S2_BAR(); }
    for (int step = 0; step < 32; ++step) {
        const int n = dir ? 31 - step : step, nn = dir ? (n > 0 ? n - 1 : 0) : (n < 31 ? n + 1 : 31);
        const int qrow = qt.gw + qt.ngw * qk; const bool qdo = (((step ^ (wave >> 2)) & 1) == 0) && (qrow < 2 * 128 * 128);
        float4 qv[8];
#pragma unroll
        for (int j = 0; j < 8; ++j) qv[j] = make_float4(0.f, 0.f, 0.f, 0.f);
        if (qdo) { const float4* sp_ = (const float4*)(qrow < 128 * 128 ? qt.tu + (size_t)qrow * 2048 : qt.tv + (size_t)(qrow - 128 * 128) * 2048) + lane;
#pragma unroll
            for (int j = 0; j < 8; ++j) { const f32x4_ t_ = __builtin_nontemporal_load((const f32x4_*)(sp_ + 64 * j)); qv[j] = make_float4(t_[0], t_[1], t_[2], t_[3]); } }
        S2_ISSUE(nn);
        f32x4_ po[4][2];
        { bf16x8_ bs_[2][2];
#pragma unroll
          for (int t = 0; t < 2; ++t)
#pragma unroll
            for (int s_ = 0; s_ < 2; ++s_) { uint4 w; w.x = cvtpk(st[2 * s_][t][0], st[2 * s_][t][1]); w.y = cvtpk(st[2 * s_][t][2], st[2 * s_][t][3]); w.z = cvtpk(st[2 * s_ + 1][t][0], st[2 * s_ + 1][t][1]); w.w = cvtpk(st[2 * s_ + 1][t][2], st[2 * s_ + 1][t][3]); bs_[t][s_] = __builtin_bit_cast(bf16x8_, w); }
#pragma unroll
          for (int m = 0; m < 4; ++m) { bf16x8_ qa_[2];
#pragma unroll
            for (int s_ = 0; s_ < 2; ++s_) { const LASF unsigned char* qp_ = lds + S2_QT + (16 * m + fr) * 528 + (kq * 64 + 32 * s_ + 4 * g) * 2; const u32x2_ lo = *(const LASF u32x2_*)qp_, hi = *(const LASF u32x2_*)(qp_ + 32);
                uint4 w; w.x = lo.x; w.y = lo.y; w.z = hi.x; w.w = hi.y; qa_[s_] = __builtin_bit_cast(bf16x8_, w); }
#pragma unroll
            for (int t = 0; t < 2; ++t) { f32x4_ a = {0.f, 0.f, 0.f, 0.f}; a = __builtin_amdgcn_mfma_f32_16x16x32_bf16(qa_[0], bs_[t][0], a, 0, 0, 0); a = __builtin_amdgcn_mfma_f32_16x16x32_bf16(qa_[1], bs_[t][1], a, 0, 0, 0); po[m][t] = a; } } }
#pragma unroll
        for (int m = 0; m < 4; ++m)
#pragma unroll
            for (int t = 0; t < 2; ++t) { u32x2_ w; w.x = cvtpk(po[m][t][0], po[m][t][1]); w.y = cvtpk(po[m][t][2], po[m][t][3]); *(LASF u32x2_*)(lds + S2_P + wave * S2_PW + (16 * t + fr) * 144 + (16 * m + 4 * g) * 2) = w; }
        S2_BAR();
        bf16x8_ vb[2][2];
#pragma unroll
        for (int t = 0; t < 2; ++t)
#pragma unroll
            for (int s2 = 0; s2 < 2; ++s2) vb[t][s2] = *(const LASF bf16x8_*)(lds + S2_VT + (dh * 32 + 16 * t + fr) * 144 + (32 * s2 + 8 * g) * 2);
        { const bf16x8_ aa0 = *(const LASF bf16x8_*)(lds + S2_AT + (16 * kq + fr) * 144 + (8 * g) * 2), aa1 = *(const LASF bf16x8_*)(lds + S2_AT + (16 * kq + fr) * 144 + (32 + 8 * g) * 2);
#pragma unroll
          for (int t = 0; t < 2; ++t) { f32x4_ a = {0.f, 0.f, 0.f, 0.f};
#pragma unroll
            for (int w4 = 0; w4 < 4; ++w4) { const u32x2_ pw = *(const LASF u32x2_*)(lds + S2_P + (2 * w4 + dh) * S2_PW + (16 * t + fr) * 144 + (16 * kq + 4 * g) * 2);
                a[0] += __uint_as_float(pw.x << 16); a[1] += __uint_as_float(pw.x & 0xffff0000u); a[2] += __uint_as_float(pw.y << 16); a[3] += __uint_as_float(pw.y & 0xffff0000u); }
            a = __builtin_amdgcn_mfma_f32_16x16x32_bf16(aa0, vb[t][0], a, 0, 0, 0); a = __builtin_amdgcn_mfma_f32_16x16x32_bf16(aa1, vb[t][1], a, 0, 0, 0);
#pragma unroll
            for (int r = 0; r < 4; ++r) O[(size_t)(b * 2048 + n * 64 + 16 * kq + 4 * g + r) * 2048 + h * 512 + sl * 64 + dh * 32 + 16 * t + fr] = f2bf(a[r]); } }
#pragma unroll
        for (int i = 0; i < 4; ++i) { const f32x4_ dc = *(const LASF f32x4_*)(lds + S2_DC + (kq * 64 + 16 * i + 4 * g) * 4);
            const bf16x8_ ka0 = *(const LASF bf16x8_*)(lds + S2_KT + (kq * 64 + 16 * i + fr) * 144 + (8 * g) * 2), ka1 = *(const LASF bf16x8_*)(lds + S2_KT + (kq * 64 + 16 * i + fr) * 144 + (32 + 8 * g) * 2);
#pragma unroll
            for (int t = 0; t < 2; ++t) { f32x4_ a = st[i][t] * dc; a = __builtin_amdgcn_mfma_f32_16x16x32_bf16(ka0, vb[t][0], a, 0, 0, 0); a = __builtin_amdgcn_mfma_f32_16x16x32_bf16(ka1, vb[t][1], a, 0, 0, 0); st[i][t] = a; } }
        S2_BAR();
        asm volatile("s_waitcnt vmcnt(0)" ::: "memory");
        S2_COMMIT();
        if (qdo) { if (qrow < 128 * 128) f4_finish(qv, qt.u4, qt.rsu, qrow, lane); else f4_finish(qv, qt.v4, qt.rsv, qrow - 128 * 128, lane); ++qk; }
        S2_BAR();
    }
#undef S2_ISSUE
#undef S2_COMMIT
}

DEV void na_task(const bf16* __restrict__ NAQK, const bf16* __restrict__ VT, const float* __restrict__ rpb, bf16* __restrict__ YNA, int task, int lane) {
    const int w = task & 3, r = (task >> 2) & 31, h = (task >> 7) & 15, b = task >> 11, fr = lane & 15, g = lane >> 4;
    const int r0 = min(max(r - WIN_R / 2, 0), ROWS - WIN_R), cs = min(max(16 * w - 8, 0), GRID_W - 32), qc = 16 * w + fr, c0 = min(max(qc - WIN_C / 2, 0), GRID_W - WIN_C);
    const size_t tokq = (size_t)b * 2048 + r * 64 + qc;
    const bf16x8_ q0 = *(const bf16x8_*)(NAQK + tokq * 2048 + h * 64 + 8 * g), q1 = *(const bf16x8_*)(NAQK + tokq * 2048 + h * 64 + 32 + 8 * g);
    bf16x8_ kf[8][2][2];
#pragma unroll
    for (int i = 0; i < 8; ++i)
#pragma unroll
        for (int ct = 0; ct < 2; ++ct) { const bf16* kp = NAQK + ((size_t)b * 2048 + (r0 + i) * 64 + cs + 16 * ct + fr) * 2048 + 1024 + h * 64 + 8 * g; kf[i][ct][0] = *(const bf16x8_*)kp; kf[i][ct][1] = *(const bf16x8_*)(kp + 32); }
    __builtin_amdgcn_sched_barrier(0);
    f32x4_ sc[8][2];
#pragma unroll
    for (int i = 0; i < 8; ++i)
#pragma unroll
        for (int ct = 0; ct < 2; ++ct) { f32x4_ a = {0.f, 0.f, 0.f, 0.f}; a = __builtin_amdgcn_mfma_f32_16x16x32_bf16(kf[i][ct][0], q0, a, 0, 0, 0); a = __builtin_amdgcn_mfma_f32_16x16x32_bf16(kf[i][ct][1], q1, a, 0, 0, 0); sc[i][ct] = a; }
    __builtin_amdgcn_sched_barrier(0);
    float bs[8][2][4]; uint2 va[4][4][2], vc[4][4][2];
#pragma unroll
    for (int i = 0; i < 8; ++i)
#pragma unroll
        for (int ct = 0; ct < 2; ++ct)
#pragma unroll
            for (int rg = 0; rg < 4; ++rg) bs[i][ct][rg] = rpb[(h * 15 + (r0 + i - r + WIN_R - 1)) * 31 + min(max(cs + 16 * ct + 4 * g + rg - qc + WIN_C - 1, 0), 30)];
#define NA_LDV(dst, ibase) do { _Pragma("unroll") for (int i_ = 0; i_ < 4; ++i_) _Pragma("unroll") for (int mt = 0; mt < 4; ++mt) { \
        const bf16* vp_ = VT + (size_t)(h * 64 + 16 * mt + fr) * T + (size_t)b * 2048 + (r0 + (ibase) + i_) * 64 + cs + 4 * g; dst[i_][mt][0] = *(const uint2*)vp_; dst[i_][mt][1] = *(const uint2*)(vp_ + 16); } } while (0)
    NA_LDV(va, 0);
    __builtin_amdgcn_sched_barrier(0);
    float mx = -3.0e38f;
#pragma unroll
    for (int i = 0; i < 8; ++i)
#pragma unroll
        for (int ct = 0; ct < 2; ++ct)
#pragma unroll
            for (int rg = 0; rg < 4; ++rg) { const int kc = cs + 16 * ct + 4 * g + rg; const bool valid = (kc >= c0) && (kc < c0 + WIN_C);
                const float v = valid ? sc[i][ct][rg] + bs[i][ct][rg] : -3.0e38f; sc[i][ct][rg] = v; mx = fmaxf(mx, v); }
    mx = fmaxf(mx, __shfl_xor(mx, 16)); mx = fmaxf(mx, __shfl_xor(mx, 32));
    NA_LDV(vc, 4);
    __builtin_amdgcn_sched_barrier(0);
    float sum = 0.f;
#pragma unroll
    for (int i = 0; i < 8; ++i)
#pragma unroll
        for (int ct = 0; ct < 2; ++ct)
#pragma unroll
            for (int rg = 0; rg < 4; ++rg) { const float p = sc[i][ct][rg] > -1.0e38f ? __expf(sc[i][ct][rg] - mx) : 0.f; sc[i][ct][rg] = p; sum += p; }
    sum += __shfl_xor(sum, 16); sum += __shfl_xor(sum, 32);
    f32x4_ o[4];
#pragma unroll
    for (int mt = 0; mt < 4; ++mt) o[mt] = (f32x4_){0.f, 0.f, 0.f, 0.f};
#define NA_PV(src, ibase) do { _Pragma("unroll") for (int i_ = 0; i_ < 4; ++i_) { const int i = (ibase) + i_; uint4 pw; pw.x = cvtpk(sc[i][0][0], sc[i][0][1]); pw.y = cvtpk(sc[i][0][2], sc[i][0][3]); pw.z = cvtpk(sc[i][1][0], sc[i][1][1]); pw.w = cvtpk(sc[i][1][2], sc[i][1][3]); \
        const bf16x8_ pb = __builtin_bit_cast(bf16x8_, pw); \
        _Pragma("unroll") for (int mt = 0; mt < 4; ++mt) { uint4 aw; aw.x = src[i_][mt][0].x; aw.y = src[i_][mt][0].y; aw.z = src[i_][mt][1].x; aw.w = src[i_][mt][1].y; \
            o[mt] = __builtin_amdgcn_mfma_f32_16x16x32_bf16(__builtin_bit_cast(bf16x8_, aw), pb, o[mt], 0, 0, 0); } } } while (0)
    NA_PV(va, 0); NA_PV(vc, 4);
#undef NA_LDV
#undef NA_PV
    const float inv = 1.f / sum;
#pragma unroll
    for (int mt = 0; mt < 4; ++mt) { uint2 ow; ow.x = cvtpk(o[mt][0] * inv, o[mt][1] * inv); ow.y = cvtpk(o[mt][2] * inv, o[mt][3] * inv);
        *(uint2*)(YNA + tokq * 1024 + h * 64 + 16 * mt + 4 * g) = ow; }
}

constexpr int NA_KROW = 64 * 144, NA_K = 0, NA_V = 8 * NA_KROW, NA_VP = 1040, NA_BT = NA_V + 64 * NA_VP, NA_EX = NA_BT + 1872;
DEV void na_item(LASF unsigned char* lds, const bf16* __restrict__ NAQK, const bf16* __restrict__ VT, const float* __restrict__ rpb, bf16* __restrict__ YNA, int b, int h, int rb, int tid, const QTab& qt, int& qk) {
    const int lane = tid & 63, wave = __builtin_amdgcn_readfirstlane(tid >> 6), fr = lane & 15, g = lane >> 4, w = wave >> 1, dhalf = wave & 1;
    const int cs = min(max(16 * w - 8, 0), GRID_W - 32), qc = 16 * w + fr, c0 = min(max(qc - WIN_C / 2, 0), GRID_W - WIN_C);
    LASF float* BT = (LASF float*)(lds + NA_BT);
    for (int i = tid; i < 15 * 31; i += 512) BT[i] = rpb[h * 465 + i];
    const int kkey = tid >> 3, kch = tid & 7;
#define NA_LDROW(kx, vx, row) do { kx = *(const u32x4_*)(NAQK + ((size_t)b * 2048 + (row) * 64 + kkey) * 2048 + 1024 + h * 64 + kch * 8); vx = *(const u32x4_*)(VT + (size_t)(h * 64 + kkey) * T + (size_t)b * 2048 + (row) * 64 + kch * 8); } while (0)
#define NA_STROW(kx, vx, row) do { const int sl_ = (row) & 7; *(LASF u32x4_*)(lds + NA_K + sl_ * NA_KROW + kkey * 144 + kch * 16) = kx; *(LASF u32x4_*)(lds + NA_V + kkey * NA_VP + (sl_ * 64 + kch * 8) * 2) = vx; } while (0)
    { const int r0i = min(max(8 * rb - WIN_R / 2, 0), ROWS - WIN_R); u32x4_ k8[8], v8[8];
#pragma unroll
      for (int i = 0; i < 8; ++i) NA_LDROW(k8[i], v8[i], r0i + i);
#pragma unroll
      for (int i = 0; i < 8; ++i) NA_STROW(k8[i], v8[i], r0i + i); }
    size_t tokq = (size_t)b * 2048 + (8 * rb) * 64 + qc;
    bf16x8_ q0 = *(const bf16x8_*)(NAQK + tokq * 2048 + h * 64 + 8 * g), q1 = *(const bf16x8_*)(NAQK + tokq * 2048 + h * 64 + 32 + 8 * g);
    int bofs[2][4]; float mneg[2][4];
#pragma unroll
    for (int ct = 0; ct < 2; ++ct)
#pragma unroll
        for (int rg = 0; rg < 4; ++rg) { const int kc = cs + 16 * ct + 4 * g + rg; const bool valid = (kc >= c0) && (kc < c0 + WIN_C);
            bofs[ct][rg] = min(max(kc - qc + WIN_C - 1, 0), 30); mneg[ct][rg] = valid ? 0.f : -3.0e38f; }
    f32x4_ bsv[4][2]; int broff = -1000;
    S2_BAR();
    for (int ri = 0; ri < 8; ++ri) {
        const int r = 8 * rb + ri, r0 = min(max(r - WIN_R / 2, 0), ROWS - WIN_R), r0n = min(max(r + 1 - WIN_R / 2, 0), ROWS - WIN_R);
        const bool more = ri < 7, newrow = more && (r0n != r0);
        u32x4_ kx = {0u, 0u, 0u, 0u}, vx = {0u, 0u, 0u, 0u}; bf16x8_ q0n = q0, q1n = q1;
        if (newrow) NA_LDROW(kx, vx, r0n + 7);
        if (more) { const size_t tn = tokq + 64; q0n = *(const bf16x8_*)(NAQK + tn * 2048 + h * 64 + 8 * g); q1n = *(const bf16x8_*)(NAQK + tn * 2048 + h * 64 + 32 + 8 * g); }
        const int i0 = 4 * dhalf;
        { const int roff = r0 + i0 - r + WIN_R - 1;
          if (roff != broff) { broff = roff;
#pragma unroll
            for (int i = 0; i < 4; ++i)
#pragma unroll
                for (int ct = 0; ct < 2; ++ct)
#pragma unroll
                    for (int rg = 0; rg < 4; ++rg) bsv[i][ct][rg] = BT[(roff + i) * 31 + bofs[ct][rg]] + mneg[ct][rg]; } }
        f32x4_ sc[4][2];
#pragma unroll
        for (int i = 0; i < 4; ++i)
#pragma unroll
            for (int ct = 0; ct < 2; ++ct) { const LASF unsigned char* kp = lds + NA_K + ((r0 + i0 + i) & 7) * NA_KROW + (cs + 16 * ct + fr) * 144 + 16 * g;
                f32x4_ a = {0.f, 0.f, 0.f, 0.f}; a = __builtin_amdgcn_mfma_f32_16x16x32_bf16(*(const LASF bf16x8_*)kp, q0, a, 0, 0, 0); a = __builtin_amdgcn_mfma_f32_16x16x32_bf16(*(const LASF bf16x8_*)(kp + 64), q1, a, 0, 0, 0); sc[i][ct] = a; }
        const int qrow = qt.gw + qt.ngw * qk; const bool qdo = qrow < 2 * 128 * 128;
        float4 qv[8];
#pragma unroll
        for (int j = 0; j < 8; ++j) qv[j] = make_float4(0.f, 0.f, 0.f, 0.f);
        __builtin_amdgcn_sched_barrier(0);
        if (qdo) { const float4* sp_ = (const float4*)(qrow < 128 * 128 ? qt.tu + (size_t)qrow * 2048 : qt.tv + (size_t)(qrow - 128 * 128) * 2048) + lane;
#pragma unroll
            for (int j = 0; j < 8; ++j) { const f32x4_ t_ = __builtin_nontemporal_load((const f32x4_*)(sp_ + 64 * j)); qv[j] = make_float4(t_[0], t_[1], t_[2], t_[3]); } }
        __builtin_amdgcn_sched_barrier(0);
        float mx = -3.0e38f;
#pragma unroll
        for (int i = 0; i < 4; ++i)
#pragma unroll
            for (int ct = 0; ct < 2; ++ct)
#pragma unroll
                for (int rg = 0; rg < 4; ++rg) { const float v = sc[i][ct][rg] + bsv[i][ct][rg]; sc[i][ct][rg] = v; mx = fmaxf(mx, v); }
        mx = fmaxf(mx, __shfl_xor(mx, 16)); mx = fmaxf(mx, __shfl_xor(mx, 32));
        float sum = 0.f;
#pragma unroll
        for (int i = 0; i < 4; ++i)
#pragma unroll
            for (int ct = 0; ct < 2; ++ct)
#pragma unroll
                for (int rg = 0; rg < 4; ++rg) { const float p = __builtin_amdgcn_exp2f((sc[i][ct][rg] - mx) * 1.44269504f); sc[i][ct][rg] = p; sum += p; }
        sum += __shfl_xor(sum, 16); sum += __shfl_xor(sum, 32);
        f32x4_ o[4] = {{0.f, 0.f, 0.f, 0.f}, {0.f, 0.f, 0.f, 0.f}, {0.f, 0.f, 0.f, 0.f}, {0.f, 0.f, 0.f, 0.f}};
#pragma unroll
        for (int i = 0; i < 4; ++i) { uint4 pw; pw.x = cvtpk(sc[i][0][0], sc[i][0][1]); pw.y = cvtpk(sc[i][0][2], sc[i][0][3]); pw.z = cvtpk(sc[i][1][0], sc[i][1][1]); pw.w = cvtpk(sc[i][1][2], sc[i][1][3]);
            const bf16x8_ pb = __builtin_bit_cast(bf16x8_, pw);
#pragma unroll
            for (int mm = 0; mm < 4; ++mm) { const LASF unsigned char* vp = lds + NA_V + (16 * ((2 * dhalf + mm) & 3) + fr) * NA_VP + ((((r0 + i0 + i) & 7) * 64) + cs + 4 * g) * 2;
                const u32x2_ lo = *(const LASF u32x2_*)vp, hi = *(const LASF u32x2_*)(vp + 32); uint4 vw; vw.x = lo.x; vw.y = lo.y; vw.z = hi.x; vw.w = hi.y;
                o[mm] = __builtin_amdgcn_mfma_f32_16x16x32_bf16(__builtin_bit_cast(bf16x8_, vw), pb, o[mm], 0, 0, 0); } }
        { LASF unsigned char* ex = lds + NA_EX + wave * 1152; const f32x4_ pa = o[2], pb2 = o[3];
          *(LASF u32x4_*)(ex + 16 * lane) = (u32x4_){cvtpk(pa[0], pa[1]), cvtpk(pa[2], pa[3]), cvtpk(pb2[0], pb2[1]), cvtpk(pb2[2], pb2[3])};
          if (g == 0) *(LASF f32x2_*)(ex + 1024 + 8 * fr) = (f32x2_){mx, sum}; }
        S2_BAR();
        if (newrow) NA_STROW(kx, vx, r0n + 7);
        { const LASF unsigned char* ex = lds + NA_EX + (wave ^ 1) * 1152; const u32x4_ pp = *(const LASF u32x4_*)(ex + 16 * lane); const f32x2_ ps = *(const LASF f32x2_*)(ex + 1024 + 8 * fr);
          const float M = fmaxf(mx, ps[0]), sw = __builtin_amdgcn_exp2f((mx - M) * 1.44269504f), sp = __builtin_amdgcn_exp2f((ps[0] - M) * 1.44269504f), inv = 1.f / (sum * sw + ps[1] * sp);
          const float cw = sw * inv, cp = sp * inv;
#pragma unroll
          for (int mm = 0; mm < 2; ++mm) { const f32x4_ ow_ = o[mm]; const unsigned p0 = pp[2 * mm], p1 = pp[2 * mm + 1];
              const float y0 = ow_[0] * cw + __uint_as_float(p0 << 16) * cp, y1 = ow_[1] * cw + __uint_as_float(p0 & 0xffff0000u) * cp, y2 = ow_[2] * cw + __uint_as_float(p1 << 16) * cp, y3 = ow_[3] * cw + __uint_as_float(p1 & 0xffff0000u) * cp;
              int ow = 0; ow = __builtin_amdgcn_cvt_pk_fp8_f32(y0, y1, ow, false); ow = __builtin_amdgcn_cvt_pk_fp8_f32(y2, y3, ow, true);
              *(int*)((unsigned char*)YNA + tokq * 1024 + h * 64 + 16 * (2 * dhalf + mm) + 4 * g) = ow; } }
        if (qdo) { if (qrow < 128 * 128) f4_finish(qv, qt.u4, qt.rsu, qrow, lane); else f4_finish(qv, qt.v4, qt.rsv, qrow - 128 * 128, lane); ++qk; }
        S2_BAR();
        q0 = q0n; q1 = q1n; tokq += 64;
    }
#undef NA_LDROW
#undef NA_STROW
}

DEV void gla_pre_block(LASF unsigned char* lds, const bf16* __restrict__ GQK, const bf16* __restrict__ LR, const float* __restrict__ upf, const float* __restrict__ bif, const float* __restrict__ upb, const float* __restrict__ bib,
                       bf16* __restrict__ QD0, bf16* __restrict__ KST0, bf16* __restrict__ ATT0, float* __restrict__ DEC0, int bx, int G, int tid) {
    const int k = tid & 255, ch = tid >> 8, lane = tid & 63, wave = tid >> 6, fr = lane & 15, g = lane >> 4;
    LASF float* LRs = (LASF float*)(lds + GP_LR); LASF float* Sx = (LASF float*)(lds + GP_SX);
    u32x4_ rq[4], rk[4], rl = {0u, 0u, 0u, 0u};
#define GPB_ISSUE(it_) do { const int dir_ = (it_) & 1, n_ = ((it_) >> 1) & 31, h_ = ((it_) >> 6) & 3, b_ = (it_) >> 8; const size_t t0_ = (size_t)b_ * 2048 + n_ * 64; \
        _Pragma("unroll") for (int j = 0; j < 4; ++j) { const int ix_ = tid + 512 * j; const bf16* p_ = GQK + (t0_ + (ix_ >> 5)) * 2048 + h_ * 256 + (ix_ & 31) * 8; rq[j] = *(const u32x4_*)p_; rk[j] = *(const u32x4_*)(p_ + 1024); } \
        if (tid < 128) rl = *(const u32x4_*)(LR + (t0_ + (tid >> 1)) * 256 + dir_ * 16 + (tid & 1) * 8); } while (0)
#define GPB_COMMIT() do { \
        _Pragma("unroll") for (int j = 0; j < 4; ++j) { const int ix_ = tid + 512 * j; *(LASF u32x4_*)(lds + GP_QD + (ix_ >> 5) * GP_ROW + (ix_ & 31) * 16) = rq[j]; *(LASF u32x4_*)(lds + GP_KI + (ix_ >> 5) * GP_ROW + (ix_ & 31) * 16) = rk[j]; } \
        if (tid < 128) { f32x4_ a_, b_; a_[0] = __uint_as_float(rl[0] << 16); a_[1] = __uint_as_float(rl[0] & 0xffff0000u); a_[2] = __uint_as_float(rl[1] << 16); a_[3] = __uint_as_float(rl[1] & 0xffff0000u); \
            b_[0] = __uint_as_float(rl[2] << 16); b_[1] = __uint_as_float(rl[2] & 0xffff0000u); b_[2] = __uint_as_float(rl[3] << 16); b_[3] = __uint_as_float(rl[3] & 0xffff0000u); \
            *(LASF f32x4_*)(LRs + (tid >> 1) * 16 + (tid & 1) * 8) = a_; *(LASF f32x4_*)(LRs + (tid >> 1) * 16 + (tid & 1) * 8 + 4) = b_; } } while (0)
    if (bx < 1024) GPB_ISSUE(bx);
    const int kp = tid & 127, qd = tid >> 7;
    int hd_cached = -1; float bs0 = 0.f, bs1 = 0.f; bf16x8_ upb_[2] = {{0, 0, 0, 0, 0, 0, 0, 0}, {0, 0, 0, 0, 0, 0, 0, 0}};
    for (int it = bx; it < 1024; it += G) {
        const int dir = it & 1, n = (it >> 1) & 31, h = (it >> 6) & 3, b = it >> 8, tok0 = b * 2048 + n * 64, cidx = (b * 4 + h) * 32 + n;
        bf16* QD = QD0 + (size_t)dir * T * 1024; bf16* KST = KST0 + (size_t)dir * 512 * 256 * 64; bf16* ATT = ATT0 + (size_t)dir * 512 * 4096; float* DEC = DEC0 + (size_t)dir * 512 * 256;
        if (hd_cached != h * 2 + dir) { const float* up = dir ? upb : upf; const float* bias = dir ? bib : bif; hd_cached = h * 2 + dir;
#pragma unroll
            for (int ct = 0; ct < 2; ++ct) { uint4 w = {0u, 0u, 0u, 0u};
                if (g < 2) { const float* up_ = up + (8 * g) * 1024 + h * 256 + 16 * (2 * wave + ct) + fr;
                    w.x = cvtpk(up_[0], up_[1024]); w.y = cvtpk(up_[2 * 1024], up_[3 * 1024]); w.z = cvtpk(up_[4 * 1024], up_[5 * 1024]); w.w = cvtpk(up_[6 * 1024], up_[7 * 1024]); }
                upb_[ct] = __builtin_bit_cast(bf16x8_, w); }
            { const f32x2_ b2 = *(const f32x2_*)(bias + h * 256 + 2 * kp); bs0 = b2[0]; bs1 = b2[1]; } }
        GPB_COMMIT();
        S2_BAR();
        if (it + G < 1024) GPB_ISSUE(it + G);
#pragma unroll
        for (int tm = 0; tm < 4; ++tm) { uint4 aw = {0u, 0u, 0u, 0u};
            if (g < 2) { const f32x4_ l0 = *(const LASF f32x4_*)(LRs + (16 * tm + fr) * 16 + 8 * g), l1 = *(const LASF f32x4_*)(LRs + (16 * tm + fr) * 16 + 8 * g + 4);
                aw.x = cvtpk(l0[0], l0[1]); aw.y = cvtpk(l0[2], l0[3]); aw.z = cvtpk(l1[0], l1[1]); aw.w = cvtpk(l1[2], l1[3]); }
            const bf16x8_ af = __builtin_bit_cast(bf16x8_, aw);
#pragma unroll
            for (int ct = 0; ct < 2; ++ct) { const f32x4_ z4 = {0.f, 0.f, 0.f, 0.f}; const f32x4_ cg = __builtin_amdgcn_mfma_f32_16x16x32_bf16(af, upb_[ct], z4, 0, 0, 0);
#pragma unroll
                for (int j = 0; j < 4; ++j) *(LASF bf16*)(lds + GP_GK + (16 * tm + 4 * g + j) * GP_ROW + (16 * (2 * wave + ct) + fr) * 2) = f2bf(cg[j]); } }
        S2_BAR();
        float S0 = 0.f, S1 = 0.f, la0[16], la1[16];
#pragma unroll
        for (int cc = 0; cc < 16; ++cc) { const int c = dir ? 16 * qd + 15 - cc : 16 * qd + cc; const unsigned gw_ = *(const LASF unsigned*)(lds + GP_GK + c * GP_ROW + kp * 4);
            const float g0 = bs0 + __uint_as_float(gw_ << 16), g1 = bs1 + __uint_as_float(gw_ & 0xffff0000u);
            la0[cc] = (fminf(g0, 0.f) - __logf(1.f + __expf(-fabsf(g0)))) * (1.f / 16.f); la1[cc] = (fminf(g1, 0.f) - __logf(1.f + __expf(-fabsf(g1)))) * (1.f / 16.f); S0 += la0[cc]; S1 += la1[cc]; }
        *(LASF f32x2_*)(Sx + qd * 256 + 2 * kp) = (f32x2_){S0, S1};
        S2_BAR();
        float cum0 = 0.f, cum1 = 0.f, bt0 = 0.f, bt1 = 0.f;
#pragma unroll
        for (int q4 = 0; q4 < 4; ++q4) { const f32x2_ sq_ = *(const LASF f32x2_*)(Sx + q4 * 256 + 2 * kp); bt0 += sq_[0]; bt1 += sq_[1];
            const bool before = dir ? (q4 > qd) : (q4 < qd); cum0 += before ? sq_[0] : 0.f; cum1 += before ? sq_[1] : 0.f; }
        const float ebt0 = __expf(bt0), ebt1 = __expf(bt1);
#pragma unroll
        for (int cc = 0; cc < 16; ++cc) { const int c = dir ? 16 * qd + 15 - cc : 16 * qd + cc;
            cum0 += la0[cc]; cum1 += la1[cc];
            LASF unsigned* qp = (LASF unsigned*)(lds + GP_QD + c * GP_ROW + kp * 4); LASF unsigned* kq_ = (LASF unsigned*)(lds + GP_KI + c * GP_ROW + kp * 4);
            const unsigned qw = *qp, kw = *kq_; const float q0 = __uint_as_float(qw << 16), q1 = __uint_as_float(qw & 0xffff0000u), k0 = __uint_as_float(kw << 16), k1 = __uint_as_float(kw & 0xffff0000u);
            const float e0 = __expf(cum0), e1 = __expf(cum1), i0 = __builtin_amdgcn_rcpf(e0), i1 = __builtin_amdgcn_rcpf(e1);
            *qp = cvtpk(q0 * e0, q1 * e1); *kq_ = cvtpk(k0 * i0, k1 * i1); *(LASF unsigned*)(lds + GP_KS + c * GP_ROW + kp * 4) = cvtpk(k0 * i0 * ebt0, k1 * i1 * ebt1); }
        if (qd == 0) *(f32x2_*)(DEC + (size_t)cidx * 256 + 2 * kp) = (f32x2_){ebt0, ebt1};
        S2_BAR();
        { const int ti = wave >> 1, tj0 = 2 * (wave & 1);
#pragma unroll
          for (int u = 0; u < 2; ++u) { const int tj = tj0 + u; f32x4_ acc = {0.f, 0.f, 0.f, 0.f};
            if (dir ? (tj >= ti) : (tj <= ti)) {
#pragma unroll
                for (int s8 = 0; s8 < 8; ++s8) { const bf16x8_ a = *(const LASF bf16x8_*)(lds + GP_QD + (16 * ti + fr) * GP_ROW + 64 * s8 + 16 * g), bq = *(const LASF bf16x8_*)(lds + GP_KI + (16 * tj + fr) * GP_ROW + 64 * s8 + 16 * g);
                    acc = __builtin_amdgcn_mfma_f32_16x16x32_bf16(a, bq, acc, 0, 0, 0); } }
#pragma unroll
            for (int r = 0; r < 4; ++r) { const int i = 16 * ti + 4 * g + r, j = 16 * tj + fr; const bool keep = dir ? (j > i) : (j <= i);
                ATT[(size_t)cidx * 4096 + i * 64 + j] = f2bf(keep ? acc[r] : 0.f); } } }
#pragma unroll
        for (int qq = 0; qq < 4; ++qq) { const int c0 = 8 * (ch * 4 + qq); unsigned short v[8];
#pragma unroll
            for (int jj = 0; jj < 8; ++jj) v[jj] = *(const LASF bf16*)(lds + GP_KS + (c0 + jj) * GP_ROW + k * 2);
            uint4 o; o.x = v[0] | ((unsigned)v[1] << 16); o.y = v[2] | ((unsigned)v[3] << 16); o.z = v[4] | ((unsigned)v[5] << 16); o.w = v[6] | ((unsigned)v[7] << 16);
            *(uint4*)(KST + ((size_t)cidx * 256 + k) * 64 + c0) = o; }
#pragma unroll
        for (int j = 0; j < 4; ++j) { const int ix_ = tid + 512 * j; const u32x4_ o = *(const LASF u32x4_*)(lds + GP_QD + (ix_ >> 5) * GP_ROW + (ix_ & 31) * 16); *(u32x4_*)(QD + (size_t)(tok0 + (ix_ >> 5)) * 1024 + h * 256 + (ix_ & 31) * 8) = o; }
        S2_BAR();
    }
#undef GPB_ISSUE
#undef GPB_COMMIT
}

struct __attribute__((aligned(4))) U3_ { unsigned a, b, c; };
DEV void q6_row(const float* __restrict__ src, unsigned char* __restrict__ dst, float* __restrict__ rs, int row, int lane) {
    const float4* sp = (const float4*)(src + (size_t)row * 2048 + 32 * lane); float4 v[8]; float m = 0.f;
#pragma unroll
    for (int j = 0; j < 8; ++j) { v[j] = sp[j]; m = fmaxf(fmaxf(m, fmaxf(fabsf(v[j].x), fabsf(v[j].y))), fmaxf(fabsf(v[j].z), fabsf(v[j].w))); }
    m = wave_max(m); const float inv = m > 0.f ? 31.f / m : 0.f;
    unsigned q[32];
#pragma unroll
    for (int j = 0; j < 8; ++j) { q[4 * j] = (unsigned)(__float2int_rn(v[j].x * inv) + 32); q[4 * j + 1] = (unsigned)(__float2int_rn(v[j].y * inv) + 32); q[4 * j + 2] = (unsigned)(__float2int_rn(v[j].z * inv) + 32); q[4 * j + 3] = (unsigned)(__float2int_rn(v[j].w * inv) + 32); }
#pragma unroll
    for (int t = 0; t < 2; ++t) { const unsigned* p = q + 16 * t; U3_ w;
        w.a = p[0] | (p[1] << 6) | (p[2] << 12) | (p[3] << 18) | (p[4] << 24) | (p[5] << 30);
        w.b = (p[5] >> 2) | (p[6] << 4) | (p[7] << 10) | (p[8] << 16) | (p[9] << 22) | (p[10] << 28);
        w.c = (p[10] >> 4) | (p[11] << 2) | (p[12] << 8) | (p[13] << 14) | (p[14] << 20) | (p[15] << 26);
        *(U3_*)(dst + (size_t)row * 1536 + 24 * lane + 12 * t) = w; }
    if (lane == 0) rs[row] = m * (1.f / 31.f);
}
#define Q6_DEC(T, f) do { const unsigned t0_ = (T).a, t1_ = (T).b, t2_ = (T).c; \
        f[0] = (f32x2_){(float)(t0_ & 63u), (float)((t0_ >> 6) & 63u)}; f[1] = (f32x2_){(float)((t0_ >> 12) & 63u), (float)((t0_ >> 18) & 63u)}; \
        f[2] = (f32x2_){(float)((t0_ >> 24) & 63u), (float)(__builtin_amdgcn_alignbit(t1_, t0_, 30) & 63u)}; f[3] = (f32x2_){(float)((t1_ >> 4) & 63u), (float)((t1_ >> 10) & 63u)}; \
        f[4] = (f32x2_){(float)((t1_ >> 16) & 63u), (float)((t1_ >> 22) & 63u)}; f[5] = (f32x2_){(float)(__builtin_amdgcn_alignbit(t2_, t1_, 28) & 63u), (float)((t2_ >> 2) & 63u)}; \
        f[6] = (f32x2_){(float)((t2_ >> 8) & 63u), (float)((t2_ >> 14) & 63u)}; f[7] = (f32x2_){(float)((t2_ >> 20) & 63u), (float)(t2_ >> 26)}; } while (0)
#define P6_ISSUE_U(grp) do { _Pragma("unroll") for (int e_ = 0; e_ < 8; ++e_) { const int ee_ = 8 * (grp) + e_; const int id_ = __builtin_amdgcn_readlane(ee_ < 64 ? id0 : id1, ee_ & 63); \
        const unsigned char* up_ = U6 + (size_t)id_ * 1536 + 24 * lane; ub[e_][0] = *(const U3_*)up_; ub[e_][1] = *(const U3_*)(up_ + 12); } } while (0)
#define P6_ISSUE_V(grp) do { _Pragma("unroll") for (int e_ = 0; e_ < 8; ++e_) { const int ee_ = 8 * (grp) + e_; const int id_ = __builtin_amdgcn_readlane(ee_ < 64 ? id0 : id1, ee_ & 63); \
        const unsigned char* vp_ = V6 + (size_t)id_ * 1536 + 24 * lane; vb[e_][0] = *(const U3_*)vp_; vb[e_][1] = *(const U3_*)(vp_ + 12); } } while (0)
#define P6_LANE_OF(e) (8 * (e))
#define P6_DPP(x, ctl) __builtin_bit_cast(float, __builtin_amdgcn_mov_dpp(__builtin_bit_cast(int, x), ctl, 0xf, 0xf, true))
#define P6_SW32(a, b) ({ const auto p_ = __builtin_amdgcn_permlane32_swap(__float_as_uint(a), __float_as_uint(b), false, false); __uint_as_float(p_[0]) + __uint_as_float(p_[1]); })
#define P6_SW16(a, b) ({ const auto p_ = __builtin_amdgcn_permlane16_swap(__float_as_uint(a), __float_as_uint(b), false, false); __uint_as_float(p_[0]) + __uint_as_float(p_[1]); })
#define P6_GROUP(grp, more) do { float a_[8]; \
        _Pragma("unroll") for (int e_ = 0; e_ < 8; ++e_) { f32x2_ acc_ = {0.f, 0.f}; \
            _Pragma("unroll") for (int t_ = 0; t_ < 2; ++t_) { f32x2_ f_[8]; Q6_DEC(ub[e_][t_], f_); _Pragma("unroll") for (int p_ = 0; p_ < 8; ++p_) acc_ += f_[p_] * x2[8 * t_ + p_]; } \
            a_[e_] = acc_.x + acc_.y - xs32; } \
        if (more) P6_ISSUE_U((grp) + 1); \
        const int ow_ = (8 * (grp) + (lane >> 3)) & 63; const float su_ = __shfl((grp) < 8 ? su0 : su1, ow_), sv_ = __shfl((grp) < 8 ? sv0 : sv1, ow_); \
          \
        const float h0_ = P6_SW32(a_[0], a_[4]), h1_ = P6_SW32(a_[1], a_[5]), h2_ = P6_SW32(a_[2], a_[6]), h3_ = P6_SW32(a_[3], a_[7]); \
          \
        const float r0_ = P6_SW16(h0_, h2_), r1_ = P6_SW16(h1_, h3_); \
          \
        const bool hi8_ = (lane & 8) != 0; const float keep_ = hi8_ ? r1_ : r0_, send_ = hi8_ ? r0_ : r1_; \
        float kk_ = keep_ + P6_DPP(send_, 0x128); \
        kk_ += P6_DPP(kk_, 0xB1); kk_ += P6_DPP(kk_, 0x4E); kk_ += P6_DPP(kk_, 0x141); \
        const float hid_ = su_ * kk_; const float wv_ = sv_ * (0.5f * hid_ * (1.f + erff(hid_ * 0.70710678f))); \
        _Pragma("unroll") for (int e_ = 0; e_ < 8; ++e_) { const float we_ = __uint_as_float((unsigned)__builtin_amdgcn_readlane((int)__float_as_uint(wv_), P6_LANE_OF(e_))); wsum += we_; \
            _Pragma("unroll") for (int t_ = 0; t_ < 2; ++t_) { f32x2_ f_[8]; Q6_DEC(vb[e_][t_], f_); _Pragma("unroll") for (int p_ = 0; p_ < 8; ++p_) y2[8 * t_ + p_] += f_[p_] * we_; } } \
        if (more) P6_ISSUE_V((grp) + 1); } while (0)
DEV void peer_gather_tok6(const bf16* __restrict__ H1, int id0, int id1, float gp0, float gp1, const unsigned char* __restrict__ U6, const unsigned char* __restrict__ V6,
                          const float* __restrict__ RSU, const float* __restrict__ RSV, const bf16* __restrict__ PLEB, const float* lg, const float* lb, float* __restrict__ out, int tok, int lane) {
    const bool hi32 = (lane & 32) != 0, hi16 = (lane & 16) != 0;
    f32x2_ x2[16], y2[16];
#pragma unroll
    for (int u = 0; u < 4; ++u) { const uint4 w = *(const uint4*)(H1 + (size_t)tok * 2048 + 32 * lane + 8 * u); const unsigned q[4] = {w.x, w.y, w.z, w.w};
#pragma unroll
        for (int k = 0; k < 4; ++k) x2[4 * u + k] = (f32x2_){__uint_as_float(q[k] << 16), __uint_as_float(q[k] & 0xffff0000u)}; }
#pragma unroll
    for (int k = 0; k < 16; ++k) y2[k] = (f32x2_){0.f, 0.f};
    const float su0 = RSU[id0], su1 = RSU[id1], sv0 = RSV[id0] * gp0, sv1 = RSV[id1] * gp1;
    float xs32 = 0.f, wsum = 0.f;
#pragma unroll
    for (int k = 0; k < 16; ++k) xs32 += x2[k].x + x2[k].y;
    xs32 *= 32.f;
    U3_ ub[8][2], vb[8][2];
    P6_ISSUE_U(0); P6_ISSUE_V(0);
    for (int g = 0; g < 15; ++g) P6_GROUP(g, true);
    P6_GROUP(15, false);
    wsum *= 32.f;
#pragma unroll
    for (int k = 0; k < 16; ++k) y2[k] -= wsum;
    asm volatile("" : "+s"(lg), "+s"(lb));
    float s = 0.f;
#pragma unroll
    for (int u = 0; u < 4; ++u) { const uint4 w = *(const uint4*)(PLEB + (size_t)tok * 2048 + 32 * lane + 8 * u); const unsigned q[4] = {w.x, w.y, w.z, w.w};
#pragma unroll
        for (int k = 0; k < 4; ++k) { const int ix = 4 * u + k; y2[ix] += x2[ix] * ALPHA + (f32x2_){__uint_as_float(q[k] << 16), __uint_as_float(q[k] & 0xffff0000u)}; s += y2[ix].x + y2[ix].y; } }
    const float mean = wave_sum(s) * (1.f / D); float q = 0.f;
#pragma unroll
    for (int k = 0; k < 16; ++k) { y2[k] -= mean; q += y2[k].x * y2[k].x + y2[k].y * y2[k].y; }
    const float rstd = rsqrtf(wave_sum(q) * (1.f / D) + LN_EPS);
#pragma unroll
    for (int k = 0; k < 8; ++k) { const int c = 32 * lane + 4 * k; const float4 gg = *(const float4*)(lg + c), bb = *(const float4*)(lb + c); const f32x2_ a = y2[2 * k], b = y2[2 * k + 1];
        float4 o; o.x = a.x * rstd * gg.x + bb.x; o.y = a.y * rstd * gg.y + bb.y; o.z = b.x * rstd * gg.z + bb.z; o.w = b.y * rstd * gg.w + bb.w; *(float4*)(out + (size_t)tok * 2048 + c) = o; }
}

#define FP4_LOW 3
template <bool VLAY> DEV void f6_row(const float* __restrict__ src, unsigned char* __restrict__ dst, unsigned char* __restrict__ dst4, float* __restrict__ rs, int row, int lane) {
    const float4* sp = (const float4*)(src + (size_t)row * 2048 + 32 * lane); float4 v[8]; float m = 0.f;
#pragma unroll
    for (int j = 0; j < 8; ++j) { v[j] = sp[j]; m = fmaxf(fmaxf(m, fmaxf(fabsf(v[j].x), fabsf(v[j].y))), fmaxf(fabsf(v[j].z), fabsf(v[j].w))); }
    m = wave_max(m); const float inv = m > 0.f ? 7.5f / m : 0.f;
    unsigned q[32];
#define F6_CODE(xv) ({ const float x_ = (xv); const float a_ = fabsf(x_) * inv; const float t_ = fminf(fminf(8.f * a_, 4.f * a_ + 8.f), 2.f * a_ + 16.f); \
        (__float_as_uint(t_ + 8388608.f) & 31u) | ((__float_as_uint(x_) >> 26) & 32u); })
#pragma unroll
    for (int j = 0; j < 8; ++j) { q[4 * j] = F6_CODE(v[j].x); q[4 * j + 1] = F6_CODE(v[j].y); q[4 * j + 2] = F6_CODE(v[j].z); q[4 * j + 3] = F6_CODE(v[j].w); }
#undef F6_CODE
    unsigned w6[6];
#pragma unroll
    for (int t = 0; t < 2; ++t) { const unsigned* p = q + 16 * t;
        w6[3 * t] = p[0] | (p[1] << 6) | (p[2] << 12) | (p[3] << 18) | (p[4] << 24) | (p[5] << 30);
        w6[3 * t + 1] = (p[5] >> 2) | (p[6] << 4) | (p[7] << 10) | (p[8] << 16) | (p[9] << 22) | (p[10] << 28);
        w6[3 * t + 2] = (p[10] >> 4) | (p[11] << 2) | (p[12] << 8) | (p[13] << 14) | (p[14] << 20) | (p[15] << 26); }
    unsigned char* rp = dst + (size_t)row * 1536;
    if (VLAY) { rp += 384 * (lane >> 4); *(u32x4_*)(rp + 16 * (lane & 15)) = (u32x4_){w6[0], w6[1], w6[2], w6[3]}; *(u32x2_*)(rp + 256 + 8 * (lane & 15)) = (u32x2_){w6[4], w6[5]}; }
    else { *(u32x4_*)(rp + 16 * lane) = (u32x4_){w6[0], w6[1], w6[2], w6[3]}; *(u32x2_*)(rp + 1024 + 8 * lane) = (u32x2_){w6[4], w6[5]}; }
    if (lane == 0) rs[row] = m * (1.f / 7.5f);
#if FP4_LOW
    { const float inv4 = m > 0.f ? 6.f / m : 0.f; unsigned w4[4];
#pragma unroll
      for (int j = 0; j < 4; ++j) { unsigned w = 0u;
          w = __builtin_amdgcn_cvt_scalef32_pk_fp4_f32(w, v[2 * j].x * inv4, v[2 * j].y * inv4, 1.0f, 0); w = __builtin_amdgcn_cvt_scalef32_pk_fp4_f32(w, v[2 * j].z * inv4, v[2 * j].w * inv4, 1.0f, 1);
          w = __builtin_amdgcn_cvt_scalef32_pk_fp4_f32(w, v[2 * j + 1].x * inv4, v[2 * j + 1].y * inv4, 1.0f, 2); w = __builtin_amdgcn_cvt_scalef32_pk_fp4_f32(w, v[2 * j + 1].z * inv4, v[2 * j + 1].w * inv4, 1.0f, 3); w4[j] = w; }
      *(u32x4_*)(dst4 + (size_t)row * 1024 + 16 * lane) = (u32x4_){w4[0], w4[1], w4[2], w4[3]};
      if (lane == 0) rs[PNK * PNK + row] = m * (1.f / 6.f); }
#endif
}
DEV void f4_row(const float* __restrict__ src, unsigned char* __restrict__ dst4, float* __restrict__ rs, int row, int lane) {
    const float4* sp = (const float4*)(src + (size_t)row * 2048 + 32 * lane); float4 v[8]; float q = 0.f;
#pragma unroll
    for (int j = 0; j < 8; ++j) { v[j] = sp[j]; q += (v[j].x * v[j].x + v[j].y * v[j].y) + (v[j].z * v[j].z + v[j].w * v[j].w); }
    const float rms = sqrtf(wave_sum(q) * (1.f / 2048.f)); const float inv4 = rms > 0.f ? 2.f / rms : 0.f; unsigned w4[4];
#pragma unroll
    for (int j = 0; j < 4; ++j) { unsigned w = 0u;
        w = __builtin_amdgcn_cvt_scalef32_pk_fp4_f32(w, v[2 * j].x * inv4, v[2 * j].y * inv4, 1.0f, 0); w = __builtin_amdgcn_cvt_scalef32_pk_fp4_f32(w, v[2 * j].z * inv4, v[2 * j].w * inv4, 1.0f, 1);
        w = __builtin_amdgcn_cvt_scalef32_pk_fp4_f32(w, v[2 * j + 1].x * inv4, v[2 * j + 1].y * inv4, 1.0f, 2); w = __builtin_amdgcn_cvt_scalef32_pk_fp4_f32(w, v[2 * j + 1].z * inv4, v[2 * j + 1].w * inv4, 1.0f, 3); w4[j] = w; }
    *(u32x4_*)(dst4 + (size_t)row * 1024 + 16 * lane) = (u32x4_){w4[0], w4[1], w4[2], w4[3]};
    if (lane == 0) rs[PNK * PNK + row] = rms * 0.5f;
}
struct R6_ { u32x4_ a; u32x2_ b; };
typedef int i32x8g_ __attribute__((ext_vector_type(8)));
#define M6_MFMA(a, b, c, sa) __builtin_amdgcn_mfma_scale_f32_16x16x128_f8f6f4(a, b, c, 2, 2, 0, sa, 0, 127)
#define M4_MFMA(a, b, c, sa) __builtin_amdgcn_mfma_scale_f32_16x16x128_f8f6f4(a, b, c, 2, 4, 0, sa, 0, 127)
#define M6_B(r) ((i32x8g_){(int)(r).a[0], (int)(r).a[1], (int)(r).a[2], (int)(r).a[3], (int)(r).b[0], (int)(r).b[1], 0, 0})
#define M4_B(r) ((i32x8g_){(int)(r).a[0], (int)(r).a[1], (int)(r).a[2], (int)(r).a[3], 0, 0, 0, 0})
#define M6_ISSUE_U(grp) do { _Pragma("unroll") for (int e_ = 0; e_ < 8; ++e_) { const int ee_ = 8 * (grp) + e_; const int id_ = __builtin_amdgcn_readlane(ee_ < 64 ? id0 : id1, ee_ & 63); \
        const unsigned char* up_ = U6 + (size_t)id_ * 1536; ub[e_].a = *(const u32x4_*)(up_ + 16 * lane); ub[e_].b = *(const u32x2_*)(up_ + 1024 + 8 * lane); } } while (0)
#define M6_ISSUE_V(grp) do { _Pragma("unroll") for (int q_ = 0; q_ < 2; ++q_) { const int idv_ = __shfl((grp) < 8 ? id0 : id1, (8 * (grp) + 4 * q_ + kg) & 63); \
        const unsigned char* vp_ = V6 + (unsigned)(idv_ * 1536 + n16); const unsigned char* vq_ = V6 + (unsigned)(idv_ * 1536 + 256 + n8); \
        _Pragma("unroll") for (int t_ = 0; t_ < 4; ++t_) { vb[q_][t_].a = *(const u32x4_*)(vp_ + 384 * t_); vb[q_][t_].b = *(const u32x2_*)(vq_ + 384 * t_); } } } while (0)
#define M4_ISSUE_U(grp) do { _Pragma("unroll") for (int e_ = 0; e_ < 8; ++e_) { const int ee_ = 8 * (grp) + e_; const int id_ = __builtin_amdgcn_readlane(ee_ < 64 ? id0 : id1, ee_ & 63); \
        ub[e_].a = *(const u32x4_*)(U4 + (size_t)id_ * 1024 + 16 * lane); } } while (0)
#define M4_ISSUE_V(grp) do { _Pragma("unroll") for (int q_ = 0; q_ < 2; ++q_) { const int idv_ = __shfl((grp) < 8 ? id0 : id1, (8 * (grp) + 4 * q_ + kg) & 63); \
        const unsigned char* vp_ = V4 + (unsigned)(idv_ * 1024 + n16); \
        _Pragma("unroll") for (int t_ = 0; t_ < 4; ++t_) vb[q_][t_].a = *(const u32x4_*)(vp_ + 256 * t_); } } while (0)
#define MQ_ISSUE_U(grp) do { _Pragma("unroll") for (int e_ = 0; e_ < 8; ++e_) { const int ee_ = 8 * (grp) + e_; const int id_ = __builtin_amdgcn_readlane(ee_ < 64 ? id0 : id1, ee_ & 63); \
        if (e_ < 4) { const unsigned char* up_ = U6 + (size_t)id_ * 1536; ub[e_].a = *(const u32x4_*)(up_ + 16 * lane); ub[e_].b = *(const u32x2_*)(up_ + 1024 + 8 * lane); } \
        else ub[e_].a = *(const u32x4_*)(U4 + (size_t)id_ * 1024 + 16 * lane); } } while (0)
#define MQ_ISSUE_V(grp) do { { const int idv_ = __shfl((grp) < 8 ? id0 : id1, (8 * (grp) + kg) & 63); \
        const unsigned char* vp_ = V6 + (unsigned)(idv_ * 1536 + n16); const unsigned char* vq_ = V6 + (unsigned)(idv_ * 1536 + 256 + n8); \
        _Pragma("unroll") for (int t_ = 0; t_ < 4; ++t_) { vb[0][t_].a = *(const u32x4_*)(vp_ + 384 * t_); vb[0][t_].b = *(const u32x2_*)(vq_ + 384 * t_); } } \
      { const int idv_ = __shfl((grp) < 8 ? id0 : id1, (8 * (grp) + 4 + kg) & 63); const unsigned char* vp_ = V4 + (unsigned)(idv_ * 1024 + n16); \
        _Pragma("unroll") for (int t_ = 0; t_ < 4; ++t_) vb[1][t_].a = *(const u32x4_*)(vp_ + 256 * t_); } } while (0)
#define MQ_U(e_) ((e_) < 4 ? M6_MFMA(xa, M6_B(ub[e_]), zero4, xsb) : M4_MFMA(xa, M4_B(ub[e_]), zero4, xsb))
#define MQ_V(q_, A_, t_, c_, s_) ((q_) == 0 ? M6_MFMA(A_, M6_B(vb[q_][t_]), c_, s_) : M4_MFMA(A_, M4_B(vb[q_][t_]), c_, s_))
#define M6_U(e_) M6_MFMA(xa, M6_B(ub[e_]), zero4, xsb)
#define M4_U(e_) M4_MFMA(xa, M4_B(ub[e_]), zero4, xsb)
#define M6_V(q_, A_, t_, c_, s_) M6_MFMA(A_, M6_B(vb[q_][t_]), c_, s_)
#define M4_V(q_, A_, t_, c_, s_) M4_MFMA(A_, M4_B(vb[q_][t_]), c_, s_)
#define MX_GROUP(grp, UOP, VOP, NEXT_U, NEXT_V) do { float a_[8]; \
        _Pragma("unroll") for (int e_ = 0; e_ < 8; ++e_) { const f32x4_ c_ = UOP(e_); \
            const float t0_ = lb0 ? c_[1] : c_[0], t1_ = lb0 ? c_[3] : c_[2]; const float s_ = lb1 ? t1_ : t0_; a_[e_] = dg ? s_ : 0.f; } \
        NEXT_U; \
        const int ow_ = (8 * (grp) + (lane >> 3)) & 63; const float su_ = __shfl((grp) < 8 ? su0 : su1, ow_), sv_ = __shfl((grp) < 8 ? sv0 : sv1, ow_); \
        const float h0_ = P6_SW32(a_[0], a_[4]), h1_ = P6_SW32(a_[1], a_[5]), h2_ = P6_SW32(a_[2], a_[6]), h3_ = P6_SW32(a_[3], a_[7]); \
        const float r0_ = P6_SW16(h0_, h2_), r1_ = P6_SW16(h1_, h3_); \
        const bool hi8_ = (lane & 8) != 0; const float keep_ = hi8_ ? r1_ : r0_, send_ = hi8_ ? r0_ : r1_; \
        float kk_ = keep_ + P6_DPP(send_, 0x128); \
        kk_ += P6_DPP(kk_, 0xB1); kk_ += P6_DPP(kk_, 0x4E); kk_ += P6_DPP(kk_, 0x141); \
        const float hid_ = su_ * kk_; const float wv_ = sv_ * (0.5f * hid_ * (1.f + erff(hid_ * 0.70710678f))); \
        _Pragma("unroll") for (int q_ = 0; q_ < 2; ++q_) { const float wq_ = __shfl(wv_, 32 * q_ + 8 * kg); \
            const unsigned wb_ = __float_as_uint(wq_), wr_ = wb_ + 0x00080000u; const int wsb_ = (int)((wr_ >> 23) & 255u); \
            const unsigned cd_ = 8u | ((wr_ >> 20) & 7u) | ((wb_ >> 26) & 32u); const unsigned lo_ = cd_ << wsh, hi_ = (cd_ >> 1) >> (31 - wsh); \
            const int a0_ = (int)(wrl == 0 ? lo_ : 0u), a1_ = (int)(wrl == 1 ? lo_ : (wrl == 0 ? hi_ : 0u)), a2_ = (int)(wrl == 2 ? lo_ : (wrl == 1 ? hi_ : 0u)); \
            const i32x8g_ A0_ = {a0_, a1_, a2_, 0, 0, 0, 0, 0}, A1_ = {0, 0, 0, a0_, a1_, a2_, 0, 0}; \
            _Pragma("unroll") for (int t_ = 0; t_ < 4; ++t_) { acc[t_][0] = VOP(q_, A0_, t_, acc[t_][0], wsb_); acc[t_][1] = VOP(q_, A1_, t_, acc[t_][1], wsb_); } } \
        NEXT_V; } while (0)
DEV void peer_gather_tokm(const bf16* __restrict__ H1, int id0, int id1, float gp0, float gp1, const unsigned char* __restrict__ U6, const unsigned char* __restrict__ V6,
                          const unsigned char* __restrict__ U4, const unsigned char* __restrict__ V4, const float* __restrict__ RSU, const float* __restrict__ RSV,
                          const bf16* __restrict__ PLEB, const float* lg, const float* lb, float* __restrict__ out, int tok, int lane) {
    const int kg = lane >> 4, n16 = (lane & 15) * 16, n8 = (lane & 15) * 8, r4 = (lane & 15) >> 2, wsh = (6 * (lane & 15)) & 31, wrl = (6 * (lane & 15)) >> 5;
    const bool lb0 = (lane & 1) != 0, lb1 = (lane & 2) != 0, dg = kg == r4;
    i32x8g_ xa; int xsb;
    { float xf[32]; float m = 0.f;
#pragma unroll
      for (int u = 0; u < 4; ++u) { const uint4 w = *(const uint4*)(H1 + (size_t)tok * 2048 + 32 * lane + 8 * u); const unsigned q[4] = {w.x, w.y, w.z, w.w};
#pragma unroll
          for (int k = 0; k < 4; ++k) { xf[8 * u + 2 * k] = __uint_as_float(q[k] << 16); xf[8 * u + 2 * k + 1] = __uint_as_float(q[k] & 0xffff0000u); m = fmaxf(m, fmaxf(fabsf(xf[8 * u + 2 * k]), fabsf(xf[8 * u + 2 * k + 1]))); } }
      const unsigned eb = (__float_as_uint(m * 1.0666667f) >> 23) & 255u; const bool ok = eb >= 3u;
      xsb = ok ? (int)eb - 2 : 0; const float inv = ok ? __uint_as_float((256u - eb) << 23) : 0.f;
      unsigned p[32];
#pragma unroll
      for (int i = 0; i < 32; ++i) { const float a = fabsf(xf[i]) * inv; const float t = fminf(fminf(8.f * a, 4.f * a + 8.f), 2.f * a + 16.f); p[i] = (__float_as_uint(t + 8388608.f) & 31u) | ((__float_as_uint(xf[i]) >> 26) & 32u); }
      unsigned w6[6];
#pragma unroll
      for (int t = 0; t < 2; ++t) { const unsigned* c = p + 16 * t;
          w6[3 * t] = c[0] | (c[1] << 6) | (c[2] << 12) | (c[3] << 18) | (c[4] << 24) | (c[5] << 30);
          w6[3 * t + 1] = (c[5] >> 2) | (c[6] << 4) | (c[7] << 10) | (c[8] << 16) | (c[9] << 22) | (c[10] << 28);
          w6[3 * t + 2] = (c[10] >> 4) | (c[11] << 2) | (c[12] << 8) | (c[13] << 14) | (c[14] << 20) | (c[15] << 26); }
      xa = (i32x8g_){(int)w6[0], (int)w6[1], (int)w6[2], (int)w6[3], (int)w6[4], (int)w6[5], 0, 0}; }
    const f32x4_ zero4 = {0.f, 0.f, 0.f, 0.f};
    f32x4_ acc[4][2];
#pragma unroll
    for (int t = 0; t < 4; ++t) { acc[t][0] = zero4; acc[t][1] = zero4; }
    const int so = (FP4_LOW == 1 && (lane & 8)) || (FP4_LOW == 2 && (lane & 12)) || FP4_LOW == 3 ? PNK * PNK : 0;
    const float su0 = RSU[id0 + so], su1 = RSU[id1 + so], sv0 = RSV[id0 + so] * gp0, sv1 = RSV[id1 + so] * gp1;
    R6_ ub[8], vb[2][4];
#if FP4_LOW == 1
    M6_ISSUE_U(0); M6_ISSUE_V(0);
    for (int g = 0; g < 14; g += 2) { MX_GROUP(g, M6_U, M6_V, M4_ISSUE_U(g + 1), M4_ISSUE_V(g + 1)); MX_GROUP(g + 1, M4_U, M4_V, M6_ISSUE_U(g + 2), M6_ISSUE_V(g + 2)); }
    MX_GROUP(14, M6_U, M6_V, M4_ISSUE_U(15), M4_ISSUE_V(15)); MX_GROUP(15, M4_U, M4_V, (void)0, (void)0);
#elif FP4_LOW == 2
    MQ_ISSUE_U(0); MQ_ISSUE_V(0);
    for (int g = 0; g < 14; g += 2) { MX_GROUP(g, MQ_U, MQ_V, M4_ISSUE_U(g + 1), M4_ISSUE_V(g + 1)); MX_GROUP(g + 1, M4_U, M4_V, MQ_ISSUE_U(g + 2), MQ_ISSUE_V(g + 2)); }
    MX_GROUP(14, MQ_U, MQ_V, M4_ISSUE_U(15), M4_ISSUE_V(15)); MX_GROUP(15, M4_U, M4_V, (void)0, (void)0);
#elif FP4_LOW == 3
    M4_ISSUE_U(0); M4_ISSUE_V(0);
    for (int g = 0; g < 14; ++g) MX_GROUP(g, M4_U, M4_V, M4_ISSUE_U(g + 1), M4_ISSUE_V(g + 1));
    MX_GROUP(14, M4_U, M4_V, M4_ISSUE_U(15), M4_ISSUE_V(15)); MX_GROUP(15, M4_U, M4_V, (void)0, (void)0);
#else
    M6_ISSUE_U(0); M6_ISSUE_V(0);
    for (int g = 0; g < 15; ++g) MX_GROUP(g, M6_U, M6_V, M6_ISSUE_U(g + 1), M6_ISSUE_V(g + 1));
    MX_GROUP(15, M6_U, M6_V, (void)0, (void)0);
#endif
    asm volatile("" : "+s"(lg), "+s"(lb));
    const int dl = 32 * (lane & 15) + 4 * kg; float s = 0.f;
#pragma unroll
    for (int t = 0; t < 4; ++t)
#pragma unroll
        for (int h = 0; h < 2; ++h) { const size_t o = (size_t)tok * 2048 + 512 * t + 16 * h + dl; const u32x2_ hw = *(const u32x2_*)(H1 + o), pw = *(const u32x2_*)(PLEB + o);
            f32x4_ y = acc[t][h];
            y[0] += __uint_as_float(hw.x << 16) * ALPHA + __uint_as_float(pw.x << 16); y[1] += __uint_as_float(hw.x & 0xffff0000u) * ALPHA + __uint_as_float(pw.x & 0xffff0000u);
            y[2] += __uint_as_float(hw.y << 16) * ALPHA + __uint_as_float(pw.y << 16); y[3] += __uint_as_float(hw.y & 0xffff0000u) * ALPHA + __uint_as_float(pw.y & 0xffff0000u);
            acc[t][h] = y; s += (y[0] + y[1]) + (y[2] + y[3]); }
    const float mean = wave_sum(s) * (1.f / D); float q = 0.f;
#pragma unroll
    for (int t = 0; t < 4; ++t)
#pragma unroll
        for (int h = 0; h < 2; ++h) { acc[t][h] -= mean; const f32x4_ y = acc[t][h]; q += (y[0] * y[0] + y[1] * y[1]) + (y[2] * y[2] + y[3] * y[3]); }
    const float rstd = rsqrtf(wave_sum(q) * (1.f / D) + LN_EPS);
#pragma unroll
    for (int t = 0; t < 4; ++t)
#pragma unroll
        for (int h = 0; h < 2; ++h) { const int c = 512 * t + 16 * h + dl; const f32x4_ gg = *(const f32x4_*)(lg + c), bb = *(const f32x4_*)(lb + c);
            __builtin_nontemporal_store(acc[t][h] * rstd * gg + bb, (f32x4_*)(out + (size_t)tok * 2048 + c)); }
}

constexpr int PS_ROW = 528, PS_IDS = 256 * PS_ROW, PS_GT = PS_IDS + 8192;
#define TOPK_INSERT(tv, ti, xv, xi) do { if ((xv) > tv[15]) { tv[15] = (xv); ti[15] = (xi); \
        _Pragma("unroll") for (int k_ = 15; k_ > 0; --k_) { const bool sw_ = tv[k_] > tv[k_ - 1]; const float fa_ = tv[k_ - 1], fb_ = tv[k_]; const int ia_ = ti[k_ - 1], ib_ = ti[k_]; \
            tv[k_ - 1] = sw_ ? fb_ : fa_; tv[k_] = sw_ ? fa_ : fb_; ti[k_ - 1] = sw_ ? ib_ : ia_; ti[k_] = sw_ ? ia_ : ib_; } } } while (0)
template <bool DESC> DEV void sort16(unsigned (&a)[16]) {
#pragma unroll
    for (int k = 2; k <= 16; k <<= 1)
#pragma unroll
        for (int j = k >> 1; j > 0; j >>= 1)
#pragma unroll
            for (int i = 0; i < 16; ++i) { const int l = i ^ j; if (l > i) { const bool up = ((i & k) == 0) != DESC; const unsigned lo = a[i] < a[l] ? a[i] : a[l], hi = a[i] < a[l] ? a[l] : a[i]; a[i] = up ? lo : hi; a[l] = up ? hi : lo; } }
}
DEV void merge16(unsigned (&top)[16], const unsigned (&asc)[16]) {
#pragma unroll
    for (int i = 0; i < 16; ++i) top[i] = top[i] > asc[i] ? top[i] : asc[i];
#pragma unroll
    for (int j = 8; j > 0; j >>= 1)
#pragma unroll
        for (int i = 0; i < 16; ++i) if ((i & j) == 0) { const unsigned hi = top[i] > top[i + j] ? top[i] : top[i + j], lo = top[i] > top[i + j] ? top[i + j] : top[i]; top[i] = hi; top[i + j] = lo; }
}
DEV void peer_tile(LASF unsigned char* lds, const bf16* __restrict__ QP, const bf16* __restrict__ KEYS, const bf16* __restrict__ H1, const unsigned char* __restrict__ U8, const unsigned char* __restrict__ V8, const unsigned char* __restrict__ U4, const unsigned char* __restrict__ V4,
                   const float* __restrict__ RSU, const float* __restrict__ RSV, const bf16* __restrict__ PLEB, const float* __restrict__ lg, const float* __restrict__ lb, float* __restrict__ out, int tile, int tid) {
    const int lane = tid & 63, wave = __builtin_amdgcn_readfirstlane(tid >> 6), fr = lane & 15, g = lane >> 4, tok0 = tile * 16;
    LASF float* SC = (LASF float*)lds; LASF int* LID = (LASF int*)(lds + PS_IDS); LASF float* LGT = (LASF float*)(lds + PS_GT);
#pragma unroll
    for (int half = 0; half < 2; ++half) {
        bf16x8_ qa[4];
#pragma unroll
        for (int ks = 0; ks < 4; ++ks) qa[ks] = *(const bf16x8_*)(QP + (size_t)(tok0 + fr) * 2048 + wave * 256 + half * 128 + 32 * ks + 8 * g);
        const bf16* kb = KEYS + ((size_t)(wave * 2 + half) * 128 + fr) * 128 + 8 * g;
#pragma unroll
        for (int nt = 0; nt < 8; ++nt) { f32x4_ acc = {0.f, 0.f, 0.f, 0.f};
#pragma unroll
            for (int ks = 0; ks < 4; ++ks) acc = __builtin_amdgcn_mfma_f32_16x16x32_bf16(qa[ks], *(const bf16x8_*)(kb + (size_t)nt * 16 * 128 + 32 * ks), acc, 0, 0, 0);
#pragma unroll
            for (int r = 0; r < 4; ++r) SC[((wave * 2 + half) * 16 + 4 * g + r) * (PS_ROW / 4) + 16 * nt + fr] = acc[r]; } }
    __syncthreads();
#define KEY_OF(f, low, mask) ({ const unsigned u_ = __float_as_uint(f); ((u_ ^ ((unsigned)((int)u_ >> 31) | 0x80000000u)) & ~(mask)) | (low); })
#define VAL_OF(kk, mask) ({ const unsigned k_ = (kk) & ~(mask); __uint_as_float(k_ ^ ((k_ >> 31) ? 0x80000000u : 0xffffffffu)); })
#define KEY_INSERT(tk, key) do { if ((key) > tk[15]) { const unsigned ky_ = (key); \
        _Pragma("unroll") for (int k_ = 15; k_ > 0; --k_) { const unsigned m_ = tk[k_] > ky_ ? tk[k_] : ky_; tk[k_] = tk[k_ - 1] < m_ ? tk[k_ - 1] : m_; } \
        tk[0] = tk[0] > ky_ ? tk[0] : ky_; } } while (0)
    { LASF float* row = SC + (tid & 255) * (PS_ROW / 4); const int hf = tid >> 8; unsigned tk[16];
#pragma unroll 1
        for (int b4 = 0; b4 < 4; ++b4) { const int bt = 4 * hf + b4; unsigned nk[16];
#pragma unroll
            for (int c4 = 0; c4 < 4; ++c4) { const f32x4_ v = *(const LASF f32x4_*)(row + 16 * bt + 4 * c4);
#pragma unroll
                for (int j = 0; j < 4; ++j) nk[4 * c4 + j] = KEY_OF(v[j], (unsigned)(127 - (16 * bt + 4 * c4 + j)), 127u); }
            if (b4 == 0) { sort16<true>(nk);
#pragma unroll
                for (int k = 0; k < 16; ++k) tk[k] = nk[k]; }
            else { sort16<false>(nk); merge16(tk, nk); } }
        if (hf == 1) {
#pragma unroll
            for (int k = 0; k < 16; ++k) ((LASF unsigned*)row)[64 + k] = tk[15 - k]; }
        __syncthreads();
        if (hf == 0) { unsigned asc[16];
#pragma unroll
            for (int k4 = 0; k4 < 4; ++k4) { const u32x4_ a4 = *(const LASF u32x4_*)((LASF unsigned*)row + 64 + 4 * k4); asc[4 * k4] = a4[0]; asc[4 * k4 + 1] = a4[1]; asc[4 * k4 + 2] = a4[2]; asc[4 * k4 + 3] = a4[3]; }
            merge16(tk, asc);
#pragma unroll
            for (int k = 0; k < 16; ++k) { row[k] = VAL_OF(tk[k], 127u); ((LASF int*)row)[16 + k] = 127 - (int)(tk[k] & 127u); } } }
    __syncthreads();
    if (tid < 128) { int tc_ = tid; asm volatile("" : "+v"(tc_));
        const int tk_ = tc_ & 15, hh = tc_ >> 4; const LASF float* ra = SC + ((hh * 2) * 16 + tk_) * (PS_ROW / 4); const LASF float* rb = SC + ((hh * 2 + 1) * 16 + tk_) * (PS_ROW / 4);
        unsigned tk[16], cd[64]; float fa[16], fb[16];
#pragma unroll
        for (int k4 = 0; k4 < 4; ++k4) { const f32x4_ va = *(const LASF f32x4_*)(ra + 4 * k4), vb_ = *(const LASF f32x4_*)(rb + 4 * k4);
#pragma unroll
            for (int r = 0; r < 4; ++r) { fa[4 * k4 + r] = va[r]; fb[4 * k4 + r] = vb_[r]; } }
        { int c = 0;
#pragma unroll
          for (int i = 0; i < 16; ++i)
#pragma unroll
              for (int j = 0; j < 16; ++j) if ((i + 1) * (j + 1) <= 16) { cd[c] = KEY_OF(fa[i] + fb[j], (unsigned)(255 - (16 * i + j)), 255u); ++c; }
#pragma unroll
          for (int k = 50; k < 64; ++k) cd[k] = 0u; }
#pragma unroll
        for (int bt = 0; bt < 4; ++bt) { unsigned nk[16];
#pragma unroll
            for (int k = 0; k < 16; ++k) nk[k] = cd[16 * bt + k];
            if (bt == 0) { sort16<true>(nk);
#pragma unroll
                for (int k = 0; k < 16; ++k) tk[k] = nk[k]; }
            else { sort16<false>(nk); merge16(tk, nk); } }
        float tv[16]; const float mx = VAL_OF(tk[0], 255u); float sum = 0.f;
#pragma unroll
        for (int k = 0; k < 16; ++k) { tv[k] = __expf(VAL_OF(tk[k], 255u) - mx); sum += tv[k]; }
        const float inv = 1.f / sum;
#pragma unroll
        for (int k = 0; k < 16; ++k) { const int slot = 255 - (int)(tk[k] & 255u); LID[tk_ * 128 + hh * 16 + k] = ((const LASF int*)ra)[16 + (slot >> 4)] * 128 + ((const LASF int*)rb)[16 + (slot & 15)]; LGT[tk_ * 128 + hh * 16 + k] = tv[k] * inv; } }
    __syncthreads();
#undef KEY_OF
#undef VAL_OF
#undef KEY_INSERT
#pragma unroll 1
    for (int u = 0; u < 2; ++u) { const int tl = 2 * wave + u;
        peer_gather_tokm(H1, LID[tl * 128 + lane], LID[tl * 128 + 64 + lane], LGT[tl * 128 + lane], LGT[tl * 128 + 64 + lane], U8, V8, U4, V4, RSU, RSV, PLEB, lg, lb, out, tok0 + tl, lane); }
    __syncthreads();
}

namespace pg8 {
#define PG8_LAS __attribute__((address_space(3)))
typedef unsigned short bf16_t;
typedef short bf16x8 __attribute__((ext_vector_type(8)));
typedef float f32x4 __attribute__((ext_vector_type(4)));
typedef unsigned u32x4 __attribute__((ext_vector_type(4)));
constexpr int BM = 256, BK = 64, HALF = 128, HTB = HALF * BK * 2  , STAGE_BYTES = 8 * HTB, NXCD = 8, WGM = 8;
__host__ __device__ __forceinline__ int lds_byte(int r, int c) { const int st = (r >> 4) * 2 + (c >> 5), rr = r & 15, cc = c & 31, ob = rr * 64 + cc * 2; return st * 1024 + (ob ^ (((ob >> 9) & 1) << 5)); }
__host__ __device__ __forceinline__ void stage_rc(int b, int& R, int& C) { const int st = b / 1024, sb = b % 1024, swz = sb ^ (((sb >> 9) & 1) << 5); R = (st >> 1) * 16 + swz / 64; C = (st & 1) * 32 + (swz % 64) / 2; }
__host__ __device__ __forceinline__ int perm32(int rho) { const int n = rho >> 4, i = rho & 15; return 8 * (i >> 2) + 4 * n + (i & 3); }
struct Unit { int pm, pn, which; };
struct Gemm { const bf16_t* A; const bf16_t* Bt; const bf16_t* A2; const bf16_t* Bt2; int K; };

struct StaticOrder {
    int nM, nN, nwg, G, c;
    __host__ __device__ void init(int M, int N, int G_, int c_) { nM = M / BM; nN = N / BM; nwg = nM * nN; G = G_; c = c_; }
    __host__ __device__ bool next(int i, Unit& u) const {
        const long L = (long)i * G + c; if (L >= nwg) return false;
        int wgid = (int)L; { const int q = nwg / NXCD, r = nwg % NXCD, xcd = wgid % NXCD, off = wgid / NXCD; wgid = (xcd < r ? xcd * (q + 1) : r * (q + 1) + (xcd - r) * q) + off; }
        const int nig = WGM * nN, gid = wgid / nig, fm = gid * WGM, gsz = (nM - fm) < WGM ? (nM - fm) : WGM;
        u.pm = fm + ((wgid % nig) % gsz); u.pn = (wgid % nig) / gsz; return true;
    }
    __device__ __forceinline__ void a_ready(const Unit&) const {}
    __device__ __forceinline__ void done(const Unit&) const {}
};
typedef __bf16 bf16x2_t __attribute__((ext_vector_type(2)));
typedef float f32x2_t __attribute__((ext_vector_type(2)));
__device__ __forceinline__ unsigned cvt_pk_bf16(float lo, float hi) { const f32x2_t v = {lo, hi}; return __builtin_bit_cast(unsigned, __builtin_convertvector(v, bf16x2_t)); }
typedef float f32x2 __attribute__((ext_vector_type(2)));
__device__ __forceinline__ f32x2 gelu_pk(f32x2 v) {
    const f32x2 av = __builtin_elementwise_abs(v), d = av * 0.2316418882f + 1.0f;
    f32x2 t; t.x = __builtin_amdgcn_rcpf(d.x); t.y = __builtin_amdgcn_rcpf(d.y);
    f32x2 q = t * 0.5307027145f + (-0.7265760135f); q = q * t + 0.7107068705f; q = q * t + (-0.142248368f); q = q * t + 0.127414796f; q = q * t;
    const f32x2 s = (v * v) * (-0.72134752044f);
    f32x2 e; e.x = __builtin_amdgcn_exp2f(s.x); e.y = __builtin_amdgcn_exp2f(s.y);
    const f32x2 m = v * (q * e), r = v - m;
    f32x2 o; o.x = v.x < 0.f ? m.x : r.x; o.y = v.y < 0.f ? m.y : r.y; return o;
}


struct Order2 {
    int nM0, nN0, n0, nM1, nN1, n1, G, c;
    __device__ __forceinline__ void init(int M0, int N0, int M1, int N1_, int G_, int c_) { nM0 = M0 / BM; nN0 = N0 / BM; n0 = nM0 * nN0; nM1 = M1 / BM; nN1 = N1_ / BM; n1 = nM1 * nN1; G = G_; c = c_; }
    static __device__ __forceinline__ void map(int wgid, int nwg, int nM, int nN, Unit& u) {
        { const int q = nwg / NXCD, r = nwg % NXCD, xcd = wgid % NXCD, off = wgid / NXCD; wgid = (xcd < r ? xcd * (q + 1) : r * (q + 1) + (xcd - r) * q) + off; }
        const int nig = WGM * nN, gid = wgid / nig, fm = gid * WGM, gsz = (nM - fm) < WGM ? (nM - fm) : WGM;
        u.pm = fm + ((wgid % nig) % gsz); u.pn = (wgid % nig) / gsz; }
    __device__ __forceinline__ bool next(int i, Unit& u) const {
        int L = i * G + c;
        if (L < n0) { map(L, n0, nM0, nN0, u); u.which = 0; return true; }
        L -= n0; if (L < n1) { map(L, n1, nM1, nN1, u); u.which = 1; return true; }
        return false; }
    __device__ __forceinline__ void a_ready(const Unit&) const {}
    __device__ __forceinline__ void done(const Unit&) const {}
};
__device__ __forceinline__ void st8bf(bf16_t* p, f32x4 v0, f32x4 v1) { u32x4 w; w.x = cvt_pk_bf16(v0[0], v0[1]); w.y = cvt_pk_bf16(v0[2], v0[3]); w.z = cvt_pk_bf16(v1[0], v1[1]); w.w = cvt_pk_bf16(v1[2], v1[3]); *(u32x4*)p = w; }
__device__ __forceinline__ void st8f8(unsigned char* p, f32x4 v0, f32x4 v1) { int a = 0, b = 0; a = __builtin_amdgcn_cvt_pk_fp8_f32(v0[0], v0[1], a, false); a = __builtin_amdgcn_cvt_pk_fp8_f32(v0[2], v0[3], a, true);
    b = __builtin_amdgcn_cvt_pk_fp8_f32(v1[0], v1[1], b, false); b = __builtin_amdgcn_cvt_pk_fp8_f32(v1[2], v1[3], b, true); typedef int i32x2_ __attribute__((ext_vector_type(2))); *(i32x2_*)p = (i32x2_){a, b}; }
__device__ __forceinline__ void ld8bf(const bf16_t* p, f32x4& v0, f32x4& v1) { const u32x4 w = *(const u32x4*)p;
    v0[0] = __uint_as_float(w.x << 16); v0[1] = __uint_as_float(w.x & 0xffff0000u); v0[2] = __uint_as_float(w.y << 16); v0[3] = __uint_as_float(w.y & 0xffff0000u);
    v1[0] = __uint_as_float(w.z << 16); v1[1] = __uint_as_float(w.z & 0xffff0000u); v1[2] = __uint_as_float(w.w << 16); v1[3] = __uint_as_float(w.w & 0xffff0000u); }
__device__ __forceinline__ void ld8bf_nt(const bf16_t* p, f32x4& v0, f32x4& v1) { const u32x4 w = __builtin_nontemporal_load((const u32x4*)p);
    v0[0] = __uint_as_float(w.x << 16); v0[1] = __uint_as_float(w.x & 0xffff0000u); v0[2] = __uint_as_float(w.y << 16); v0[3] = __uint_as_float(w.y & 0xffff0000u);
    v1[0] = __uint_as_float(w.z << 16); v1[1] = __uint_as_float(w.z & 0xffff0000u); v1[2] = __uint_as_float(w.w << 16); v1[3] = __uint_as_float(w.w & 0xffff0000u); }
__device__ __forceinline__ f32x4 sig4(f32x4 v) { f32x4 r; r[0] = sigmoidf_(v[0]); r[1] = sigmoidf_(v[1]); r[2] = sigmoidf_(v[2]); r[3] = sigmoidf_(v[3]); return r; }
template <int KIND> struct Epi {
    static constexpr bool PERM = true, AFTER_DRAIN = false;
    EpiArgs e;
    __device__ __forceinline__ void operator()(const f32x4 (&acc)[2][2][4][2], const Unit& u, int wr, int wc, int fr, int fq) const {
        const int row0 = u.pm * BM + wr * 64 + fr, colu = u.pn * BM + wc * 32 + 8 * fq;
        if (KIND == EK_MAIN && u.which == 1) {
#pragma unroll
            for (int ai = 0; ai < 2; ++ai)
#pragma unroll
                for (int m = 0; m < 4; ++m) { const int row = row0 + ai * HALF + m * 16; const float bv = e.bias2[row];
#pragma unroll
                    for (int bj = 0; bj < 2; ++bj) st8bf(e.o5 + (size_t)row * T + colu + bj * HALF, acc[ai][bj][m][0] + bv, acc[ai][bj][m][1] + bv); }
            return; }
        bf16_t* ob = e.o0; int ldc = 2048, c0 = colu, mode = 0; float sc = 1.f;
        if (KIND == EK_MAIN) { const int pn = u.pn, cw = wc * 32 + 8 * fq;
            if (pn < 8) { ob = e.o0; c0 = pn * 256 + cw; sc = pn < 4 ? 0.125f : 1.f; }
            else if (pn < 16) { ob = e.o1; c0 = (pn - 8) * 256 + cw; sc = pn < 12 ? 0.0625f : 1.f; }
            else if (pn < 24) { ob = e.o2; c0 = (pn - 16) * 256 + cw; mode = 1; }
            else if (pn < 40) { ob = e.o3; c0 = (pn - 24) * 256 + cw; ldc = 4096; mode = 2; }
            else { ob = e.o4; c0 = cw; ldc = 256; } }
        if (KIND == EK_2) { if (e.qonly) { ob = e.o1; mode = 1; } else if (u.pn >= 8) { ob = e.o1; c0 = colu - 2048; mode = 1; } }
        if (KIND == EK_MAIN) {
#pragma unroll
            for (int bj = 0; bj < 2; ++bj) { const float* bp_ = e.bias + colu + bj * HALF; asm volatile("" : "+v"(bp_)); const f32x4 bs0 = *(const f32x4*)bp_, bs1 = *(const f32x4*)(bp_ + 4); const int cc = c0 + bj * HALF;
#pragma unroll
                for (int ai = 0; ai < 2; ++ai)
#pragma unroll
                    for (int m = 0; m < 4; ++m) { const int row = row0 + ai * HALF + m * 16; f32x4 v0 = acc[ai][bj][m][0] + bs0, v1 = acc[ai][bj][m][1] + bs1;
                        if (mode == 0) { v0 *= sc; v1 *= sc; } else if (mode == 1) { v0 *= sig4(v0); v1 *= sig4(v1); } else { v0 = sig4(v0); v1 = sig4(v1); }
                        st8bf(ob + (size_t)row * ldc + cc, v0, v1); } }
            return; }
#pragma unroll
        for (int ai = 0; ai < 2; ++ai)
#pragma unroll
            for (int m = 0; m < 4; ++m) { const int row = row0 + ai * HALF + m * 16;
#pragma unroll
                for (int bj = 0; bj < 2; ++bj) { f32x4 v0 = acc[ai][bj][m][0], v1 = acc[ai][bj][m][1]; const int cc = c0 + bj * HALF;
                    if (KIND == EK_MAIN) { const float* bp_ = e.bias + colu + bj * HALF; asm volatile("" : "+v"(bp_));
                        v0 += *(const f32x4*)bp_; v1 += *(const f32x4*)(bp_ + 4);
                        if (mode == 0) { v0 *= sc; v1 *= sc; } else if (mode == 1) { v0 *= sig4(v0); v1 *= sig4(v1); } else { v0 = sig4(v0); v1 = sig4(v1); }
                        st8bf(ob + (size_t)row * ldc + cc, v0, v1); }
                    else if (KIND == EK_A) { f32x4 g0, g1; ld8bf_nt(e.a0 + (size_t)row * 4096 + cc, g0, g1); st8bf(ob + (size_t)row * 2048 + cc, g0 * v0, g1 * v1); }
                    else if (KIND == EK_B) { f32x4 g0, g1, t0, t1; ld8bf_nt(e.a0 + (size_t)row * 4096 + 2048 + cc, g0, g1); ld8bf_nt(e.a1 + (size_t)row * 2048 + cc, t0, t1); st8f8((unsigned char*)ob + (size_t)row * 2048 + cc, t0 + g0 * v0, t1 + g1 * v1); }
                    else if (KIND == EK_OUT) { f32x4 h0, h1; ld8bf(e.a0 + (size_t)row * 2048 + cc, h0, h1); float* op = e.of + (size_t)row * 2048 + cc; *(f32x4*)op = h0 * ALPHA + v0; *(f32x4*)(op + 4) = h1 * ALPHA + v1; }
                    else if (KIND == EK_PLE) { st8bf(ob + (size_t)row * 2048 + cc, v0, v1); }
                    else if (KIND == EK_2) { if (mode == 0) { f32x4 p0, p1; ld8bf_nt(e.a0 + (size_t)row * 2048 + cc, p0, p1); st8bf(ob + (size_t)row * 2048 + cc, p0 * sig4(v0), p1 * sig4(v1)); } else st8bf(ob + (size_t)row * 2048 + cc, v0, v1); }
                } }
    }
};

struct EpiLnOut {
    static constexpr bool PERM = true, AFTER_DRAIN = true;
    const bf16_t* h0; const float* lng; const float* lnb; bf16_t* h1; unsigned char* h1f8; unsigned long long* xbuf; unsigned* cnt; unsigned* tmo;
    __device__ __forceinline__ void operator()(const f32x4 (&)[2][2][4][2], const Unit&, int, int, int, int) const {}
    __device__ __forceinline__ void fused(f32x4 (&acc)[2][2][4][2], const Unit& u, int wr, int wc, int fr, int fq, PG8_LAS unsigned char* lds, int wid, int lane) const {
        typedef float f32x2v __attribute__((ext_vector_type(2)));
        PG8_LAS f32x2v* P = (PG8_LAS f32x2v*)lds; PG8_LAS f32x2v* S = (PG8_LAS f32x2v*)(lds + 8192);
        const int row0 = u.pm * BM + wr * 64 + fr, colu = u.pn * BM + wc * 32 + 8 * fq, tid = wid * 64 + lane;
#define LNO_BAR() do { asm volatile("s_waitcnt lgkmcnt(0)" ::: "memory"); __builtin_amdgcn_s_barrier(); asm volatile("" ::: "memory"); } while (0)
#pragma unroll
        for (int ai = 0; ai < 2; ++ai)
#pragma unroll
            for (int m = 0; m < 4; ++m) { const int row = row0 + ai * HALF + m * 16; float s1 = 0.f, s2 = 0.f;
#pragma unroll
                for (int bj = 0; bj < 2; ++bj) { f32x4 ha, hb; ld8bf_nt(h0 + (size_t)row * 2048 + colu + bj * HALF, ha, hb);
                    const f32x4 v0 = acc[ai][bj][m][0] + ha * ALPHA, v1 = acc[ai][bj][m][1] + hb * ALPHA; acc[ai][bj][m][0] = v0; acc[ai][bj][m][1] = v1;
                    s1 += (v0[0] + v0[1]) + (v0[2] + v0[3]) + (v1[0] + v1[1]) + (v1[2] + v1[3]); s2 += (v0[0] * v0[0] + v0[1] * v0[1]) + (v0[2] * v0[2] + v0[3] * v0[3]) + (v1[0] * v1[0] + v1[1] * v1[1]) + (v1[2] * v1[2] + v1[3] * v1[3]); }
                s1 += __shfl_xor(s1, 16); s1 += __shfl_xor(s1, 32); s2 += __shfl_xor(s2, 16); s2 += __shfl_xor(s2, 32);
                if (fq == 0) P[(ai * HALF + wr * 64 + m * 16 + fr) * 4 + wc] = (f32x2v){s1, s2}; }
        LNO_BAR();
        if (tid < 256) { const f32x2v a = P[tid * 4], b = P[tid * 4 + 1], c = P[tid * 4 + 2], d = P[tid * 4 + 3]; const float t1 = (a.x + b.x) + (c.x + d.x), t2 = (a.y + b.y) + (c.y + d.y);
            __hip_atomic_store(xbuf + ((size_t)(u.pm * BM + tid) * 8 + u.pn), ((unsigned long long)__float_as_uint(t2) << 32) | __float_as_uint(t1), __ATOMIC_RELAXED, __HIP_MEMORY_SCOPE_AGENT); }
        asm volatile("s_waitcnt vmcnt(0)" ::: "memory");
        LNO_BAR();
        if (tid == 0) { __hip_atomic_fetch_add(cnt + 64 * u.pm, 1u, __ATOMIC_RELAXED, __HIP_MEMORY_SCOPE_AGENT);
            unsigned sp = 0; while (__hip_atomic_load(cnt + 64 * u.pm, __ATOMIC_RELAXED, __HIP_MEMORY_SCOPE_AGENT) < 8u) { __builtin_amdgcn_s_sleep(1);
                if ((++sp & 255u) == 0u) { if (__hip_atomic_load(tmo, __ATOMIC_RELAXED, __HIP_MEMORY_SCOPE_AGENT)) break; if (sp > (1u << 18)) { atomicAdd(tmo, 1u); break; } } }
            __builtin_amdgcn_fence(__ATOMIC_ACQUIRE, "agent"); asm volatile("s_waitcnt vmcnt(0)" ::: "memory"); }
        LNO_BAR();
        if (tid < 256) { float t1 = 0.f, t2 = 0.f;
#pragma unroll
            for (int t = 0; t < 8; ++t) { const unsigned long long w = __hip_atomic_load(xbuf + ((size_t)(u.pm * BM + tid) * 8 + t), __ATOMIC_RELAXED, __HIP_MEMORY_SCOPE_AGENT); t1 += __uint_as_float((unsigned)w); t2 += __uint_as_float((unsigned)(w >> 32)); }
            const float mean = t1 * (1.f / 2048.f), var = fmaxf(t2 * (1.f / 2048.f) - mean * mean, 0.f); S[tid] = (f32x2v){mean, rsqrtf(var + LN_EPS)}; }
        LNO_BAR();
#pragma unroll
        for (int ai = 0; ai < 2; ++ai)
#pragma unroll
            for (int m = 0; m < 4; ++m) { const int rl = ai * HALF + wr * 64 + m * 16 + fr, row = u.pm * BM + rl; const f32x2v ms = S[rl];
#pragma unroll
                for (int bj = 0; bj < 2; ++bj) { const int cc = colu + bj * HALF; const f32x4 g0 = *(const f32x4*)(lng + cc), g1 = *(const f32x4*)(lng + cc + 4), b0 = *(const f32x4*)(lnb + cc), b1 = *(const f32x4*)(lnb + cc + 4);
                    const f32x4 y0 = (acc[ai][bj][m][0] - ms.x) * ms.y * g0 + b0, y1 = (acc[ai][bj][m][1] - ms.x) * ms.y * g1 + b1;
                    st8bf(h1 + (size_t)row * 2048 + cc, y0, y1); st8f8(h1f8 + (size_t)row * 2048 + cc, y0, y1); } }
#undef LNO_BAR
    }
};
typedef int i32x8_ __attribute__((ext_vector_type(8)));
template <class Epi, class Sched, bool ALIGN_EPI = false, bool SP2 = false, bool F8 = false>
__device__ __forceinline__ void gemm_phase(PG8_LAS unsigned char* lds, const Gemm g, const Sched& S, const Epi& E) {
    const int tid = threadIdx.x, wid = __builtin_amdgcn_readfirstlane(tid >> 6), lane = tid & 63, wr = wid >> 2, wc = wid & 3, fr = lane & 15, fq = lane >> 4;
    const int K = g.K, nt = K / BK;
    unsigned voffA[2], voffB[2];
#pragma unroll
    for (int i = 0; i < 2; ++i) { int R, C; stage_rc(tid * 16 + i * 8192, R, C); const int Rb = Epi::PERM ? ((R & ~31) + perm32(R & 31)) : R;
        voffA[i] = (unsigned)(R * K + C) * 2u; voffB[i] = (unsigned)(Rb * K + C) * 2u; }
    const size_t kstep = (size_t)(BK * 2);
    const size_t hstep = (size_t)HALF * K * 2;
    const size_t tstep = 2 * hstep;
    const unsigned ldsw = (unsigned)wid * 1024u;
    const int aoff = lds_byte(wr * 64 + fr, fq * 8), boff = lds_byte(wc * 32 + fr, fq * 8);
#define PG8_SA(b, h) (((b) * 2 + (h)) * HTB)
#define PG8_SB(b, h) ((4 + (b) * 2 + (h)) * HTB)
#define PG8_STAGE(bufoff, gbase, voff) do { _Pragma("unroll") for (int _i = 0; _i < 2; ++_i) \
        __builtin_amdgcn_global_load_lds((const unsigned*)((const char*)(gbase) + (voff)[_i]), (PG8_LAS unsigned*)(lds + (bufoff) + ldsw + _i * 8192), 16, 0, 0); } while (0)
#define PG8_LDA(dst, b, h) do { _Pragma("unroll") for (int m = 0; m < 4; ++m) { if constexpr (F8) { const u32x4 l_ = *(const PG8_LAS u32x4*)(lds + PG8_SA(b, h) + aoff + m * 2048), h_ = *(const PG8_LAS u32x4*)(lds + PG8_SA(b, h) + aoff + m * 2048 + 1024); dst##8[m] = __builtin_shufflevector(l_, h_, 0, 1, 2, 3, 4, 5, 6, 7); } \
        else { _Pragma("unroll") for (int k = 0; k < 2; ++k) dst[m][k] = *(const PG8_LAS bf16x8*)(lds + PG8_SA(b, h) + aoff + m * 2048 + k * 1024); } } } while (0)
#define PG8_LDB(dst, b, h) do { _Pragma("unroll") for (int n = 0; n < 2; ++n) { if constexpr (F8) { const u32x4 l_ = *(const PG8_LAS u32x4*)(lds + PG8_SB(b, h) + boff + n * 2048), h_ = *(const PG8_LAS u32x4*)(lds + PG8_SB(b, h) + boff + n * 2048 + 1024); dst##8[n] = __builtin_shufflevector(l_, h_, 0, 1, 2, 3, 4, 5, 6, 7); } \
        else { _Pragma("unroll") for (int k = 0; k < 2; ++k) dst[n][k] = *(const PG8_LAS bf16x8*)(lds + PG8_SB(b, h) + boff + n * 2048 + k * 1024); } } } while (0)
#define PG8_MMA(ai, bj, At, Bt) do { __builtin_amdgcn_s_setprio(1); _Pragma("unroll") for (int m = 0; m < 4; ++m) _Pragma("unroll") for (int n = 0; n < 2; ++n) { \
        if constexpr (F8) asm volatile("v_mfma_scale_f32_16x16x128_f8f6f4 %0, %1, %2, %0, %3, %4 op_sel_hi:[0,0,0]" : "+v"(acc[ai][bj][m][n]) : "v"(Bt##8[n]), "v"(At##8[m]), "v"(sclB), "v"(sclA)); \
        else { _Pragma("unroll") for (int k = 0; k < 2; ++k) acc[ai][bj][m][n] = __builtin_amdgcn_mfma_f32_16x16x32_bf16(Bt[n][k], At[m][k], acc[ai][bj][m][n], 0, 0, 0); } } __builtin_amdgcn_s_setprio(0); } while (0)
#define PG8_WAIT_V(n) asm volatile("s_waitcnt vmcnt(" #n ")" ::: "memory")
#define PG8_WAIT_L(n) asm volatile("s_waitcnt lgkmcnt(" #n ")" ::: "memory")
#define PG8_BAR __builtin_amdgcn_s_barrier()
#define PG8_SCHED __builtin_amdgcn_sched_barrier(0)
    Unit cur, nxt; int ui = 0;
    if (!S.next(0, cur)) return;
    f32x4 acc[2][2][4][2];
#pragma unroll
    for (int a = 0; a < 2; ++a)
#pragma unroll
        for (int b = 0; b < 2; ++b)
#pragma unroll
            for (int m = 0; m < 4; ++m)
#pragma unroll
                for (int n = 0; n < 2; ++n) acc[a][b][m][n] = (f32x4){0.f, 0.f, 0.f, 0.f};
    int sclB = 0x79797979, sclA = 0x7f7f7f7f; asm volatile("" : "+v"(sclB), "+v"(sclA));
    bf16x8 At[4][2], B0[2][2], B1[2][2]; typedef unsigned u32x8 __attribute__((ext_vector_type(8))); u32x8 At8[4], B08[2], B18[2]; (void)At; (void)B0; (void)B1; (void)At8; (void)B08; (void)B18;
    const char* cA = (const char*)(cur.which ? g.A2 : g.A) + (size_t)cur.pm * tstep; const char* cB = (const char*)(cur.which ? g.Bt2 : g.Bt) + (size_t)cur.pn * tstep;
    S.a_ready(cur);
    if constexpr (SP2) {
        PG8_STAGE(PG8_SB(0, 0), cB, voffB); PG8_STAGE(PG8_SB(0, 1), cB + hstep, voffB); PG8_STAGE(PG8_SA(0, 0), cA, voffA); PG8_STAGE(PG8_SA(0, 1), cA + hstep, voffA);
        if (wr == 1) PG8_BAR;
        PG8_WAIT_V(2); PG8_BAR;
        PG8_STAGE(PG8_SB(1, 0), cB + kstep, voffB); PG8_STAGE(PG8_SA(1, 0), cA + kstep, voffA); PG8_STAGE(PG8_SB(1, 1), cB + hstep + kstep, voffB);
        PG8_WAIT_V(6); PG8_BAR;
    } else {
        PG8_STAGE(PG8_SB(0, 0), cB, voffB); PG8_STAGE(PG8_SA(0, 0), cA, voffA); PG8_STAGE(PG8_SB(0, 1), cB + hstep, voffB); PG8_STAGE(PG8_SA(0, 1), cA + hstep, voffA);
        if (wr == 1) PG8_BAR;
        PG8_WAIT_V(4); PG8_BAR;
        PG8_STAGE(PG8_SB(1, 0), cB + kstep, voffB); PG8_STAGE(PG8_SA(1, 0), cA + kstep, voffA); PG8_STAGE(PG8_SB(1, 1), cB + hstep + kstep, voffB);
        PG8_WAIT_V(6); PG8_BAR;
    }
    for (;;) {
        const bool has_next = S.next(ui + 1, nxt);
        const char* nA = has_next ? (const char*)(nxt.which ? g.A2 : g.A) + (size_t)nxt.pm * tstep : cA; const char* nB = has_next ? (const char*)(nxt.which ? g.Bt2 : g.Bt) + (size_t)nxt.pn * tstep : cB;
        for (int t = 0; t < nt; t += 2) {
            const bool last = (t == nt - 2);
            const char* a1 = cA + (size_t)(t + 1) * kstep;
            const char* a2 = last ? nA : cA + (size_t)(t + 2) * kstep; const char* b2 = last ? nB : cB + (size_t)(t + 2) * kstep;
            const char* a3 = a2 + kstep; const char* b3 = b2 + kstep;
            if (last && has_next) S.a_ready(nxt);
            if constexpr (SP2) {
            PG8_LDB(B0, 0, 0); PG8_LDB(B1, 0, 1); PG8_SCHED; PG8_LDA(At, 0, 0); PG8_STAGE(PG8_SA(1, 1), a1 + hstep, voffA);
            PG8_WAIT_V(8); PG8_WAIT_L(0); PG8_BAR; PG8_MMA(0, 0, At, B0); PG8_MMA(0, 1, At, B1); PG8_BAR; PG8_SCHED;
            PG8_LDA(At, 0, 1); PG8_STAGE(PG8_SB(0, 0), b2, voffB); PG8_STAGE(PG8_SB(0, 1), b2 + hstep, voffB); PG8_STAGE(PG8_SA(0, 0), a2, voffA);
            PG8_WAIT_V(8); PG8_WAIT_L(0); PG8_BAR; PG8_MMA(1, 0, At, B0); PG8_MMA(1, 1, At, B1); PG8_BAR; PG8_SCHED;
            PG8_LDB(B0, 1, 0); PG8_LDB(B1, 1, 1); PG8_SCHED; PG8_LDA(At, 1, 0); PG8_STAGE(PG8_SA(0, 1), a2 + hstep, voffA);
            PG8_WAIT_V(8); PG8_WAIT_L(0); PG8_BAR; PG8_MMA(0, 0, At, B0); PG8_MMA(0, 1, At, B1); PG8_BAR; PG8_SCHED;
            PG8_LDA(At, 1, 1); PG8_STAGE(PG8_SB(1, 0), b3, voffB); PG8_STAGE(PG8_SB(1, 1), b3 + hstep, voffB); PG8_STAGE(PG8_SA(1, 0), a3, voffA);
            PG8_WAIT_V(8); PG8_WAIT_L(0); PG8_BAR; PG8_MMA(1, 0, At, B0); PG8_MMA(1, 1, At, B1); PG8_BAR; PG8_SCHED;
            } else {
            PG8_LDB(B0, 0, 0); PG8_SCHED; PG8_LDA(At, 0, 0); PG8_STAGE(PG8_SA(1, 1), a1 + hstep, voffA);
            PG8_WAIT_L(8); PG8_BAR; PG8_WAIT_L(0); PG8_MMA(0, 0, At, B0); PG8_BAR; PG8_SCHED;
            PG8_LDB(B1, 0, 1); PG8_STAGE(PG8_SB(0, 0), b2, voffB);
            PG8_BAR; PG8_WAIT_L(0); PG8_MMA(0, 1, At, B1); PG8_BAR;
            PG8_LDA(At, 0, 1); PG8_STAGE(PG8_SA(0, 0), a2, voffA);
            PG8_BAR; PG8_WAIT_L(0); PG8_MMA(1, 0, At, B0); PG8_BAR; PG8_SCHED;
            PG8_STAGE(PG8_SB(0, 1), b2 + hstep, voffB);
            PG8_WAIT_V(6); PG8_BAR; PG8_MMA(1, 1, At, B1); PG8_BAR;
            PG8_LDB(B0, 1, 0); PG8_SCHED; PG8_LDA(At, 1, 0); PG8_STAGE(PG8_SA(0, 1), a2 + hstep, voffA);
            PG8_WAIT_L(8); PG8_BAR; PG8_WAIT_L(0); PG8_MMA(0, 0, At, B0); PG8_BAR; PG8_SCHED;
            PG8_LDB(B1, 1, 1); PG8_STAGE(PG8_SB(1, 0), b3, voffB);
            PG8_BAR; PG8_WAIT_L(0); PG8_MMA(0, 1, At, B1); PG8_BAR;
            PG8_LDA(At, 1, 1); PG8_STAGE(PG8_SA(1, 0), a3, voffA);
            PG8_BAR; PG8_WAIT_L(0); PG8_MMA(1, 0, At, B0); PG8_BAR; PG8_SCHED;
            PG8_STAGE(PG8_SB(1, 1), b3 + hstep, voffB);
            PG8_WAIT_V(6); PG8_BAR; PG8_MMA(1, 1, At, B1); PG8_BAR;
            }
        }
        if constexpr (F8) asm volatile("s_nop 15\n\ts_nop 15" ::: "memory");
        if constexpr (ALIGN_EPI) { if (wr == 0) PG8_BAR; }
        if constexpr (!Epi::AFTER_DRAIN) { E(acc, cur, wr, wc, fr, fq); S.done(cur); }
        if (!has_next) break;
#pragma unroll
        for (int a = 0; a < 2; ++a)
#pragma unroll
            for (int b = 0; b < 2; ++b)
#pragma unroll
                for (int m = 0; m < 4; ++m)
#pragma unroll
                    for (int n = 0; n < 2; ++n) acc[a][b][m][n] = (f32x4){0.f, 0.f, 0.f, 0.f};
        cur = nxt; cA = nA; cB = nB; ++ui;
        if constexpr (ALIGN_EPI) { if (wr == 1) PG8_BAR; }
    }
    PG8_WAIT_V(0);
    if constexpr (!ALIGN_EPI) { if (wr == 0) PG8_BAR; }
    PG8_BAR;
    if constexpr (Epi::AFTER_DRAIN) { E.fused(acc, cur, wr, wc, fr, fq, lds, wid, lane); S.done(cur); }
#undef PG8_SA
#undef PG8_SB
#undef PG8_STAGE
#undef PG8_LDA
#undef PG8_LDB
#undef PG8_MMA
#undef PG8_WAIT_V
#undef PG8_WAIT_L
#undef PG8_BAR
#undef PG8_SCHED
}
}

constexpr int NWAVES = 8;
constexpr int RING_BYTES = 131072, LDSCTL_OFF = 256 * 528 + 16384, MISC_OFF = LDSCTL_OFF + 320, LDS_BYTES = LDSCTL_OFF + 1024;
#define GAS __attribute__((address_space(1)))
#define LAS __attribute__((address_space(3)))
typedef GAS unsigned gu32;
constexpr int CW_TMO = 0, CW_CODE = 1, CW_BAR = 4096;
#define XB_TMO      128
#define XB_XCNT(j)  (256  + 64 * (j))
#define XB_XSUB(j)  (1280 + 64 * (j))
#define XB_XGEN(j)  (2304 + 64 * (j))
#define XB_TOP      3328
#define XB_TOPGEN   3392
#define XCD_BAR_WORDS 3456
#define XB_SPIN_CAP (1u << 18)

__device__ __forceinline__ unsigned xb_ld(unsigned* p)              { return __hip_atomic_load(p, __ATOMIC_RELAXED, __HIP_MEMORY_SCOPE_AGENT); }
__device__ __forceinline__ unsigned xb_add(unsigned* p, unsigned v) { return __hip_atomic_fetch_add(p, v, __ATOMIC_RELAXED, __HIP_MEMORY_SCOPE_AGENT); }
__device__ __forceinline__ unsigned xb_xcc_id() { return (unsigned)__builtin_amdgcn_s_getreg((3 << 11) | 20) & 0xFu; }
#define XB_SPIN(cond, bar) do { unsigned _sp = 0; while (cond) { __builtin_amdgcn_s_sleep(1); \
    if ((++_sp & 255u) == 0u) { if (xb_ld(&(bar)[XB_TMO])) break; if (_sp > XB_SPIN_CAP) { atomicAdd(&(bar)[XB_TMO], 1u); break; } } } } while (0)

struct XcdBarrier {
    unsigned* bar; unsigned x;
    volatile LAS unsigned* st;
};

__device__ __forceinline__ XcdBarrier xcd_barrier_post(unsigned* bar, volatile LAS unsigned* st) {
    XcdBarrier b; b.bar = bar; b.x = xb_xcc_id(); b.st = st;
    if (threadIdx.x == 0) (void)xb_add(&bar[XB_XCNT(b.x)], 1u);
    return b;
}
__device__ __forceinline__ void xcd_barrier_complete(unsigned* bar, unsigned x, unsigned& nloc, unsigned& nx) {
    const unsigned G = gridDim.x * gridDim.y * gridDim.z;
    unsigned sum, cnt, mine, sp = 0u;
    for (;;) {
        sum = 0u; cnt = 0u; mine = 0u;
#pragma unroll
        for (unsigned j = 0; j < 16; ++j) { const unsigned c = xb_ld(&bar[XB_XCNT(j)]); sum += c; cnt += (c > 0u) ? 1u : 0u; mine = (j == x) ? c : mine; }
        if (sum == G) break;
        __builtin_amdgcn_s_sleep(1);
        if ((++sp & 255u) == 0u) { if (xb_ld(&bar[XB_TMO])) break; if (sp > XB_SPIN_CAP) { atomicAdd(&bar[XB_TMO], 1u); break; } }
    }
    nloc = mine > 0u ? mine : 1u; nx = cnt > 0u ? cnt : 1u;
}

__device__ __forceinline__ void xcd_barrier(const XcdBarrier& b) {
    asm volatile("s_waitcnt vmcnt(0)" ::: "memory");
    __syncthreads();
    if (threadIdx.x == 0) {
        unsigned* bar = b.bar;
        __builtin_amdgcn_s_waitcnt(0);
        unsigned nloc = b.st[0], nx = b.st[1];
        if (nloc == 0u) { xcd_barrier_complete(bar, b.x, nloc, nx); b.st[0] = nloc; b.st[1] = nx; }
        const unsigned old = xb_add(&bar[XB_XSUB(b.x)], 1u);
        const unsigned gen = old / nloc;
        if (old + 1u == (gen + 1u) * nloc) {
            __builtin_amdgcn_fence(__ATOMIC_RELEASE, "agent");
            asm volatile("s_waitcnt vmcnt(0)" ::: "memory");
            const unsigned og = xb_add(&bar[XB_TOP], 1u);
            const unsigned tg = og / nx;
            if (og + 1u == (tg + 1u) * nx) xb_add(&bar[XB_TOPGEN], 1u);
            else XB_SPIN(xb_ld(&bar[XB_TOPGEN]) == tg, bar);
            __builtin_amdgcn_fence(__ATOMIC_ACQUIRE, "agent");
            xb_add(&bar[XB_XGEN(b.x)], 1u);
            asm volatile("s_waitcnt vmcnt(0)" ::: "memory");
        } else {
            XB_SPIN(xb_ld(&bar[XB_XGEN(b.x)]) == gen, bar);
            __builtin_amdgcn_fence(__ATOMIC_ACQUIRE, "agent");
            asm volatile("s_waitcnt vmcnt(0)" ::: "memory");
        }
    }
    __syncthreads();
}

struct Args { const float* in[25]; float* out; unsigned char* ws; int ph_lo, ph_hi, li, flags; };
#ifndef PROBE_PHASE
#define PROBE_PHASE -1
#endif

DEV float4 ldnt4(const float* p) { const f32x4_ t = __builtin_nontemporal_load((const f32x4_*)p); return make_float4(t[0], t[1], t[2], t[3]); }
__device__ __forceinline__ void p0_transpose_item(const float* W, int ldw, int K, bf16* WT, LAS float* scr, int k0, int n0, int lane) {
#pragma unroll 8
    for (int i = 0; i < 32; ++i) { const int kk = 2 * i + (lane >> 5); scr[kk * 33 + (lane & 31)] = W[(size_t)(k0 + kk) * ldw + n0 + (lane & 31)]; }
    asm volatile("s_waitcnt lgkmcnt(0)" ::: "memory");
    const int c = lane & 7;
#pragma unroll
    for (int j = 0; j < 4; ++j) { const int n = (lane >> 3) + 8 * j; const LAS float* s = scr + (8 * c) * 33 + n;
        uint4 o; o.x = f2bf(s[0 * 33]) | ((unsigned)f2bf(s[1 * 33]) << 16); o.y = f2bf(s[2 * 33]) | ((unsigned)f2bf(s[3 * 33]) << 16); o.z = f2bf(s[4 * 33]) | ((unsigned)f2bf(s[5 * 33]) << 16); o.w = f2bf(s[6 * 33]) | ((unsigned)f2bf(s[7 * 33]) << 16);
        *(uint4*)(WT + (size_t)(n0 + n) * K + k0 + 8 * c) = o; }
    asm volatile("s_waitcnt lgkmcnt(0)" ::: "memory");
}
__device__ __forceinline__ void p0_transpose_item64(const float* W, int ldw, int K, bf16* WT, LAS unsigned char* scr, int k0, int n0, int lane) {
    const int q = lane >> 4, n4 = (lane & 15) * 4;
    float4 v[16];
#pragma unroll
    for (int i = 0; i < 16; ++i) v[i] = ldnt4(W + (size_t)(k0 + 8 * (i >> 1) + 2 * q + (i & 1)) * ldw + n0 + n4);
#pragma unroll
    for (int p = 0; p < 8; ++p) { const int kb = (8 * p + 2 * q) * 2;
        *(LAS unsigned*)(scr + (n4 + 0) * 144 + kb) = f2bf(v[2 * p].x) | ((unsigned)f2bf(v[2 * p + 1].x) << 16); *(LAS unsigned*)(scr + (n4 + 1) * 144 + kb) = f2bf(v[2 * p].y) | ((unsigned)f2bf(v[2 * p + 1].y) << 16);
        *(LAS unsigned*)(scr + (n4 + 2) * 144 + kb) = f2bf(v[2 * p].z) | ((unsigned)f2bf(v[2 * p + 1].z) << 16); *(LAS unsigned*)(scr + (n4 + 3) * 144 + kb) = f2bf(v[2 * p].w) | ((unsigned)f2bf(v[2 * p + 1].w) << 16); }
    asm volatile("s_waitcnt lgkmcnt(0)" ::: "memory");
    const int c = lane & 7;
#pragma unroll
    for (int jj = 0; jj < 8; ++jj) { const int n = (lane >> 3) + 8 * jj; const pg8::u32x4 o = *(const LAS pg8::u32x4*)(scr + n * 144 + c * 16); *(pg8::u32x4*)(WT + (size_t)(n0 + n) * K + k0 + 8 * c) = o; }
    asm volatile("s_waitcnt lgkmcnt(0)" ::: "memory");
}
__device__ __forceinline__ void p0_transpose_item64_f8(const float* W, int ldw, int K, unsigned char* WT8, LAS unsigned char* scr, int k0, int n0, int lane, float sc) {
    const int q = lane >> 4, n4 = (lane & 15) * 4;
    float4 v[16];
#pragma unroll
    for (int i = 0; i < 16; ++i) v[i] = ldnt4(W + (size_t)(k0 + 16 * (i >> 2) + 4 * q + (i & 3)) * ldw + n0 + n4);
#pragma unroll
    for (int p = 0; p < 4; ++p) { const int kb = 16 * p + 4 * q;
#define P0_PK4(comp) ({ int w_ = 0; w_ = __builtin_amdgcn_cvt_pk_fp8_f32(v[4 * p].comp * sc, v[4 * p + 1].comp * sc, w_, false); w_ = __builtin_amdgcn_cvt_pk_fp8_f32(v[4 * p + 2].comp * sc, v[4 * p + 3].comp * sc, w_, true); w_; })
        *(LAS int*)(scr + (n4 + 0) * 80 + kb) = P0_PK4(x); *(LAS int*)(scr + (n4 + 1) * 80 + kb) = P0_PK4(y); *(LAS int*)(scr + (n4 + 2) * 80 + kb) = P0_PK4(z); *(LAS int*)(scr + (n4 + 3) * 80 + kb) = P0_PK4(w);
#undef P0_PK4
    }
    asm volatile("s_waitcnt lgkmcnt(0)" ::: "memory");
    const int c = lane & 3;
#pragma unroll
    for (int jj = 0; jj < 4; ++jj) { const int n = (lane >> 2) + 16 * jj; const pg8::u32x4 o = *(const LAS pg8::u32x4*)(scr + n * 80 + c * 16); *(pg8::u32x4*)(WT8 + (size_t)(n0 + n) * K + k0 + 16 * c) = o; }
    asm volatile("s_waitcnt lgkmcnt(0)" ::: "memory");
}
__device__ __forceinline__ void ln_row_dev(const float* __restrict__ xrow, const float* __restrict__ g, const float* __restrict__ b, bf16* __restrict__ orow, int lane, unsigned char* __restrict__ o8 = nullptr) {
    const float4* xr = (const float4*)xrow + lane;
    float4 v[8]; float s = 0.f;
#pragma unroll
    for (int j = 0; j < 8; ++j) { v[j] = ldnt4((const float*)(xr + 64 * j)); s += (v[j].x + v[j].y) + (v[j].z + v[j].w); }
    const float mean = wave_sum(s) * (1.f / D); float q = 0.f;
#pragma unroll
    for (int j = 0; j < 8; ++j) { v[j].x -= mean; v[j].y -= mean; v[j].z -= mean; v[j].w -= mean; q += (v[j].x * v[j].x + v[j].y * v[j].y) + (v[j].z * v[j].z + v[j].w * v[j].w); }
    const float rstd = rsqrtf(wave_sum(q) * (1.f / D) + LN_EPS);
#pragma unroll
    for (int j = 0; j < 8; ++j) {
        const int c = 4 * lane + 256 * j; const float4 gg = *(const float4*)(g + c), bb = *(const float4*)(b + c);
        ushort4 o; o.x = f2bf(v[j].x * rstd * gg.x + bb.x); o.y = f2bf(v[j].y * rstd * gg.y + bb.y); o.z = f2bf(v[j].z * rstd * gg.z + bb.z); o.w = f2bf(v[j].w * rstd * gg.w + bb.w);
        *(ushort4*)(orow + c) = o;
        if (o8) { int w = 0; w = __builtin_amdgcn_cvt_pk_fp8_f32(v[j].x * rstd * gg.x + bb.x, v[j].y * rstd * gg.y + bb.y, w, false); w = __builtin_amdgcn_cvt_pk_fp8_f32(v[j].z * rstd * gg.z + bb.z, v[j].w * rstd * gg.w + bb.w, w, true); *(int*)(o8 + c) = w; } }
}

__global__ void __launch_bounds__(NWAVES * 64, 2) mk_fwd(Args args) {
    extern __shared__ __attribute__((aligned(16))) unsigned char lds_raw[];
    LAS unsigned char* lds = (LAS unsigned char*)lds_raw;
    volatile LAS unsigned* MISC = (volatile LAS unsigned*)(lds + MISC_OFF);
    const int tid = threadIdx.x, lane = tid & 63, wave = __builtin_amdgcn_readfirstlane(tid >> 6);
    const int G = gridDim.x, bx = blockIdx.x, vcu = (G % 8 == 0) ? (bx % 8) * (G / 8) + bx / 8 : bx;
    unsigned char* ws = args.ws; gu32* ctl = (gu32*)(ws + WS_CTL);
    for (int u = tid; u < (LDS_BYTES - LDSCTL_OFF) / 4; u += NWAVES * 64) ((LAS unsigned*)(lds + LDSCTL_OFF))[u] = 0u;
    __syncthreads();
    XcdBarrier bar = xcd_barrier_post((unsigned*)(ctl + CW_BAR) + args.li * XCD_BAR_WORDS, MISC + 8);
    const int lo = args.ph_lo, hi = args.ph_hi;
#define IN(k) (lo <= (k) && (k) < hi)
#define BOTH(k) (IN(k) && IN((k) + 1))
#define WSP(T_, off) ((T_*)(ws + (off)))
    bf16 *H0 = WSP(bf16, WS_H0), *W1T = WSP(bf16, WS_W1T), *WVT = WSP(bf16, WS_WVT), *WAT = WSP(bf16, WS_WAT), *WBT = WSP(bf16, WS_WBT), *WOT = WSP(bf16, WS_WOT), *W2T = WSP(bf16, WS_W2T),
         *WPT = WSP(bf16, WS_WPT), *PB = WSP(bf16, WS_PB), *KEYS = WSP(bf16, WS_KEYS), *NAQK = WSP(bf16, WS_NAQK), *GQK = WSP(bf16, WS_GQK),
         *GOUT = WSP(bf16, WS_GOUT), *GATES = WSP(bf16, WS_GATES), *LR = WSP(bf16, WS_LR), *VT = WSP(bf16, WS_VT);
    float *B1 = WSP(float, WS_B1), *BV = WSP(float, WS_BV);
    const int gw = vcu * NWAVES + wave, NGW = G * NWAVES;

    if (IN(0)) { for (int rep_ = 0; rep_ < (PROBE_PHASE == 0 ? 2 : 1); ++rep_) {
        const float* w_in = args.in[4];
        LAS float* scr = (LAS float*)(lds + wave * 16384);
        for (int m = gw; m < T; m += NGW) ln_row_dev(args.in[0] + (size_t)m * D, args.in[2], args.in[3], H0 + (size_t)m * D, lane, WSP(unsigned char, WS_H0F8) + (size_t)m * D);
        struct Seg { const float* W; bf16* WT; int ldw, col0, ncols, K, row0, pad; };
        LAS unsigned long long* segp = (LAS unsigned long long*)(lds + 8 * 16384); LAS int* segi = (LAS int*)(lds + 8 * 16384 + 512);
        if (tid < 16) { Seg sg{};
            switch (tid) {
                case 0: sg = Seg{w_in, W1T, IN_W, C_NAQ, 1024, D, 0, 0}; break; case 1: sg = Seg{w_in, W1T, IN_W, C_NAK, 1024, D, 1024, 0}; break;
                case 2: sg = Seg{w_in, W1T, IN_W, C_GQ, 1024, D, 2048, 0}; break; case 3: sg = Seg{w_in, W1T, IN_W, C_GK, 1024, D, 3072, 0}; break;
                case 4: sg = Seg{w_in, W1T, IN_W, C_GOUT, 2048, D, 4096, 0}; break; case 5: sg = Seg{w_in, W1T, IN_W, C_GA, 2048, D, 6144, 0}; break;
                case 6: sg = Seg{w_in, W1T, IN_W, C_GB, 2048, D, 8192, 0}; break; case 7: sg = Seg{w_in, W1T, IN_W, C_LRF, 32, D, 10240, 0}; break;
                case 8: sg = Seg{w_in, WVT, IN_W, C_NAV, 1024, D, 0, 0}; break; case 9: sg = Seg{w_in, WVT, IN_W, C_GV, 2048, D, 1024, 0}; break;
                case 10: sg = Seg{args.in[12], WAT, D, 0, D, NA_W, 0, 0}; break; case 11: sg = Seg{args.in[13], WBT, D, 0, D, GV, 0, 0}; break;
                case 12: sg = Seg{args.in[14], WOT, D, 0, D, D, 0, 0}; break; case 13: sg = Seg{args.in[22], W2T, D, 0, D, D, 0, 0}; break;
                case 14: sg = Seg{args.in[17], W2T, D, 0, D, D, 2048, 0}; break; default: sg = Seg{args.in[21], WPT, D, 0, D, PLE, 0, 0}; break; }
            segp[2 * tid] = (unsigned long long)sg.W; segp[2 * tid + 1] = (unsigned long long)sg.WT; segi[8 * tid] = sg.ldw; segi[8 * tid + 1] = sg.col0; segi[8 * tid + 2] = sg.ncols; segi[8 * tid + 3] = sg.K; segi[8 * tid + 4] = sg.row0; }
        __syncthreads();
        int base = 0;
        for (int sgi = 0; sgi < 16; ++sgi) { Seg sg; sg.W = (const float*)segp[2 * sgi]; sg.WT = (bf16*)segp[2 * sgi + 1]; sg.ldw = segi[8 * sgi]; sg.col0 = segi[8 * sgi + 1]; sg.ncols = segi[8 * sgi + 2]; sg.K = segi[8 * sgi + 3]; sg.row0 = segi[8 * sgi + 4]; const bool wide = (sg.ncols % 64) == 0; const int nblk = sg.ncols / (wide ? 64 : 32), nit = nblk * (sg.K / 64);
            int first = gw - (base % NGW); if (first < 0) first += NGW;
            for (int it = first; it < nit; it += NGW) { if (wide && sgi <= 13) p0_transpose_item64_f8(sg.W + sg.col0, sg.ldw, sg.K, (sgi < 8 ? WSP(unsigned char, WS_W1F8) : sgi < 10 ? WSP(unsigned char, WS_WVF8) : sgi == 10 ? WSP(unsigned char, WS_WAT) : sgi == 11 ? WSP(unsigned char, WS_WBT) : sgi == 12 ? WSP(unsigned char, WS_WOT) : WSP(unsigned char, WS_W2F8)) + (size_t)sg.row0 * sg.K, (LAS unsigned char*)scr, 64 * (it / nblk), 64 * (it % nblk), lane, 64.f);
                else if (wide) p0_transpose_item64(sg.W + sg.col0, sg.ldw, sg.K, sg.WT + (size_t)sg.row0 * sg.K, (LAS unsigned char*)scr, 64 * (it / nblk), 64 * (it % nblk), lane);
                else if (sgi != 7) p0_transpose_item(sg.W + sg.col0, sg.ldw, sg.K, sg.WT + (size_t)sg.row0 * sg.K, scr, 64 * (it / nblk), 32 * (it % nblk), lane); }
            base += nit; }
        const int gt = vcu * NWAVES * 64 + tid, NGT = G * NWAVES * 64;
        for (int i = gt; i < (N1 - 10272) * D / 16; i += NGT) ((uint4*)(WSP(unsigned char, WS_W1F8) + (size_t)10272 * D))[i] = make_uint4(0u, 0u, 0u, 0u);
        for (int i = gt; i < 32 * D / 4; i += NGT) { const int n = i / (D / 4), k4 = (i % (D / 4)) * 4; const float* wp = w_in + (size_t)k4 * IN_W + C_LRF + n;
            int w = 0; w = __builtin_amdgcn_cvt_pk_fp8_f32(wp[0] * 64.f, wp[IN_W] * 64.f, w, false); w = __builtin_amdgcn_cvt_pk_fp8_f32(wp[2 * (size_t)IN_W] * 64.f, wp[3 * (size_t)IN_W] * 64.f, w, true);
            *(int*)(WSP(unsigned char, WS_W1F8) + (size_t)(10240 + n) * D + k4) = w; }
        for (int i = gt; i < T * PLE / 4; i += NGT) { const float4 v = ldnt4(args.in[1] + 4 * (size_t)i); ushort4 o; o.x = f2bf(v.x); o.y = f2bf(v.y); o.z = f2bf(v.z); o.w = f2bf(v.w); ((ushort4*)PB)[i] = o; }
        for (int i = gt; i < PH * 2 * PNK * 128 / 4; i += NGT) { const float4 v = ((const float4*)args.in[18])[i]; ushort4 o; o.x = f2bf(v.x); o.y = f2bf(v.y); o.z = f2bf(v.z); o.w = f2bf(v.w); ((ushort4*)KEYS)[i] = o; }
        for (int i = gt; i < N1; i += NGT) { const int c = orig_col_main(i); B1[i] = c >= 0 ? args.in[5][c] : 0.f; }
        for (int i = gt; i < 3072; i += NGT) BV[i] = args.in[5][i < 1024 ? C_NAV + i : C_GV + (i - 1024)];
        if (PROBE_PHASE == 0) __syncthreads(); }
        if (BOTH(0)) xcd_barrier(bar);
    }
    if (IN(1)) { for (int rep_ = 0; rep_ < (PROBE_PHASE == 1 ? 2 : 1); ++rep_) {
        pg8::Gemm g{(const bf16*)WSP(unsigned char, WS_H0F8), (const bf16*)WSP(unsigned char, WS_W1F8), (const bf16*)WSP(unsigned char, WS_WVF8), (const bf16*)WSP(unsigned char, WS_H0F8), D / 2}; pg8::Order2 S; S.init(T, N1, 3072, T, G, bx);
        pg8::Epi<EK_MAIN> E; E.e = EpiArgs{}; E.e.bias = B1; E.e.bias2 = BV; E.e.o0 = NAQK; E.e.o1 = GQK; E.e.o2 = GOUT; E.e.o3 = GATES; E.e.o4 = LR; E.e.o5 = VT;
        pg8::gemm_phase<pg8::Epi<EK_MAIN>, pg8::Order2, true, true, true>(lds, g, S, E);
        { const int n1u = (T / 256) * (N1 / 256) + (3072 / 256) * (T / 256), rem = n1u % G;
          if (rem != 0 && bx >= rem) { int kple = PLE; asm volatile("" : "+s"(kple));
            pg8::Gemm g2{PB, WPT, PB, WPT, kple}; pg8::Order2 S2; S2.init(T, D, 0, 0, G - rem, bx - rem);
            pg8::Epi<EK_PLE> E2; E2.e = EpiArgs{}; E2.e.o0 = WSP(bf16, WS_PLELIN);
            pg8::gemm_phase<pg8::Epi<EK_PLE>, pg8::Order2, true, true>(lds, g2, S2, E2); } }
        if (PROBE_PHASE == 1) __syncthreads(); }
        if (BOTH(1)) xcd_barrier(bar);
    }
    bf16 *YNA = WSP(bf16, WS_YNA), *TMP = WSP(bf16, WS_TMP), *OG = WSP(bf16, WS_OG), *MERGED = WSP(bf16, WS_MERGED), *H1 = WSP(bf16, WS_H1), *PLELIN = WSP(bf16, WS_PLELIN), *PLEB = WSP(bf16, WS_PLEB), *QP = WSP(bf16, WS_QP);
    float* R1 = WSP(float, WS_R1);
    const bf16* OF = (args.flags & 1) ? WSP(bf16, WS_OF) : WSP(bf16, WS_NAQK); const bf16* OB = (args.flags & 1) ? WSP(bf16, WS_OB) : WSP(bf16, WS_GQK);
    float *AF = WSP(float, WS_AF), *AB = WSP(float, WS_AB), *GP = WSP(float, WS_GATEP); int* IDS = WSP(int, WS_IDS);
    const int gt_ = vcu * NWAVES * 64 + tid, NGT_ = G * NWAVES * 64;
    const QTab qt_{args.in[19], args.in[20], WSP(unsigned char, WS_U4), WSP(unsigned char, WS_V4), WSP(float, WS_RSU), WSP(float, WS_RSV), gw, NGW}; int qk_ = 0;
    if (IN(2)) { for (int rep_ = 0; rep_ < (PROBE_PHASE == 2 ? 2 : 1); ++rep_) {
        for (int rr_ = 0; rr_ < (PROBE_PHASE == 20 ? 2 : 1); ++rr_)
        for (int it = bx; it < BATCH * NA_H * (ROWS / 8); it += G) na_item(lds, NAQK, VT, args.in[6], YNA, it >> 6, (it >> 2) & 15, it & 3, tid, qt_, qk_);
        __syncthreads();
        for (int rr_ = 0; rr_ < (PROBE_PHASE == 21 ? 2 : 1); ++rr_)
        gla_pre_block(lds, GQK, LR, args.in[7], args.in[8], args.in[9], args.in[10], WSP(bf16, WS_QD), WSP(bf16, WS_KST), WSP(bf16, WS_ATT), WSP(float, WS_DEC), bx, G, tid);
        __syncthreads();
        if (PROBE_PHASE == 2) __syncthreads(); }
        if (BOTH(2)) xcd_barrier(bar);
    }
    if (IN(3)) { for (int rep_ = 0; rep_ < (PROBE_PHASE == 3 ? 2 : 1); ++rep_) {
        for (int rr_ = 0; rr_ < (PROBE_PHASE == 30 ? 2 : 1); ++rr_) {
        for (int it = bx; it < 256; it += G) { const int grp_ = (it & 7) * 4 + (it >> 6), sl = (it >> 3) & 7, dir = grp_ & 1, h = (grp_ >> 1) & 3, b = grp_ >> 3;
            gla_scan_item(lds, WSP(bf16, WS_QD) + (size_t)dir * T * 1024, WSP(bf16, WS_KST) + (size_t)dir * 512 * 256 * 64, WSP(bf16, WS_ATT) + (size_t)dir * 512 * 4096, WSP(float, WS_DEC) + (size_t)dir * 512 * 256,
                          VT, dir ? WSP(bf16, WS_GQK) : WSP(bf16, WS_NAQK), b, h, dir, sl, tid, qt_, qk_); }
        for (int r = gw + NGW * qk_; r < 2 * PNK * PNK; r += NGW) { if (r < PNK * PNK) f4_row(args.in[19], WSP(unsigned char, WS_U4), WSP(float, WS_RSU), r, lane); else f4_row(args.in[20], WSP(unsigned char, WS_V4), WSP(float, WS_RSV), r - PNK * PNK, lane); }
        }
        __syncthreads();
        pg8::Gemm g{YNA, WAT, YNA, WAT, NA_W / 2}; pg8::Order2 S; S.init(T, D, 0, 0, G, bx);
        pg8::Epi<EK_A> E; E.e = EpiArgs{}; E.e.o0 = TMP; E.e.a0 = GATES;
        pg8::gemm_phase<pg8::Epi<EK_A>, pg8::Order2, true, true, true>(lds, g, S, E);
        if (PROBE_PHASE == 3) __syncthreads(); }
        if (BOTH(3)) xcd_barrier(bar);
    }
    if (IN(4)) { for (int rep_ = 0; rep_ < (PROBE_PHASE == 4 ? 2 : 1); ++rep_) {
        const float* ng = args.in[11];
        const pg8::f32x4 n0 = *(const pg8::f32x4*)(ng + lane * 8), n1 = *(const pg8::f32x4*)(ng + lane * 8 + 4);
        for (int task = gw; task < T * GH; task += 2 * NGW) {
            const int task2 = task + NGW; const bool two = task2 < T * GH; const int tk2 = two ? task2 : task;
            const size_t base = (size_t)(task >> 2) * 2048 + (task & 3) * 512 + lane * 8, base2 = (size_t)(tk2 >> 2) * 2048 + (tk2 & 3) * 512 + lane * 8;
            pg8::f32x4 a0, a1, b0, b1, g0, g1, c0, c1, d0, d1, e0, e1;
            pg8::ld8bf_nt(OF + base, a0, a1); pg8::ld8bf_nt(OB + base, b0, b1); pg8::ld8bf_nt(GOUT + base, g0, g1); pg8::ld8bf_nt(OF + base2, c0, c1); pg8::ld8bf_nt(OB + base2, d0, d1); pg8::ld8bf_nt(GOUT + base2, e0, e1);
            a0 += b0; a1 += b1; c0 += d0; c1 += d1; const pg8::f32x4 q4 = a0 * a0 + a1 * a1, q5 = c0 * c0 + c1 * c1;
            const float r = rsqrtf(wave_sum((q4[0] + q4[1]) + (q4[2] + q4[3])) * (1.f / 512.f) + LN_EPS), r2 = rsqrtf(wave_sum((q5[0] + q5[1]) + (q5[2] + q5[3])) * (1.f / 512.f) + LN_EPS);
            pg8::st8f8((unsigned char*)OG + base, a0 * r * n0 * g0, a1 * r * n1 * g1);
            if (two) pg8::st8f8((unsigned char*)OG + base2, c0 * r2 * n0 * e0, c1 * r2 * n1 * e1); }
        if (PROBE_PHASE == 4) __syncthreads(); }
        if (BOTH(4)) xcd_barrier(bar);
    }
    if (IN(5)) { for (int rep_ = 0; rep_ < (PROBE_PHASE == 5 ? 2 : 1); ++rep_) {
        pg8::Gemm g{OG, WBT, OG, WBT, GV / 2}; pg8::Order2 S; S.init(T, D, 0, 0, G, bx);
        pg8::Epi<EK_B> E; E.e = EpiArgs{}; E.e.o0 = MERGED; E.e.a0 = GATES; E.e.a1 = TMP;
        pg8::gemm_phase<pg8::Epi<EK_B>, pg8::Order2, true, true, true>(lds, g, S, E);
        if (PROBE_PHASE == 5) __syncthreads(); }
        if (BOTH(5)) xcd_barrier(bar);
    }
    if (IN(6)) { for (int rep_ = 0; rep_ < (PROBE_PHASE == 6 ? 2 : 1); ++rep_) {
        pg8::Gemm g{MERGED, WOT, MERGED, WOT, D / 2}; pg8::Order2 S; S.init(T, D, 0, 0, G, bx);
        if (G == 256) { pg8::EpiLnOut E{H0, args.in[15], args.in[16], H1, WSP(unsigned char, WS_H1F8), WSP(unsigned long long, WS_LNX), (unsigned*)(ctl + 16384), (unsigned*)(ctl + CW_TMO)};
            pg8::gemm_phase<pg8::EpiLnOut, pg8::Order2, false, true, true>(lds, g, S, E); }
        else { pg8::Epi<EK_OUT> E; E.e = EpiArgs{}; E.e.of = R1; E.e.a0 = H0;
            pg8::gemm_phase<pg8::Epi<EK_OUT>, pg8::Order2, true, true, true>(lds, g, S, E); }
#if FP4_LOW == 3
#else
        for (int r = gw; r < 2 * PNK * PNK; r += NGW) { if (r < PNK * PNK) f6_row<false>(args.in[19], WSP(unsigned char, WS_U8), WSP(unsigned char, WS_U4), WSP(float, WS_RSU), r, lane); else f6_row<true>(args.in[20], WSP(unsigned char, WS_V8), WSP(unsigned char, WS_V4), WSP(float, WS_RSV), r - PNK * PNK, lane); }
#endif
        if (PROBE_PHASE == 6) __syncthreads(); }
        if (BOTH(6)) xcd_barrier(bar);
    }
    const bool p7_needed = (G != 256) || ((((T / 256) * (N1 / 256) + (3072 / 256) * (T / 256)) % G) == 0);
    if (IN(7) && p7_needed) { for (int rep_ = 0; rep_ < (PROBE_PHASE == 7 ? 2 : 1); ++rep_) {
        if (G != 256) for (int m = gw; m < T; m += NGW) ln_row_dev(R1 + (size_t)m * D, args.in[15], args.in[16], H1 + (size_t)m * D, lane, WSP(unsigned char, WS_H1F8) + (size_t)m * D);
        if ((((T / 256) * (N1 / 256) + (3072 / 256) * (T / 256)) % G) == 0) {
        int kple = PLE; asm volatile("" : "+s"(kple));
        pg8::Gemm g{PB, WPT, PB, WPT, kple}; pg8::Order2 S; S.init(T, D, 0, 0, G, bx);
        pg8::Epi<EK_PLE> E; E.e = EpiArgs{}; E.e.o0 = PLELIN;
        pg8::gemm_phase<pg8::Epi<EK_PLE>, pg8::Order2, true, true>(lds, g, S, E); }
        if (PROBE_PHASE == 7) __syncthreads(); }
        if (BOTH(7)) xcd_barrier(bar);
    }
    if (IN(8)) { for (int rep_ = 0; rep_ < (PROBE_PHASE == 8 ? 2 : 1); ++rep_) {
        { pg8::Gemm g{(const bf16*)WSP(unsigned char, WS_H1F8), (const bf16*)WSP(unsigned char, WS_W2F8), (const bf16*)WSP(unsigned char, WS_H1F8), (const bf16*)WSP(unsigned char, WS_W2F8), D / 2}; pg8::Order2 S; S.init(T, D, 0, 0, G, bx);
          pg8::Epi<EK_2> E; E.e = EpiArgs{}; E.e.o0 = PLEB; E.e.o1 = QP; E.e.a0 = PLELIN;
          pg8::gemm_phase<pg8::Epi<EK_2>, pg8::Order2, true, true, true>(lds, g, S, E); }
        { pg8::Gemm g{H1, W2T + (size_t)2048 * D, H1, W2T + (size_t)2048 * D, D}; pg8::Order2 S; S.init(T, D, 0, 0, G, bx);
          pg8::Epi<EK_2> E; E.e = EpiArgs{}; E.e.o0 = PLEB; E.e.o1 = QP; E.e.a0 = PLELIN; E.e.qonly = 1;
          pg8::gemm_phase<pg8::Epi<EK_2>, pg8::Order2, true, true, false>(lds, g, S, E); }
        if (PROBE_PHASE == 8) __syncthreads(); }
        if (BOTH(8)) xcd_barrier(bar);
    }
    if (IN(9)) { for (int rep_ = 0; rep_ < (PROBE_PHASE == 9 ? 2 : 1); ++rep_) {
        for (int tile = bx; tile < T / 16; tile += G)
            peer_tile(lds, QP, KEYS, H1, WSP(unsigned char, WS_U8), WSP(unsigned char, WS_V8), WSP(unsigned char, WS_U4), WSP(unsigned char, WS_V4), WSP(float, WS_RSU), WSP(float, WS_RSV), PLEB, args.in[23], args.in[24], args.out, tile, tid);
    } }
#undef IN
#undef BOTH
#undef WSP
}

extern "C" void kernel_launch(void* const* d_in, const int* in_sizes, int n_in, void* d_out, int out_size, void* d_ws, size_t ws_size, hipStream_t stream) {
    (void)in_sizes; (void)n_in; (void)out_size; (void)ws_size;
    const float* x = (const float*)d_in[0]; const float* p = (const float*)d_in[1]; const float* ln_e_g = (const float*)d_in[2]; const float* ln_e_b = (const float*)d_in[3];
    const float* w_in = (const float*)d_in[4]; const float* b_in = (const float*)d_in[5]; const float* rpb = (const float*)d_in[6];
    const float* up_f = (const float*)d_in[7]; const float* gb_f = (const float*)d_in[8]; const float* up_b = (const float*)d_in[9]; const float* gb_b = (const float*)d_in[10];
    const float* norm_g = (const float*)d_in[11]; const float* w_pa = (const float*)d_in[12]; const float* w_pb = (const float*)d_in[13]; const float* w_out = (const float*)d_in[14];
    const float* ln_a_g = (const float*)d_in[15]; const float* ln_a_b = (const float*)d_in[16]; const float* peer_wq = (const float*)d_in[17]; const float* sub_keys = (const float*)d_in[18];
    const float* peer_u = (const float*)d_in[19]; const float* peer_v = (const float*)d_in[20]; const float* w_ple = (const float*)d_in[21]; const float* w_pg = (const float*)d_in[22];
    const float* ln_b_g = (const float*)d_in[23]; const float* ln_b_b = (const float*)d_in[24];
    unsigned char* ws = (unsigned char*)d_ws; float* out = (float*)d_out;
#define WSP(T_, off) ((T_*)(ws + (off)))
    static int grid = 0;
    if (grid == 0) {
        int dev = 0, cus = 0; (void)hipGetDevice(&dev); (void)hipDeviceGetAttribute(&cus, hipDeviceAttributeMultiprocessorCount, dev);
        if (hipFuncSetAttribute((const void*)mk_fwd, hipFuncAttributeMaxDynamicSharedMemorySize, LDS_BYTES) != hipSuccess) { fprintf(stderr, "hipFuncSetAttribute failed\n"); grid = -1; return; }
        int per_cu = 0; (void)hipOccupancyMaxActiveBlocksPerMultiprocessor(&per_cu, (const void*)mk_fwd, NWAVES * 64, LDS_BYTES); (void)hipGetLastError();
        if (per_cu < 1) fprintf(stderr, "occupancy query reports %d blocks per CU\n", per_cu);
        grid = cus;
    }
    if (grid < 0) return;
    (void)hipMemsetAsync(ws + WS_CTL, 0, 1 * MiB, stream);
    { Args a{}; for (int i = 0; i < 25; ++i) a.in[i] = (const float*)d_in[i]; a.out = out; a.ws = ws; a.ph_lo = 0; a.ph_hi = 10; a.li = 0; a.flags = 0;
      hipLaunchKernelGGL(mk_fwd, dim3(grid), dim3(NWAVES * 64), LDS_BYTES, stream, a); }
}
```
